# Optimizing an MI355X kernel written in HIP

```python
import jax, jax.numpy as jnp
from jax import lax
import numpy as np

D_MODEL = 1024
BATCH = 1
SEQ = 16384
DEPTH = 2

GRID_W = 64
CTX_LEN = 256
N_Q_HEADS = 8
N_KV_HEADS = 2
HEAD_DIM = 128
ATTN_WIDTH = N_Q_HEADS * HEAD_DIM
KV_WIDTH = N_KV_HEADS * HEAD_DIM
ROPE_AXIS_DIM = HEAD_DIM // 2
ROPE_THETA = 10000.0
Q_BLOCK = 128
SGU_GROUPS = 8
SGU_WIDTH = 512
SGU_CHUNK = 128
FOURIER_GROUPS = 4
FOURIER_WIDTH = 512
N_BRANCHES = 3
FFN_HIDDEN = -(-8 * D_MODEL // (3 * 256)) * 256
Q_END = ATTN_WIDTH
K_END = Q_END + KV_WIDTH
V_END = K_END + KV_WIDTH
SGU_END = V_END + 2 * SGU_WIDTH
FOURIER_END = SGU_END + FOURIER_WIDTH
IN_WIDTH = FOURIER_END + N_BRANCHES * D_MODEL
DEEPNORM_ALPHA = (2 * DEPTH) ** 0.25
DEEPNORM_BETA = (8 * DEPTH) ** -0.25
LN_EPS = 1e-6
RMS_EPS = 1e-6

kernel_name = 'hybrid_gated_attn_gmlp_fourier_dit_block'


def layer_norm(x, g=None, b=None):
    xf = x.astype(jnp.float32)
    mu = jnp.mean(xf, axis=-1, keepdims=True)
    var = jnp.mean(jnp.square(xf - mu), axis=-1, keepdims=True)
    y = (xf - mu) * lax.rsqrt(var + LN_EPS)
    if g is not None:
        y = y * g.astype(jnp.float32) + b.astype(jnp.float32)
    return y.astype(x.dtype)


def rms_norm(x, g):
    xf = x.astype(jnp.float32)
    y = xf * lax.rsqrt(jnp.mean(jnp.square(xf), axis=-1, keepdims=True) + RMS_EPS)
    return (y * g.astype(jnp.float32)).astype(x.dtype)


def modulate(x, shift, scale):
    return layer_norm(x) * (1 + scale) + shift


def axial_rope(n_tokens):
    rows = n_tokens // GRID_W
    pos_r = jnp.repeat(jnp.arange(rows, dtype=jnp.float32), GRID_W)
    pos_c = jnp.tile(jnp.arange(GRID_W, dtype=jnp.float32), rows)
    inv = ROPE_THETA ** (-jnp.arange(0, ROPE_AXIS_DIM, 2, dtype=jnp.float32) / ROPE_AXIS_DIM)
    ang = jnp.concatenate([pos_r[:, None] * inv, pos_c[:, None] * inv], axis=-1)
    return jnp.cos(ang), jnp.sin(ang)


def apply_rope(x, cos, sin):
    xf = x.astype(jnp.float32).reshape(*x.shape[:-1], HEAD_DIM // 2, 2)
    x0, x1 = xf[..., 0], xf[..., 1]
    cc, ss = cos[None, :, None, :], sin[None, :, None, :]
    out = jnp.stack([x0 * cc - x1 * ss, x0 * ss + x1 * cc], axis=-1)
    return out.reshape(x.shape).astype(x.dtype)


def attention(q, k, v):
    B, Tq = q.shape[0], q.shape[1]
    G = N_Q_HEADS // N_KV_HEADS
    nb = Tq // Q_BLOCK
    qb = q.reshape(B, nb, Q_BLOCK, N_KV_HEADS, G, HEAD_DIM).transpose(1, 0, 2, 3, 4, 5)
    scale = HEAD_DIM ** -0.5

    def one_block(q_blk):
        s = jnp.einsum('bqhgd,bkhd->bhgqk', q_blk, k).astype(jnp.float32) * scale
        p = jax.nn.softmax(s, axis=-1).astype(v.dtype)
        return jnp.einsum('bhgqk,bkhd->bqhgd', p, v)

    o = lax.map(one_block, qb)
    return o.transpose(1, 0, 2, 3, 4, 5).reshape(B, Tq, ATTN_WIDTH)


def spatial_gating(s, ln_g, ln_b, w_sp, b_sp):
    B, T = s.shape[0], s.shape[1]
    u, v = s[..., :SGU_WIDTH], s[..., SGU_WIDTH:]
    v = layer_norm(v, ln_g, ln_b)
    n = T // SGU_CHUNK
    vg = v.reshape(B, n, SGU_CHUNK, SGU_GROUPS, SGU_WIDTH // SGU_GROUPS)
    mixed = jnp.einsum('gpq,bnqgc->bnpgc', w_sp, vg) + b_sp.T[None, None, :, :, None]
    return u * mixed.reshape(B, T, SGU_WIDTH)


def fourier_mix(f):
    B, T = f.shape[0], f.shape[1]
    fg = f.astype(jnp.float32).reshape(B, T, FOURIER_GROUPS, FOURIER_WIDTH // FOURIER_GROUPS)
    y = jnp.fft.fft2(fg, axes=(1, 3), norm='ortho').real
    return y.reshape(B, T, FOURIER_WIDTH).astype(f.dtype)


def token_mixer(h, w_in, q_gain, k_gain, sgu_ln_g, sgu_ln_b, w_sp, b_sp,
                w_br_attn, w_br_sgu, w_br_fourier, w_out, rope, ctx_kv):
    B, T, _ = h.shape
    z = h @ w_in
    q = rms_norm(z[..., :Q_END].reshape(B, T, N_Q_HEADS, HEAD_DIM), q_gain)
    k = rms_norm(z[..., Q_END:K_END].reshape(B, T, N_KV_HEADS, HEAD_DIM), k_gain)
    v = z[..., K_END:V_END].reshape(B, T, N_KV_HEADS, HEAD_DIM)
    s = jax.nn.gelu(z[..., V_END:SGU_END])
    f = z[..., SGU_END:FOURIER_END]
    gates = jax.nn.sigmoid(z[..., FOURIER_END:].astype(jnp.float32)).astype(h.dtype)
    gates = gates.reshape(B, T, N_BRANCHES, D_MODEL)
    if rope is not None:
        q = apply_rope(q, rope[0], rope[1])
        k = apply_rope(k, rope[0], rope[1])
    if ctx_kv is not None:
        k_all = jnp.concatenate([k, ctx_kv[0]], axis=1)
        v_all = jnp.concatenate([v, ctx_kv[1]], axis=1)
    else:
        k_all, v_all = k, v
    a = attention(q, k_all, v_all)
    g_out = spatial_gating(s, sgu_ln_g, sgu_ln_b, w_sp, b_sp)
    f_out = fourier_mix(f)
    merged = (gates[:, :, 0] * (a @ w_br_attn)
              + gates[:, :, 1] * (g_out @ w_br_sgu)
              + gates[:, :, 2] * (f_out @ w_br_fourier))
    return merged @ w_out, (k, v)


def context_kv(h, w_in, k_gain):
    B, T, _ = h.shape
    kv = h @ w_in[:, Q_END:V_END]
    k = rms_norm(kv[..., :KV_WIDTH].reshape(B, T, N_KV_HEADS, HEAD_DIM), k_gain)
    v = kv[..., KV_WIDTH:].reshape(B, T, N_KV_HEADS, HEAD_DIM)
    return k, v


def swiglu(h, w_up, w_down):
    gu = h @ w_up
    return (jax.nn.silu(gu[..., :FFN_HIDDEN]) * gu[..., FFN_HIDDEN:]) @ w_down


def setup_inputs(seed: int = 0) -> dict:
    key = jax.random.key(seed)
    ks = jax.random.split(key, 24)
    f32 = jnp.float32
    L, D = DEPTH, D_MODEL

    def nrm(k, shape, scale):
        return jax.random.normal(k, shape, f32) * scale

    return {
        'x': nrm(ks[0], (BATCH, SEQ, D), 1.0),
        'c': nrm(ks[1], (BATCH, D), 1.0),
        'ctx': nrm(ks[2], (BATCH, CTX_LEN, D), 1.0),
        'c_ctx': nrm(ks[3], (D,), 1.0),
        'w_ada': nrm(ks[4], (L, D, 6 * D), D ** -0.5),
        'b_ada': nrm(ks[5], (L, 6 * D), 0.01),
        'w_in': nrm(ks[6], (L, D, IN_WIDTH), D ** -0.5),
        'q_gain': 1.0 + nrm(ks[7], (L, HEAD_DIM), 0.02),
        'k_gain': 1.0 + nrm(ks[8], (L, HEAD_DIM), 0.02),
        'sgu_ln_g': 1.0 + nrm(ks[9], (L, SGU_WIDTH), 0.02),
        'sgu_ln_b': nrm(ks[10], (L, SGU_WIDTH), 0.02),
        'w_spatial': nrm(ks[11], (L, SGU_GROUPS, SGU_CHUNK, SGU_CHUNK), SGU_CHUNK ** -0.5),
        'b_spatial': 1.0 + nrm(ks[12], (L, SGU_GROUPS, SGU_CHUNK), 0.02),
        'w_br_attn': nrm(ks[13], (L, ATTN_WIDTH, D), ATTN_WIDTH ** -0.5),
        'w_br_sgu': nrm(ks[14], (L, SGU_WIDTH, D), SGU_WIDTH ** -0.5),
        'w_br_fourier': nrm(ks[15], (L, FOURIER_WIDTH, D), FOURIER_WIDTH ** -0.5),
        'w_out': nrm(ks[16], (L, D, D), D ** -0.5 * DEEPNORM_BETA),
        'ln1_g': 1.0 + nrm(ks[17], (L, D), 0.02),
        'ln1_b': nrm(ks[18], (L, D), 0.02),
        'w_up': nrm(ks[19], (L, D, 2 * FFN_HIDDEN), D ** -0.5),
        'w_down': nrm(ks[20], (L, FFN_HIDDEN, D), FFN_HIDDEN ** -0.5 * DEEPNORM_BETA),
        'ln2_g': 1.0 + nrm(ks[21], (L, D), 0.02),
        'ln2_b': nrm(ks[22], (L, D), 0.02),
    }


def reference(x, c, ctx, c_ctx, w_ada, b_ada, w_in, q_gain, k_gain, sgu_ln_g, sgu_ln_b,
              w_spatial, b_spatial, w_br_attn, w_br_sgu, w_br_fourier, w_out,
              ln1_g, ln1_b, w_up, w_down, ln2_g, ln2_b):
    rope = axial_rope(x.shape[1])
    alpha = DEEPNORM_ALPHA
    for l in range(DEPTH):
        last = l == DEPTH - 1
        mod_x = (jax.nn.silu(c) @ w_ada[l] + b_ada[l])[:, None, :]
        mod_c = (jax.nn.silu(c_ctx) @ w_ada[l] + b_ada[l])[None, None, :]
        shift1, scale1, gate1, shift2, scale2, gate2 = jnp.split(mod_x, 6, axis=-1)
        c_shift1, c_scale1, c_gate1, c_shift2, c_scale2, c_gate2 = jnp.split(mod_c, 6, axis=-1)
        mixer_w = (w_in[l], q_gain[l], k_gain[l], sgu_ln_g[l], sgu_ln_b[l], w_spatial[l],
                   b_spatial[l], w_br_attn[l], w_br_sgu[l], w_br_fourier[l], w_out[l])

        hc = modulate(ctx, c_shift1, c_scale1)
        if last:
            ctx_kv = context_kv(hc, w_in[l], k_gain[l])
        else:
            mix_c, ctx_kv = token_mixer(hc, *mixer_w, None, None)

        hx = modulate(x, shift1, scale1)
        mix_x, _ = token_mixer(hx, *mixer_w, rope, ctx_kv)
        x = layer_norm(alpha * x + gate1 * mix_x, ln1_g[l], ln1_b[l])
        ffn_x = swiglu(modulate(x, shift2, scale2), w_up[l], w_down[l])
        x = layer_norm(alpha * x + gate2 * ffn_x, ln2_g[l], ln2_b[l])

        if not last:
            ctx = layer_norm(alpha * ctx + c_gate1 * mix_c, ln1_g[l], ln1_b[l])
            ffn_c = swiglu(modulate(ctx, c_shift2, c_scale2), w_up[l], w_down[l])
            ctx = layer_norm(alpha * ctx + c_gate2 * ffn_c, ln2_g[l], ln2_b[l])
    return x
```

```cpp
#include <hip/hip_runtime.h>
#include <hip/hip_bf16.h>
#include <hip/hip_cooperative_groups.h>
#include <cstdio>
#include <cstdint>
namespace cg = cooperative_groups;

constexpr int T = 16384, CTX = 256, R = T + CTX, D = 1024, INW = 6144, FFH = 2816, NL = 2;
constexpr float ALPHA = 1.4142135623730951f;
constexpr float LN_EPS = 1e-6f, RMS_EPS = 1e-6f;

typedef unsigned short u16;
typedef short bf16x8 __attribute__((ext_vector_type(8)));
typedef short s16x4 __attribute__((ext_vector_type(4)));
typedef float f32x4 __attribute__((ext_vector_type(4)));
typedef float f32x2 __attribute__((ext_vector_type(2)));
typedef float f32x16 __attribute__((ext_vector_type(16)));
typedef unsigned u32x4 __attribute__((ext_vector_type(4)));
typedef unsigned u32x2 __attribute__((ext_vector_type(2)));
#define LAS __attribute__((address_space(3)))

constexpr size_t SZ_RD = (size_t)R * D * 2;
constexpr size_t OFF_H = 0;
constexpr size_t OFF_Q = OFF_H + SZ_RD;
constexpr size_t OFF_F = OFF_Q + SZ_RD;
constexpr size_t OFF_K = OFF_F + (size_t)R * 512 * 2;
constexpr size_t OFF_V = OFF_K + (size_t)R * 256 * 2;
constexpr size_t OFF_YC = OFF_F;
constexpr size_t OFF_S = OFF_F + SZ_RD;
constexpr size_t OFF_G = OFF_S + SZ_RD;
constexpr size_t OFF_W1 = OFF_G + (size_t)R * 3072 * 2;
constexpr size_t SZ_W1 = (size_t)5632 * 1024 * 2 + (size_t)1024 * 2816 * 2;
constexpr size_t OFF_WUP = OFF_W1, OFF_WDN = OFF_W1 + (size_t)5632 * 1024 * 2;
constexpr size_t OFF_WBA = OFF_W1 + SZ_W1;
constexpr size_t OFF_WBS = OFF_WBA + 2097152;
constexpr size_t OFF_WBF = OFF_WBS + 1048576;
constexpr size_t OFF_WO = OFF_WBF + 2097152;
constexpr size_t OFF_XCTX = OFF_WO + 2097152;
constexpr size_t OFF_MODP = OFF_XCTX + 1048576;
constexpr size_t OFF_MOD = OFF_MODP + 1572864;
constexpr size_t OFF_MA = OFF_MOD + 98304;
constexpr size_t OFF_MB = OFF_MA + 65536;
constexpr size_t OFF_MC = OFF_MB + 131072;
constexpr size_t OFF_TW = OFF_MC + 262144;
constexpr size_t OFF_ROPE = OFF_TW + 131072;
constexpr size_t OFF_WSP = OFF_ROPE + 65536;
constexpr size_t OFF_FC = OFF_WSP + 524288;
constexpr size_t WS_END = OFF_FC + 262144;
static_assert(WS_END <= 268435456ull, "workspace map exceeds 256 MiB");
static_assert(SZ_W1 >= (size_t)INW * D * 2, "w_in_t fits the shared weight region");

constexpr int LDS_BYTES = 131072 + 2048;

__device__ __forceinline__ unsigned f2bf(float f) { unsigned u = __builtin_bit_cast(unsigned, f); return (u + 0x7fffu + ((u >> 16) & 1u)) >> 16; }
__device__ __forceinline__ unsigned pk2(float lo, float hi) { return f2bf(lo) | (f2bf(hi) << 16); }
__device__ __forceinline__ float bflo(unsigned w) { return __builtin_bit_cast(float, w << 16); }
__device__ __forceinline__ float bfhi(unsigned w) { return __builtin_bit_cast(float, w & 0xffff0000u); }
__device__ __forceinline__ float bf2f(u16 b) { return __builtin_bit_cast(float, ((unsigned)b) << 16); }
__device__ __forceinline__ float wave_sum(float v) {
#pragma unroll
    for (int o = 1; o < 64; o <<= 1) v += __shfl_xor(v, o);
    return v;
}
__device__ __forceinline__ float fsigmoid(float x) { return __builtin_amdgcn_rcpf(1.0f + __builtin_amdgcn_exp2f(-1.4426950408889634f * x)); }
__device__ __forceinline__ float fgelu_tanh(float x) { const float y2 = 1.5957691216057308f * (x + 0.044715f * x * x * x); return x * fsigmoid(y2); }
__device__ __forceinline__ int crow(int r, int hi) { return (r & 3) + 8 * (r >> 2) + 4 * hi; }

namespace pg8 {
#define PG8_LAS __attribute__((address_space(3)))
typedef unsigned short bf16_t;
constexpr int BM = 256, BK = 64, HALF = 128, HTB = HALF * BK * 2, STAGE_BYTES = 8 * HTB, NXCD = 8, WGM = 8;
__host__ __device__ __forceinline__ int lds_byte(int r, int c) { const int st = (r >> 4) * 2 + (c >> 5), rr = r & 15, cc = c & 31, ob = rr * 64 + cc * 2; return st * 1024 + (ob ^ (((ob >> 9) & 1) << 5)); }
__host__ __device__ __forceinline__ void stage_rc(int b, int& Rr, int& C) { const int st = b / 1024, sb = b % 1024, swz = sb ^ (((sb >> 9) & 1) << 5); Rr = (st >> 1) * 16 + swz / 64; C = (st & 1) * 32 + (swz % 64) / 2; }
__host__ __device__ __forceinline__ int perm32(int rho) { const int n = rho >> 4, i = rho & 15; return 8 * (i >> 2) + 4 * n + (i & 3); }
struct Unit { int pm, pn; };
struct Gemm { const bf16_t* A; const bf16_t* Bt; int K, lda, ldb; };
struct StaticOrder {
    int nM, nN, nwg, G, c;
    __device__ void init(int M, int N, int G_, int c_) { nM = M / BM; nN = N / BM; nwg = nM * nN; G = G_; c = c_; }
    __device__ bool next(int i, Unit& u) const {
        const long L = (long)i * G + c; if (L >= nwg) return false;
        int wgid = (int)L; { const int q = nwg / NXCD, r = nwg % NXCD, xcd = wgid % NXCD, off = wgid / NXCD; wgid = (xcd < r ? xcd * (q + 1) : r * (q + 1) + (xcd - r) * q) + off; }
        const int nig = WGM * nN, gid = wgid / nig, fm = gid * WGM, gsz = (nM - fm) < WGM ? (nM - fm) : WGM;
        u.pm = fm + ((wgid % nig) % gsz); u.pn = (wgid % nig) / gsz; return true;
    }
};
struct OrderX {
    StaticOrder so; int nextra, pn0;
    __device__ void init(int N, int G_, int c_, int nextra_, int pn0_) { so.init(T, N, G_, c_); nextra = nextra_; pn0 = pn0_; }
    __device__ bool next(int i, Unit& u) const {
        const long L = (long)i * so.G + so.c;
        if (L < so.nwg) return so.next(i, u);
        const int e = (int)(L - so.nwg); if (e >= nextra) return false;
        u.pm = 64; u.pn = pn0 + e; return true;
    }
    __device__ __forceinline__ void a_ready(const Unit&) const {}
    __device__ __forceinline__ void done(const Unit&) const {}
};

template <class Epi, class Sched>
__device__ __forceinline__ void gemm_phase(PG8_LAS unsigned char* lds, const Gemm g, const Sched& S, const Epi& E, const int tid) {
    const int wid = __builtin_amdgcn_readfirstlane(tid >> 6), lane = tid & 63, wr = wid >> 2, wc = wid & 3, fr = lane & 15, fq = lane >> 4;
    const int K = g.K, nt = K / BK;
    unsigned voffA[2], voffB[2];
#pragma unroll
    for (int i = 0; i < 2; ++i) { int Rr, C; stage_rc(tid * 16 + i * 8192, Rr, C); const int Rb = Epi::PERM ? ((Rr & ~31) + perm32(Rr & 31)) : Rr;
        voffA[i] = (unsigned)(Rr * g.lda + C) * 2u; voffB[i] = (unsigned)(Rb * g.ldb + C) * 2u; }
    const size_t kstep = (size_t)(BK * 2);
    const size_t hstepA = (size_t)HALF * g.lda * 2, hstepB = (size_t)HALF * g.ldb * 2;
    const size_t tstepA = 2 * hstepA, tstepB = 2 * hstepB;
    const unsigned ldsw = (unsigned)wid * 1024u;
    const int aoff = lds_byte(wr * 64 + fr, fq * 8), boff = lds_byte(wc * 32 + fr, fq * 8);
#define PG8_SA(b, h) (((b) * 2 + (h)) * HTB)
#define PG8_SB(b, h) ((4 + (b) * 2 + (h)) * HTB)
#define PG8_STAGE(bufoff, gbase, voff) do { _Pragma("unroll") for (int _i = 0; _i < 2; ++_i) \
        __builtin_amdgcn_global_load_lds((const unsigned*)((const char*)(gbase) + (voff)[_i]), (PG8_LAS unsigned*)(lds + (bufoff) + ldsw + _i * 8192), 16, 0, 0); } while (0)
#define PG8_LDA(dst, b, h) do { _Pragma("unroll") for (int m = 0; m < 4; ++m) _Pragma("unroll") for (int k = 0; k < 2; ++k) dst[m][k] = *(const PG8_LAS bf16x8*)(lds + PG8_SA(b, h) + aoff + m * 2048 + k * 1024); } while (0)
#define PG8_LDB(dst, b, h) do { _Pragma("unroll") for (int n = 0; n < 2; ++n) _Pragma("unroll") for (int k = 0; k < 2; ++k) dst[n][k] = *(const PG8_LAS bf16x8*)(lds + PG8_SB(b, h) + boff + n * 2048 + k * 1024); } while (0)
#define PG8_MMA(ai, bj, At, Bt) do { __builtin_amdgcn_s_setprio(1); _Pragma("unroll") for (int m = 0; m < 4; ++m) _Pragma("unroll") for (int n = 0; n < 2; ++n) _Pragma("unroll") for (int k = 0; k < 2; ++k) \
        acc[ai][bj][m][n] = __builtin_amdgcn_mfma_f32_16x16x32_bf16(Bt[n][k], At[m][k], acc[ai][bj][m][n], 0, 0, 0); __builtin_amdgcn_s_setprio(0); } while (0)
#define PG8_WAIT_V(n) asm volatile("s_waitcnt vmcnt(" #n ")" ::: "memory")
#define PG8_WAIT_L(n) asm volatile("s_waitcnt lgkmcnt(" #n ")" ::: "memory")
#define PG8_BAR __builtin_amdgcn_s_barrier()
#define PG8_SCHED __builtin_amdgcn_sched_barrier(0)
    Unit cur, nxt; int ui = 0;
    if (!S.next(0, cur)) return;
    f32x4 acc[2][2][4][2];
#pragma unroll
    for (int a = 0; a < 2; ++a)
#pragma unroll
        for (int b = 0; b < 2; ++b)
#pragma unroll
            for (int m = 0; m < 4; ++m)
#pragma unroll
                for (int n = 0; n < 2; ++n) acc[a][b][m][n] = (f32x4){0.f, 0.f, 0.f, 0.f};
    bf16x8 At[4][2], B0[2][2], B1[2][2];
    const char* cA = (const char*)g.A + (size_t)cur.pm * tstepA; const char* cB = (const char*)g.Bt + (size_t)cur.pn * tstepB;
    S.a_ready(cur);
    PG8_STAGE(PG8_SB(0, 0), cB, voffB); PG8_STAGE(PG8_SA(0, 0), cA, voffA); PG8_STAGE(PG8_SB(0, 1), cB + hstepB, voffB); PG8_STAGE(PG8_SA(0, 1), cA + hstepA, voffA);
    if (wr == 1) PG8_BAR;
    PG8_WAIT_V(4); PG8_BAR;
    PG8_STAGE(PG8_SB(1, 0), cB + kstep, voffB); PG8_STAGE(PG8_SA(1, 0), cA + kstep, voffA); PG8_STAGE(PG8_SB(1, 1), cB + hstepB + kstep, voffB);
    PG8_WAIT_V(6); PG8_BAR;
    for (;;) {
        const bool has_next = S.next(ui + 1, nxt);
        const char* nA = has_next ? (const char*)g.A + (size_t)nxt.pm * tstepA : cA; const char* nB = has_next ? (const char*)g.Bt + (size_t)nxt.pn * tstepB : cB;
        for (int t = 0; t < nt; t += 2) {
            const bool last = (t == nt - 2);
            const char* a1 = cA + (size_t)(t + 1) * kstep;
            const char* a2 = last ? nA : cA + (size_t)(t + 2) * kstep; const char* b2 = last ? nB : cB + (size_t)(t + 2) * kstep;
            const char* a3 = a2 + kstep; const char* b3 = b2 + kstep;
            if (last && has_next) S.a_ready(nxt);
            PG8_LDB(B0, 0, 0); PG8_SCHED; PG8_LDA(At, 0, 0); PG8_STAGE(PG8_SA(1, 1), a1 + hstepA, voffA);
            PG8_WAIT_L(8); PG8_BAR; PG8_WAIT_L(0); PG8_MMA(0, 0, At, B0); PG8_BAR; PG8_SCHED;
            PG8_LDB(B1, 0, 1); PG8_STAGE(PG8_SB(0, 0), b2, voffB);
            PG8_BAR; PG8_WAIT_L(0); PG8_MMA(0, 1, At, B1); PG8_BAR;
            PG8_LDA(At, 0, 1); PG8_STAGE(PG8_SA(0, 0), a2, voffA);
            PG8_BAR; PG8_WAIT_L(0); PG8_MMA(1, 0, At, B0); PG8_BAR; PG8_SCHED;
            PG8_STAGE(PG8_SB(0, 1), b2 + hstepB, voffB);
            PG8_WAIT_V(6); PG8_BAR; PG8_MMA(1, 1, At, B1); PG8_BAR;
            PG8_LDB(B0, 1, 0); PG8_SCHED; PG8_LDA(At, 1, 0); PG8_STAGE(PG8_SA(0, 1), a2 + hstepA, voffA);
            PG8_WAIT_L(8); PG8_BAR; PG8_WAIT_L(0); PG8_MMA(0, 0, At, B0); PG8_BAR; PG8_SCHED;
            PG8_LDB(B1, 1, 1); PG8_STAGE(PG8_SB(1, 0), b3, voffB);
            PG8_BAR; PG8_WAIT_L(0); PG8_MMA(0, 1, At, B1); PG8_BAR;
            PG8_LDA(At, 1, 1); PG8_STAGE(PG8_SA(1, 0), a3, voffA);
            PG8_BAR; PG8_WAIT_L(0); PG8_MMA(1, 0, At, B0); PG8_BAR; PG8_SCHED;
            PG8_STAGE(PG8_SB(1, 1), b3 + hstepB, voffB);
            PG8_WAIT_V(6); PG8_BAR; PG8_MMA(1, 1, At, B1); PG8_BAR;
        }
        E(acc, cur, wr, wc, fr, fq); S.done(cur);
        if (!has_next) break;
#pragma unroll
        for (int a = 0; a < 2; ++a)
#pragma unroll
            for (int b = 0; b < 2; ++b)
#pragma unroll
                for (int m = 0; m < 4; ++m)
#pragma unroll
                    for (int n = 0; n < 2; ++n) acc[a][b][m][n] = (f32x4){0.f, 0.f, 0.f, 0.f};
        cur = nxt; cA = nA; cB = nB; ++ui;
    }
    PG8_WAIT_V(0);
    if (wr == 0) PG8_BAR;
    PG8_BAR;
#undef PG8_SA
#undef PG8_SB
#undef PG8_STAGE
#undef PG8_LDA
#undef PG8_LDB
#undef PG8_MMA
#undef PG8_WAIT_V
#undef PG8_WAIT_L
#undef PG8_BAR
#undef PG8_SCHED
}

struct EpiIn {
    static constexpr bool PERM = true;
    u16 *Q, *Kb, *Vb, *S, *F, *FC, *G;
    __device__ __forceinline__ void operator()(const f32x4 (&acc)[2][2][4][2], const Unit& u, int wr, int wc, int fr, int fq) const {
        const int pn = u.pn; u16* base; int ld, act = 0, radj = 0;
        if (pn < 4) { base = Q + pn * 256; ld = 1024; }
        else if (pn == 4) { base = Kb; ld = 256; }
        else if (pn == 5) { base = Vb; ld = 256; }
        else if (pn < 10) { base = S + (pn - 6) * 256; ld = 1024; act = 1; }
        else if (pn < 12) { if (u.pm == 64) { base = FC + (pn - 10) * 256; radj = T; } else base = F + (pn - 10) * 256; ld = 512; }
        else { base = G + (pn - 12) * 256; ld = 3072; act = 2; }
        const int row0 = u.pm * BM + wr * 64 + fr - radj, col0 = wc * 32 + 8 * fq;
#pragma unroll
        for (int ai = 0; ai < 2; ++ai)
#pragma unroll
            for (int m = 0; m < 4; ++m) { u16* rowp = base + (size_t)(row0 + ai * HALF + m * 16) * ld + col0;
#pragma unroll
                for (int bj = 0; bj < 2; ++bj) { f32x4 v0 = acc[ai][bj][m][0], v1 = acc[ai][bj][m][1];
                    if (act == 1) {
#pragma unroll
                        for (int j = 0; j < 4; ++j) { v0[j] = fgelu_tanh(v0[j]); v1[j] = fgelu_tanh(v1[j]); } }
                    else if (act == 2) {
#pragma unroll
                        for (int j = 0; j < 4; ++j) { v0[j] = fsigmoid(v0[j]); v1[j] = fsigmoid(v1[j]); } }
                    u32x4 w; w.x = pk2(v0[0], v0[1]); w.y = pk2(v0[2], v0[3]); w.z = pk2(v1[0], v1[1]); w.w = pk2(v1[2], v1[3]);
                    *(u32x4*)(rowp + bj * HALF) = w; } }
    }
};
struct EpiBr {
    static constexpr bool PERM = true;
    const u16* G; u16* Mg; int first;
    __device__ __forceinline__ void operator()(const f32x4 (&acc)[2][2][4][2], const Unit& u, int wr, int wc, int fr, int fq) const {
        const int row0 = u.pm * BM + wr * 64 + fr, col0 = u.pn * BM + wc * 32 + 8 * fq;
#pragma unroll
        for (int ai = 0; ai < 2; ++ai)
#pragma unroll
            for (int m = 0; m < 4; ++m) { const size_t r = (size_t)(row0 + ai * HALF + m * 16);
#pragma unroll
                for (int bj = 0; bj < 2; ++bj) { const int c = col0 + bj * HALF;
                    const u32x4 gw = *(const u32x4*)(G + r * 3072 + c);
                    f32x4 v0 = acc[ai][bj][m][0], v1 = acc[ai][bj][m][1];
                    v0[0] *= bflo(gw.x); v0[1] *= bfhi(gw.x); v0[2] *= bflo(gw.y); v0[3] *= bfhi(gw.y);
                    v1[0] *= bflo(gw.z); v1[1] *= bfhi(gw.z); v1[2] *= bflo(gw.w); v1[3] *= bfhi(gw.w);
                    u16* mp = Mg + r * 1024 + c;
                    if (!first) { const u32x4 pw = *(const u32x4*)mp;
                        v0[0] += bflo(pw.x); v0[1] += bfhi(pw.x); v0[2] += bflo(pw.y); v0[3] += bfhi(pw.y);
                        v1[0] += bflo(pw.z); v1[1] += bfhi(pw.z); v1[2] += bflo(pw.w); v1[3] += bfhi(pw.w); }
                    u32x4 w; w.x = pk2(v0[0], v0[1]); w.y = pk2(v0[2], v0[3]); w.z = pk2(v1[0], v1[1]); w.w = pk2(v1[2], v1[3]);
                    *(u32x4*)mp = w; } }
    }
};
struct EpiRes {
    static constexpr bool PERM = false;
    const float *xin_lat, *xin_ctx; float *xo_lat, *xo_ctx; const float *gate_lat, *gate_ctx;
    __device__ __forceinline__ void operator()(const f32x4 (&acc)[2][2][4][2], const Unit& u, int wr, int wc, int fr, int fq) const {
        const bool isc = (u.pm == 64);
        const float* xin = isc ? xin_ctx : xin_lat; float* xo = isc ? xo_ctx : xo_lat; const float* gate = isc ? gate_ctx : gate_lat;
        const int row0 = (isc ? 0 : u.pm * BM) + wr * 64 + fr, col0 = u.pn * BM + wc * 32 + 4 * fq;
        f32x4 gv[2][2];
#pragma unroll
        for (int bj = 0; bj < 2; ++bj)
#pragma unroll
            for (int n = 0; n < 2; ++n) gv[bj][n] = *(const f32x4*)(gate + col0 + bj * HALF + n * 16);
#pragma unroll
        for (int ai = 0; ai < 2; ++ai)
#pragma unroll
            for (int m = 0; m < 4; ++m) { const size_t off = (size_t)(row0 + ai * HALF + m * 16) * D + col0;
#pragma unroll
                for (int bj = 0; bj < 2; ++bj)
#pragma unroll
                    for (int n = 0; n < 2; ++n) { const f32x4 xv = *(const f32x4*)(xin + off + bj * HALF + n * 16);
                        *(f32x4*)(xo + off + bj * HALF + n * 16) = xv * ALPHA + gv[bj][n] * acc[ai][bj][m][n]; } }
    }
};
struct EpiUp {
    static constexpr bool PERM = true;
    u16* ACT;
    __device__ __forceinline__ void operator()(const f32x4 (&acc)[2][2][4][2], const Unit& u, int wr, int wc, int fr, int fq) const {
        const int row0 = u.pm * BM + wr * 64 + fr, col0 = u.pn * HALF + wc * 32 + 8 * fq;
#pragma unroll
        for (int ai = 0; ai < 2; ++ai)
#pragma unroll
            for (int m = 0; m < 4; ++m) { u16* rowp = ACT + (size_t)(row0 + ai * HALF + m * 16) * FFH + col0;
                f32x4 g0 = acc[ai][0][m][0], g1 = acc[ai][0][m][1]; const f32x4 u0 = acc[ai][1][m][0], u1 = acc[ai][1][m][1];
#pragma unroll
                for (int j = 0; j < 4; ++j) { g0[j] = g0[j] * fsigmoid(g0[j]) * u0[j]; g1[j] = g1[j] * fsigmoid(g1[j]) * u1[j]; }
                u32x4 w; w.x = pk2(g0[0], g0[1]); w.y = pk2(g0[2], g0[3]); w.z = pk2(g1[0], g1[1]); w.w = pk2(g1[2], g1[3]);
                *(u32x4*)rowp = w; }
    }
};
}

namespace att {
constexpr int NW = 8, QBLK = 32, KVBLK = 64;
constexpr float SCALE = 0.088388347648318440f, THR = 8.f;
constexpr int LDQ = 1024, LDK = 256, LDO = 1024;
constexpr size_t SHM_V = KVBLK * 128 * 2, SHM_K = KVBLK * 128 * 2, SHM_ATTN = 2 * SHM_V + 2 * SHM_K + NW * 64 * 4;
#define KSWZ(row, colB) ((row) * 256 + ((colB) ^ (((row) & 7) << 4)))
#define SBAR() __builtin_amdgcn_sched_barrier(0)
__device__ __forceinline__ unsigned cvtpk(float lo, float hi) { unsigned r; asm volatile("v_cvt_pk_bf16_f32 %0, %1, %2" : "=v"(r) : "v"(lo), "v"(hi)); return r; }
__device__ __forceinline__ void partialSM(f32x16& p0, f32x16& p1, float& m_reg, float& mn, float& alpha) {
  constexpr float C = SCALE * 1.4426950408889634f;
  float pmax = p0[0]; for (int r = 1; r < 16; ++r) pmax = fmaxf(pmax, p0[r]); for (int r = 0; r < 16; ++r) pmax = fmaxf(pmax, p1[r]);
  { auto rr = __builtin_amdgcn_permlane32_swap(__float_as_uint(pmax), __float_as_uint(pmax), false, false);
    pmax = fmaxf(__uint_as_float(rr[0]), __uint_as_float(rr[1])); }
  if (__builtin_expect(__all(pmax - m_reg <= THR / SCALE), 1)) { mn = m_reg; alpha = 1.f; }
  else { mn = fmaxf(m_reg, pmax); alpha = __builtin_amdgcn_exp2f((m_reg - mn) * C); m_reg = mn; }
  float mnC = -mn * C;
  for (int r = 0; r < 16; ++r) p0[r] = fmaf(p0[r], C, mnC); for (int r = 0; r < 16; ++r) p1[r] = fmaf(p1[r], C, mnC);
  for (int r = 0; r < 16; ++r) p0[r] = __builtin_amdgcn_exp2f(p0[r]);
}
__device__ __forceinline__ void finishSM(f32x16& p0, f32x16& p1, float alpha, float& l_reg, bf16x8& pa0, bf16x8& pa1, bf16x8& pa2, bf16x8& pa3) {
  for (int r = 0; r < 16; ++r) p1[r] = __builtin_amdgcn_exp2f(p1[r]);
  float ps = 0; for (int r = 0; r < 16; ++r) ps += p0[r]; for (int r = 0; r < 16; ++r) ps += p1[r];
  { auto rr = __builtin_amdgcn_permlane32_swap(__float_as_uint(ps), __float_as_uint(ps), false, false);
    ps = __uint_as_float(rr[0]) + __uint_as_float(rr[1]); }
  l_reg = l_reg * alpha + ps;
#define PK4(P, BASE, OUT) do { unsigned a0 = cvtpk(P[BASE + 0], P[BASE + 1]), a1 = cvtpk(P[BASE + 2], P[BASE + 3]);   \
    unsigned b0 = cvtpk(P[BASE + 4], P[BASE + 5]), b1 = cvtpk(P[BASE + 6], P[BASE + 7]);                              \
    auto r0 = __builtin_amdgcn_permlane32_swap(a0, b0, false, false); auto r1 = __builtin_amdgcn_permlane32_swap(a1, b1, false, false); \
    u32x4 w = {r0[0], r1[0], r0[1], r1[1]}; OUT = *reinterpret_cast<bf16x8*>(&w); } while (0)
  PK4(p0, 0, pa0); PK4(p0, 8, pa1); PK4(p1, 0, pa2); PK4(p1, 8, pa3);
#undef PK4
}
__device__ __forceinline__ void qkt(f32x16& p0, f32x16& p1, const u16* Ks, const bf16x8* qr, int r32, int hi) {
  p0 = f32x16{}; p1 = f32x16{};
  for (int d0 = 0; d0 < 8; ++d0) { int cb = (d0 * 16 + hi * 8) * 2;
    bf16x8 b0 = *reinterpret_cast<const bf16x8*>((const char*)Ks + KSWZ(r32, cb));
    bf16x8 b1 = *reinterpret_cast<const bf16x8*>((const char*)Ks + KSWZ(32 + r32, cb));
    p0 = __builtin_amdgcn_mfma_f32_32x32x16_bf16(b0, qr[d0], p0, 0, 0, 0);
    p1 = __builtin_amdgcn_mfma_f32_32x32x16_bf16(b1, qr[d0], p1, 0, 0, 0); }
}
__device__ __forceinline__ int v_st(int k, int c) { const int kk = (k & ~0xC) | ((k & 4) << 1) | ((k & 8) >> 1); return ((kk >> 3) * 4 + (c >> 5)) * 512 + ((kk & 7) * 32 + (c & 31)) * 2; }
__device__ __forceinline__ int v_rd_base(int lane) { return ((lane & 3) << 3) | (((lane >> 2) & 3) << 6) | (((lane >> 4) & 1) << 5) | (((lane >> 5) & 1) << 8); }
constexpr int v_rd_off(int d0, int ks, int half) { return d0 * 512 + ks * 4096 + half * 2048; }
template <int OFF> __device__ __forceinline__ s16x4 tr_read(int vb) {
  s16x4 r; asm volatile("ds_read_b64_tr_b16 %0, %1 offset:%2" : "=&v"(r) : "v"(vb), "i"(OFF) : "memory"); return r;
}
template <int D0> __device__ __forceinline__ void pv_one(f32x16& od, int vb, bf16x8 pa0, bf16x8 pa1, bf16x8 pa2, bf16x8 pa3) {
  const s16x4 l0 = tr_read<v_rd_off(D0, 0, 0)>(vb), h0 = tr_read<v_rd_off(D0, 0, 1)>(vb), l1 = tr_read<v_rd_off(D0, 1, 0)>(vb), h1 = tr_read<v_rd_off(D0, 1, 1)>(vb);
  const s16x4 l2 = tr_read<v_rd_off(D0, 2, 0)>(vb), h2 = tr_read<v_rd_off(D0, 2, 1)>(vb), l3 = tr_read<v_rd_off(D0, 3, 0)>(vb), h3 = tr_read<v_rd_off(D0, 3, 1)>(vb);
  asm volatile("s_waitcnt lgkmcnt(0)" ::: "memory"); SBAR();
#define PK(L, H) (bf16x8){L[0], L[1], L[2], L[3], H[0], H[1], H[2], H[3]}
  od = __builtin_amdgcn_mfma_f32_32x32x16_bf16(pa0, PK(l0, h0), od, 0, 0, 0);
  od = __builtin_amdgcn_mfma_f32_32x32x16_bf16(pa1, PK(l1, h1), od, 0, 0, 0);
  od = __builtin_amdgcn_mfma_f32_32x32x16_bf16(pa2, PK(l2, h2), od, 0, 0, 0);
  od = __builtin_amdgcn_mfma_f32_32x32x16_bf16(pa3, PK(l3, h3), od, 0, 0, 0);
#undef PK
}
__device__ __forceinline__ void pv_d0(f32x16* o, int vb, bf16x8 pa0, bf16x8 pa1, bf16x8 pa2, bf16x8 pa3) {
  pv_one<0>(o[0], vb, pa0, pa1, pa2, pa3); pv_one<1>(o[1], vb, pa0, pa1, pa2, pa3); pv_one<2>(o[2], vb, pa0, pa1, pa2, pa3); pv_one<3>(o[3], vb, pa0, pa1, pa2, pa3);
}
__device__ __forceinline__ void attn_dense_body(const u16* Qb, const u16* __restrict__ Kh, const u16* __restrict__ Vh, u16* Ob, int seq, char* lds, const int tid) {
  const int wid = tid >> 6, lane = tid & 63, r32 = lane & 31, hi = lane >> 5;
  u16* V_lds = (u16*)lds; u16* K_lds = (u16*)(lds + 2 * SHM_V);
  float* ws = (float*)(lds + 2 * SHM_V + 2 * SHM_K) + wid * 64; float* li_l = ws; float* al_l = ws + 32;
  float m_reg = -1e30f, l_reg = 0; f32x16 o[4] = {}; bf16x8 qr[8];
  const u16* Qw = Qb + (long)(wid * QBLK + r32) * LDQ + hi * 8;
#pragma unroll
  for (int d0 = 0; d0 < 8; ++d0) qr[d0] = *reinterpret_cast<const bf16x8*>(Qw + d0 * 16);
  const int sr = tid >> 4, sc = (tid & 15) * 8, vst0 = v_st(sr, sc), vst1 = v_st(32 + sr, sc);
  const int vb0 = (int)(uintptr_t)V_lds + v_rd_base(lane);
  struct { bf16x8 vs0, vs1, ks0, ks1; } sr_[2];
  const unsigned goff0 = (unsigned)(sr * LDK + sc) * 2u, goff1 = goff0 + 32u * LDK * 2u;
#define SLOAD(i, k0) do { const char* vt_ = (const char*)Vh + (size_t)(k0) * (LDK * 2); const char* kt_ = (const char*)Kh + (size_t)(k0) * (LDK * 2); \
    sr_[i].vs0 = *reinterpret_cast<const bf16x8*>(vt_ + goff0); sr_[i].vs1 = *reinterpret_cast<const bf16x8*>(vt_ + goff1); \
    sr_[i].ks0 = *reinterpret_cast<const bf16x8*>(kt_ + goff0); sr_[i].ks1 = *reinterpret_cast<const bf16x8*>(kt_ + goff1); } while (0)
#define SWRITE(b, i) do { *(bf16x8*)((char*)V_lds + (b) * SHM_V + vst0) = sr_[i].vs0;          \
    *(bf16x8*)((char*)V_lds + (b) * SHM_V + vst1) = sr_[i].vs1; int kc = sc * 2;               \
    *(bf16x8*)((char*)K_lds + (b) * SHM_K + KSWZ(sr, kc)) = sr_[i].ks0;                       \
    *(bf16x8*)((char*)K_lds + (b) * SHM_K + KSWZ(32 + sr, kc)) = sr_[i].ks1; } while (0)
#define SWAIT() asm volatile("s_waitcnt vmcnt(4)" ::: "memory")
#define RESC(a) do { if (__any((a) < 1.f)) { if (hi == 0) al_l[r32] = (a); asm volatile("s_waitcnt lgkmcnt(0)" ::: "memory"); \
    for (int d = 0; d < 4; ++d) for (int r = 0; r < 16; ++r) o[d][r] *= al_l[crow(r, hi)]; } } while (0)
  f32x16 pA0, pA1, pB0, pB1; float mnA, mnB, alA, alB; bf16x8 pa0, pa1, pa2, pa3; const int NT = seq / KVBLK;
  constexpr int SE = 0, SO = 1;
  SLOAD(SE, 0); asm volatile("s_waitcnt vmcnt(0)" ::: "memory"); SWRITE(0, SE); __syncthreads();
  qkt(pA0, pA1, K_lds, qr, r32, hi); partialSM(pA0, pA1, m_reg, mnA, alA);
  SLOAD(SO, KVBLK); if (2 < NT) SLOAD(SE, 2 * KVBLK);
  SWAIT(); SWRITE(1, SO); __syncthreads();
  for (int j = 1; j + 1 < NT; j += 2) {
    SBAR(); qkt(pB0, pB1, (u16*)((char*)K_lds + SHM_K), qr, r32, hi);
    finishSM(pA0, pA1, alA, l_reg, pa0, pa1, pa2, pa3); SBAR();
    SLOAD(SO, (j + 2) * KVBLK); SBAR();
    pv_d0(o, vb0, pa0, pa1, pa2, pa3); partialSM(pB0, pB1, m_reg, mnB, alB);
    __syncthreads(); SWAIT(); SWRITE(0, SE);
    RESC(alB); __syncthreads();
    SBAR(); qkt(pA0, pA1, K_lds, qr, r32, hi);
    finishSM(pB0, pB1, alB, l_reg, pa0, pa1, pa2, pa3); SBAR();
    if (j + 3 < NT) SLOAD(SE, (j + 3) * KVBLK); SBAR();
    pv_d0(o, vb0 + (int)SHM_V, pa0, pa1, pa2, pa3); partialSM(pA0, pA1, m_reg, mnA, alA);
    __syncthreads(); SWAIT(); SWRITE(1, SO);
    RESC(alA); __syncthreads();
  }
  SBAR(); qkt(pB0, pB1, (u16*)((char*)K_lds + SHM_K), qr, r32, hi);
  finishSM(pA0, pA1, alA, l_reg, pa0, pa1, pa2, pa3); SBAR();
  pv_d0(o, vb0, pa0, pa1, pa2, pa3); partialSM(pB0, pB1, m_reg, mnB, alB);
  __syncthreads(); RESC(alB);
  finishSM(pB0, pB1, alB, l_reg, pa0, pa1, pa2, pa3); SBAR();
  pv_d0(o, vb0 + (int)SHM_V, pa0, pa1, pa2, pa3);
  if (hi == 0) li_l[r32] = l_reg; asm volatile("s_waitcnt lgkmcnt(0)" ::: "memory");
  float rli[16];
#pragma unroll
  for (int r = 0; r < 16; ++r) rli[r] = __builtin_amdgcn_rcpf(li_l[crow(r, hi)]);
  u16* Ow = Ob + (long)(wid * QBLK) * LDO;
#pragma unroll
  for (int r = 0; r < 16; ++r) { int orow = crow(r, hi);
    for (int d0 = 0; d0 < 4; ++d0) Ow[(long)orow * LDO + d0 * 32 + r32] = (u16)f2bf(o[d0][r] * rli[r]); }
#undef SLOAD
#undef SWRITE
#undef SWAIT
#undef RESC
}
}

struct Params { const float* in[23]; float* out; unsigned char* ws; int ph_lo, ph_hi; };
static_assert(sizeof(Params) == 23 * 8 + 8 + 8 + 8, "no padding in Params");

struct Ctx {
    int tid, lane, wid, G, gw, NGW;
    unsigned char* smem;
};

template <int MODE>
__device__ __forceinline__ void transpose_job(const Ctx& C, const float* W, int K, int N, u16* WT) {
    float* scr = (float*)(C.smem + C.wid * 16384);
    const int nblk = N / 32, nitems = (K / 64) * nblk, lane = C.lane;
    for (int item = C.gw; item < nitems; item += C.NGW) {
        const int kb = item / nblk, nb = item % nblk, k0 = 64 * kb, n0 = 32 * nb;
#pragma unroll 8
        for (int i = 0; i < 32; ++i) { const int kk = 2 * i + (lane >> 5); scr[kk * 33 + (lane & 31)] = W[(size_t)(k0 + kk) * N + n0 + (lane & 31)]; }
        asm volatile("s_waitcnt lgkmcnt(0)" ::: "memory");
        const int c = lane & 7;
#pragma unroll
        for (int j = 0; j < 4; ++j) { const int n = (lane >> 3) + 8 * j; const float* s = scr + (8 * c) * 33 + n;
            u32x4 o; o.x = pk2(s[0 * 33], s[1 * 33]); o.y = pk2(s[2 * 33], s[3 * 33]); o.z = pk2(s[4 * 33], s[5 * 33]); o.w = pk2(s[6 * 33], s[7 * 33]);
            int row = n0 + n;
            if (MODE == 1) { const int b = row / FFH, jj = row % FFH; row = (jj / 128) * 256 + b * 128 + (jj % 128); }
            *(u32x4*)(WT + (size_t)row * K + k0 + 8 * c) = o; }
        asm volatile("s_waitcnt lgkmcnt(0)" ::: "memory");
    }
}
__device__ __forceinline__ void fold_fourier_job(const Ctx& C, const float* Wf, u16* Bt) {
    f32x2* tab = (f32x2*)(C.smem + 131072);
    __syncthreads();
    if (C.tid < 128) { float s, c; sincospif(2.0f * (float)C.tid / 128.0f, &s, &c); tab[C.tid] = (f32x2){c, s}; }
    __syncthreads();
    const int gt = blockIdx.x * 512 + C.tid, NT_ = C.G * 512;
    for (int id = gt; id < 131072; id += NT_) {
        const int n = id & 1023, combo = id >> 10, c8 = combo & 15, ro = (combo >> 4) & 1, g = combo >> 5;
        float a[8] = {0.f, 0.f, 0.f, 0.f, 0.f, 0.f, 0.f, 0.f};
        const float* wp = Wf + (size_t)(g * 128) * 1024 + n;
        for (int k2 = 0; k2 < 128; ++k2) { const float w = wp[(size_t)k2 * 1024];
#pragma unroll
            for (int e = 0; e < 8; ++e) { const f32x2 cs = tab[(k2 * (c8 * 8 + e)) & 127]; a[e] += (ro ? cs.y : cs.x) * w; } }
        const float sc = 0.08838834764831845f;
        u32x4 o; o.x = pk2(a[0] * sc, a[1] * sc); o.y = pk2(a[2] * sc, a[3] * sc); o.z = pk2(a[4] * sc, a[5] * sc); o.w = pk2(a[6] * sc, a[7] * sc);
        *(u32x4*)(Bt + (size_t)n * 1024 + ro * 512 + g * 128 + c8 * 8) = o;
    }
}

__device__ __forceinline__ void ln_norm(f32x4 (&v)[4]) {
    float s = 0.f;
#pragma unroll
    for (int j = 0; j < 4; ++j) s += (v[j][0] + v[j][1]) + (v[j][2] + v[j][3]);
    const float mean = wave_sum(s) * (1.f / D); float s2 = 0.f;
#pragma unroll
    for (int j = 0; j < 4; ++j) { v[j] = v[j] - mean; s2 += (v[j][0] * v[j][0] + v[j][1] * v[j][1]) + (v[j][2] * v[j][2] + v[j][3] * v[j][3]); }
    const float rstd = 1.0f / sqrtf(wave_sum(s2) * (1.f / D) + LN_EPS);
#pragma unroll
    for (int j = 0; j < 4; ++j) v[j] = v[j] * rstd;
}
__device__ __forceinline__ void ln_pass(const Ctx& C, int nrows, const float* src_lat, const float* src_ctx, float* dst_lat, float* dst_ctx,
                                        const float* lg, const float* lb, bool do_h, const float* mod_lat, const float* mod_ctx, int shift_off, int scale_off, u16* H) {
    for (int m = C.gw; m < nrows; m += C.NGW) {
        const bool isc = m >= T;
        const float* sp = isc ? src_ctx + (size_t)(m - T) * D : src_lat + (size_t)m * D;
        f32x4 v[4];
#pragma unroll
        for (int j = 0; j < 4; ++j) v[j] = *(const f32x4*)(sp + 4 * C.lane + 256 * j);
        if (lg) {
            ln_norm(v);
            float* dp = isc ? dst_ctx + (size_t)(m - T) * D : dst_lat + (size_t)m * D;
#pragma unroll
            for (int j = 0; j < 4; ++j) { const f32x4 g4 = *(const f32x4*)(lg + 4 * C.lane + 256 * j), b4 = *(const f32x4*)(lb + 4 * C.lane + 256 * j);
                v[j] = v[j] * g4 + b4; *(f32x4*)(dp + 4 * C.lane + 256 * j) = v[j]; }
        }
        if (do_h) {
            ln_norm(v);
            const float* md = isc ? mod_ctx : mod_lat;
            u32x2* hp = (u32x2*)(H + (size_t)m * D) + C.lane;
#pragma unroll
            for (int j = 0; j < 4; ++j) { const f32x4 sh = *(const f32x4*)(md + shift_off + 4 * C.lane + 256 * j), sc = *(const f32x4*)(md + scale_off + 4 * C.lane + 256 * j);
                const f32x4 h = v[j] * (sc + 1.0f) + sh; u32x2 w; w.x = pk2(h[0], h[1]); w.y = pk2(h[2], h[3]); hp[64 * j] = w; }
        }
    }
}

template <int K>
__device__ __forceinline__ void load_B_transposed(const Ctx& C, const u16* B, size_t ldb) {
    constexpr int KP = K + 8;
    unsigned* sB32 = (unsigned*)C.smem;
    for (int ch = C.tid; ch < (K / 2) * 16; ch += 512) {
        const int n8 = ch & 15, kp = ch >> 4;
        const u32x4 r0 = *(const u32x4*)(B + (size_t)(2 * kp) * ldb + n8 * 8), r1 = *(const u32x4*)(B + (size_t)(2 * kp + 1) * ldb + n8 * 8);
        const unsigned a[4] = {r0.x, r0.y, r0.z, r0.w}, b[4] = {r1.x, r1.y, r1.z, r1.w};
#pragma unroll
        for (int e = 0; e < 4; ++e) { const int n = n8 * 8 + 2 * e;
            sB32[(n * KP) / 2 + kp] = (a[e] & 0xffffu) | (b[e] << 16);
            sB32[((n + 1) * KP) / 2 + kp] = (a[e] >> 16) | (b[e] & 0xffff0000u); }
    }
}
template <int K>
__device__ __forceinline__ void mma_256x128(const Ctx& C, const u16* A_re, const u16* A_im, f32x16 (&acc_re)[2], f32x16 (&acc_im)[2]) {
    constexpr int KP = K + 8;
    const int l32 = C.lane & 31, hi = C.lane >> 5, mb = C.wid & 3, nh = C.wid >> 2;
    const u16* are = A_re + (size_t)(32 * mb + l32) * K + 8 * hi; const u16* aim = A_im + (size_t)(32 * mb + l32) * K + 8 * hi;
    const u16* sB = (const u16*)C.smem;
    const u16* b0p = sB + (64 * nh + l32) * KP + 8 * hi; const u16* b1p = b0p + 32 * KP;
    acc_re[0] = f32x16{}; acc_re[1] = f32x16{}; acc_im[0] = f32x16{}; acc_im[1] = f32x16{};
#pragma unroll 4
    for (int k0 = 0; k0 < K; k0 += 16) {
        const bf16x8 ar = *(const bf16x8*)(are + k0), ai = *(const bf16x8*)(aim + k0);
        const bf16x8 b0 = *(const bf16x8*)(b0p + k0), b1 = *(const bf16x8*)(b1p + k0);
        acc_re[0] = __builtin_amdgcn_mfma_f32_32x32x16_bf16(ar, b0, acc_re[0], 0, 0, 0);
        acc_re[1] = __builtin_amdgcn_mfma_f32_32x32x16_bf16(ar, b1, acc_re[1], 0, 0, 0);
        acc_im[0] = __builtin_amdgcn_mfma_f32_32x32x16_bf16(ai, b0, acc_im[0], 0, 0, 0);
        acc_im[1] = __builtin_amdgcn_mfma_f32_32x32x16_bf16(ai, b1, acc_im[1], 0, 0, 0);
    }
}

typedef const Params __attribute__((address_space(4))) * KargP;
__global__ void __launch_bounds__(512, 2) fwd_megakernel(Params p_unused) {
    extern __shared__ __attribute__((aligned(16))) unsigned char smem[];
    cg::grid_group grid = cg::this_grid();
    int ph_lo, ph_hi;
    { KargP kp0 = (KargP)__builtin_amdgcn_kernarg_segment_ptr(); ph_lo = kp0->ph_lo; ph_hi = kp0->ph_hi; }
#define p (*KARG)
#define x_in    (p.in[0])
#define c_in    (p.in[1])
#define ctx_in  (p.in[2])
#define cctx_in (p.in[3])
#define w_ada   (p.in[4])
#define b_ada   (p.in[5])
#define w_in    (p.in[6])
#define q_gain  (p.in[7])
#define k_gain  (p.in[8])
#define sgu_g   (p.in[9])
#define sgu_b   (p.in[10])
#define w_sp    (p.in[11])
#define b_sp    (p.in[12])
#define w_bra   (p.in[13])
#define w_brs   (p.in[14])
#define w_brf   (p.in[15])
#define w_out   (p.in[16])
#define ln1_g   (p.in[17])
#define ln1_b   (p.in[18])
#define w_up    (p.in[19])
#define w_down  (p.in[20])
#define ln2_g   (p.in[21])
#define ln2_b   (p.in[22])
#define Hb   ((u16*)(ws + OFF_H))
#define Qb   ((u16*)(ws + OFF_Q))
#define Fb   ((u16*)(ws + OFF_F))
#define Kb   ((u16*)(ws + OFF_K))
#define Vb   ((u16*)(ws + OFF_V))
#define YCb  ((u16*)(ws + OFF_YC))
#define Sb   ((u16*)(ws + OFF_S))
#define Gb   ((u16*)(ws + OFF_G))
#define ACTb ((u16*)(ws + OFF_G))
#define WINt ((u16*)(ws + OFF_W1))
#define WUPt ((u16*)(ws + OFF_WUP))
#define WDNt ((u16*)(ws + OFF_WDN))
#define WBAt ((u16*)(ws + OFF_WBA))
#define WBSt ((u16*)(ws + OFF_WBS))
#define WBFt ((u16*)(ws + OFF_WBF))
#define WOt  ((u16*)(ws + OFF_WO))
#define XCTX ((float*)(ws + OFF_XCTX))
#define MODP ((float*)(ws + OFF_MODP))
#define MOD  ((float*)(ws + OFF_MOD))
#define MA   ((u16*)(ws + OFF_MA))
#define MB   ((u16*)(ws + OFF_MB))
#define MC   ((u16*)(ws + OFF_MC))
#define TW   ((f32x2*)(ws + OFF_TW))
#define ROPE ((f32x2*)(ws + OFF_ROPE))
#define WSP  ((u16*)(ws + OFF_WSP))
#define FCb  ((u16*)(ws + OFF_FC))
#define XLAT (p.out)
#define lds3 ((PG8_LAS unsigned char*)smem)

    int ph = 0;
#define PH_BEGIN if (ph >= ph_lo && ph < ph_hi) { KargP KARG = (KargP)__builtin_amdgcn_kernarg_segment_ptr(); asm volatile("" : "+s"(KARG)); unsigned char* ws = KARG->ws; \
    Ctx C; C.tid = threadIdx.x; asm volatile("" : "+v"(C.tid)); C.lane = C.tid & 63; C.wid = __builtin_amdgcn_readfirstlane(C.tid >> 6); C.G = gridDim.x; C.gw = blockIdx.x * 8 + C.wid; C.NGW = C.G * 8; C.smem = smem;
#define PH_END } if (ph >= ph_lo && ph + 1 < ph_hi) grid.sync(); ++ph;

    PH_BEGIN
    {
        float* sm = (float*)(smem + 131072);
        for (int it = blockIdx.x; it < 384; it += C.G) {
            const int l = it / 192, rem = it % 192, kp = rem / 12, nb = rem % 12;
            __syncthreads();
            if (C.tid < 128) { const int w = C.tid >> 6, kk = C.tid & 63; const float v = (w ? cctx_in : c_in)[kp * 64 + kk]; sm[C.tid] = v / (1.0f + expf(-v)); }
            __syncthreads();
            const int n = nb * 512 + C.tid; float a0 = 0.f, a1 = 0.f; const float* wp = w_ada + ((size_t)l * 1024 + kp * 64) * INW + n;
#pragma unroll 8
            for (int kk = 0; kk < 64; ++kk) { const float w = wp[(size_t)kk * INW]; a0 += sm[kk] * w; a1 += sm[64 + kk] * w; }
            MODP[(size_t)((l * 16 + kp) * 2 + 0) * INW + n] = a0; MODP[(size_t)((l * 16 + kp) * 2 + 1) * INW + n] = a1;
        }
        __syncthreads();
        const int gt = blockIdx.x * 512 + C.tid, NTH = C.G * 512;
        const float r128 = 0.08838834764831845f;
        for (int i = gt; i < 256 * 128; i += NTH) { const int m = i >> 7, t1 = i & 127, ka = m & 127, im = m >> 7; float s, c; sincospif(2.0f * (float)((ka * t1) & 127) / 128.0f, &s, &c); MA[i] = (u16)f2bf((im ? -s : c) * r128); }
        for (int i = gt; i < 256 * 256; i += NTH) { const int row = i >> 8, col = i & 255, ro = row >> 7, kb = row & 127, ri = col >> 7, t0 = col & 127; float s, c; sincospif(2.0f * (float)((kb * t0) & 127) / 128.0f, &s, &c);
            const float v = (ro == ri) ? c : (ro == 0 ? s : -s); MB[i] = (u16)f2bf(v * r128); }
        for (int i = gt; i < 512 * 256; i += NTH) { const int row = i >> 8, t = i & 255, ro = row >> 8, k1 = row & 255; float s, c; sincospif(2.0f * (float)((k1 * t) & 255) / 256.0f, &s, &c); MC[i] = (u16)f2bf((ro ? -s : c) * 0.0625f); }
        for (int i = gt; i < 128 * 128; i += NTH) { const int ka = i >> 7, t0 = i & 127; float s, c; sincospif(2.0f * (float)((ka * t0) & 16383) / 16384.0f, &s, &c); TW[i] = (f32x2){c, s}; }
        for (int i = gt; i < 256 * 32; i += NTH) { const int pos = i >> 5, j = i & 31; const float inv = exp2f(-(float)j * (13.287712379549449f / 32.0f)); const float ang = (float)pos * inv;
            const double rev = (double)ang * 0.15915494309189535; const double fr = rev - rint(rev); float s, c; sincospif((float)(2.0 * fr), &s, &c); ROPE[i] = (f32x2){c, s}; }
        for (int i = gt; i < NL * 8 * 128 * 128; i += NTH) WSP[i] = (u16)f2bf(w_sp[i]);
        transpose_job<0>(C, w_in, D, INW, WINt);
        transpose_job<0>(C, w_bra, D, D, WBAt);
        transpose_job<0>(C, w_brs, 512, D, WBSt);
        transpose_job<0>(C, w_out, D, D, WOt);
        fold_fourier_job(C, w_brf, WBFt);
    }
    PH_END
    PH_BEGIN
    {
        const int gt = blockIdx.x * 512 + C.tid, NTH = C.G * 512;
        for (int i = gt; i < NL * 2 * INW; i += NTH) { const int n = i % INW, lw = i / INW, l = lw >> 1, w = lw & 1; float a = b_ada[l * INW + n];
            for (int kp = 0; kp < 16; ++kp) a += MODP[(size_t)((l * 16 + kp) * 2 + w) * INW + n];
            MOD[i] = a; }
    }
    PH_END
    PH_BEGIN
    ln_pass(C, R, x_in, ctx_in, nullptr, nullptr, nullptr, nullptr, true, MOD, MOD + INW, 0, 1024, Hb);
    PH_END

#pragma unroll 1
    for (int l = 0; l < NL; ++l) {
        const bool lastl = (l == NL - 1);
#define modl (MOD + (size_t)(l * 2 + 0) * INW)
#define modc (MOD + (size_t)(l * 2 + 1) * INW)
#define xin_lat ((l == 0) ? x_in : (const float*)XLAT)
#define xin_ctx ((l == 0) ? ctx_in : (const float*)XCTX)

        PH_BEGIN
        {
            pg8::Gemm g{Hb, WINt, D, D, D}; pg8::OrderX S; S.init(INW, C.G, (int)blockIdx.x, lastl ? 2 : 24, lastl ? 4 : 0);
            pg8::EpiIn E{Qb, Kb, Vb, Sb, Fb, FCb, Gb};
            pg8::gemm_phase<pg8::EpiIn, pg8::OrderX>(lds3, g, S, E, C.tid);
        }
        PH_END
        PH_BEGIN
        {
            for (int it = C.gw; it < R * 10; it += C.NGW) {
                const int m = it / 10, hh = it % 10;
                if (m >= T && lastl && hh < 8) continue;
                u16* pp = hh < 8 ? Qb + (size_t)m * 1024 + hh * 128 : Kb + (size_t)m * 256 + (hh - 8) * 128;
                const float* gain = (hh < 8 ? q_gain : k_gain) + l * 128;
                const unsigned w = ((const unsigned*)pp)[C.lane];
                float x0 = bflo(w), x1 = bfhi(w);
                const float ss = wave_sum(x0 * x0 + x1 * x1);
                const float rs = 1.0f / sqrtf(ss * (1.0f / 128.0f) + RMS_EPS);
                x0 *= rs * gain[2 * C.lane]; x1 *= rs * gain[2 * C.lane + 1];
                if (m < T) { const int pos = C.lane < 32 ? (m >> 6) : (m & 63); const f32x2 cs = ROPE[pos * 32 + (C.lane & 31)];
                    const float y0 = x0 * cs.x - x1 * cs.y, y1 = x0 * cs.y + x1 * cs.x; x0 = y0; x1 = y1; }
                ((unsigned*)pp)[C.lane] = pk2(x0, x1);
            }
            {
                const int nchunks = lastl ? 128 : 130;
                float* smean = (float*)(smem + 65536); float* srstd = smean + 128;
                unsigned* sB32 = (unsigned*)smem; constexpr int KP = 136;
                const int l32 = C.lane & 31, hi = C.lane >> 5, mb = C.wid & 3, nb = C.wid >> 2;
                for (int it = blockIdx.x; it < nchunks * 8; it += C.G) {
                    const int ch = it >> 3, g = it & 7, R0 = ch * 128;
                    __syncthreads();
                    { const int q = C.tid >> 2, part = C.tid & 3; const u16* vr = Sb + (size_t)(R0 + q) * 1024 + 512 + part * 128; float s = 0.f, s2 = 0.f;
#pragma unroll 4
                      for (int j = 0; j < 16; ++j) { const u32x4 w = *(const u32x4*)(vr + j * 8); const unsigned ww[4] = {w.x, w.y, w.z, w.w};
#pragma unroll
                          for (int e = 0; e < 4; ++e) { const float a = bflo(ww[e]), b = bfhi(ww[e]); s += a + b; s2 += a * a + b * b; } }
                      s += __shfl_xor(s, 1); s += __shfl_xor(s, 2); s2 += __shfl_xor(s2, 1); s2 += __shfl_xor(s2, 2);
                      const float mean = s * (1.0f / 512.0f); const float var = fmaxf(s2 * (1.0f / 512.0f) - mean * mean, 0.f);
                      if (part == 0) { smean[q] = mean; srstd[q] = 1.0f / sqrtf(var + LN_EPS); } }
                    __syncthreads();
                    { const int qp = C.tid >> 3, c8 = C.tid & 7; const int cb = g * 64 + c8 * 8;
                      const u32x4 r0 = *(const u32x4*)(Sb + (size_t)(R0 + 2 * qp) * 1024 + 512 + cb), r1 = *(const u32x4*)(Sb + (size_t)(R0 + 2 * qp + 1) * 1024 + 512 + cb);
                      const float m0 = smean[2 * qp], s0 = srstd[2 * qp], m1 = smean[2 * qp + 1], s1 = srstd[2 * qp + 1];
                      const unsigned a[4] = {r0.x, r0.y, r0.z, r0.w}, b[4] = {r1.x, r1.y, r1.z, r1.w};
#pragma unroll
                      for (int e = 0; e < 4; ++e) { const int c = c8 * 8 + 2 * e; const float g0 = sgu_g[l * 512 + g * 64 + c], g1 = sgu_g[l * 512 + g * 64 + c + 1], bb0 = sgu_b[l * 512 + g * 64 + c], bb1 = sgu_b[l * 512 + g * 64 + c + 1];
                          const float v00 = (bflo(a[e]) - m0) * s0 * g0 + bb0, v01 = (bfhi(a[e]) - m0) * s0 * g1 + bb1;
                          const float v10 = (bflo(b[e]) - m1) * s1 * g0 + bb0, v11 = (bfhi(b[e]) - m1) * s1 * g1 + bb1;
                          sB32[(c * KP) / 2 + qp] = pk2(v00, v10); sB32[((c + 1) * KP) / 2 + qp] = pk2(v01, v11); } }
                    __syncthreads();
                    { const u16* arow = WSP + ((size_t)(l * 8 + g) * 128 + 32 * mb + l32) * 128 + 8 * hi; const u16* bp = (const u16*)smem + (32 * nb + l32) * KP + 8 * hi;
                      f32x16 acc = f32x16{};
#pragma unroll
                      for (int k0 = 0; k0 < 128; k0 += 16) acc = __builtin_amdgcn_mfma_f32_32x32x16_bf16(*(const bf16x8*)(arow + k0), *(const bf16x8*)(bp + k0), acc, 0, 0, 0);
                      const int cc = g * 64 + 32 * nb + l32;
#pragma unroll
                      for (int r = 0; r < 16; ++r) { const int pr = 32 * mb + crow(r, hi); const float mixed = acc[r] + b_sp[(l * 8 + g) * 128 + pr];
                          u16* up = Sb + (size_t)(R0 + pr) * 1024 + cc; *up = (u16)f2bf(bf2f(*up) * mixed); } }
                }
                __syncthreads();
            }
            for (int it = blockIdx.x; it < 512; it += C.G) {
                const int n0 = it * 128, t0 = it >> 2;
                __syncthreads();
                load_B_transposed<128>(C, Fb + n0, 65536);
                __syncthreads();
                f32x16 are[2], aim[2];
                mma_256x128<128>(C, MA, MA + 128 * 128, are, aim);
                const int l32 = C.lane & 31, hi = C.lane >> 5, mb = C.wid & 3, nh = C.wid >> 2;
#pragma unroll
                for (int s = 0; s < 2; ++s)
#pragma unroll
                    for (int r = 0; r < 16; ++r) { const int ka = 32 * mb + crow(r, hi); const f32x2 tw = TW[ka * 128 + t0];
                        const float hr = are[s][r], hm = aim[s][r]; const float orr = hr * tw.x + hm * tw.y, oi = hm * tw.x - hr * tw.y;
                        const size_t o = (size_t)ka * 131072 + n0 + 64 * nh + 32 * s + l32;
                        Hb[o] = (u16)f2bf(orr); Hb[o + 65536] = (u16)f2bf(oi); }
            }
            __syncthreads();
            transpose_job<1>(C, w_up + (size_t)l * D * 2 * FFH, D, 2 * FFH, WUPt);
            transpose_job<0>(C, w_down + (size_t)l * FFH * D, FFH, D, WDNt);
        }
        PH_END
        PH_BEGIN
        {
            const int nunits = lastl ? 512 : 520;
            for (int L = blockIdx.x; L < nunits; L += C.G) {
                __syncthreads();
                if (L < 512) { const int h = L >> 6, qb = L & 63, kvh = h >> 2;
                    att::attn_dense_body(Qb + (size_t)(qb * 256) * 1024 + h * 128, Kb + kvh * 128, Vb + kvh * 128, Qb + (size_t)(qb * 256) * 1024 + h * 128, R, (char*)smem, C.tid); }
                else { const int h = L - 512, kvh = h >> 2;
                    att::attn_dense_body(Qb + (size_t)T * 1024 + h * 128, Kb + (size_t)T * 256 + kvh * 128, Vb + (size_t)T * 256 + kvh * 128, Qb + (size_t)T * 1024 + h * 128, CTX, (char*)smem, C.tid); }
            }
            __syncthreads();
        }
        PH_END
        PH_BEGIN
        {
            const int nitems = lastl ? 512 : 520;
            for (int it = blockIdx.x; it < nitems; it += C.G) {
                const u16 *Are, *Aim, *Bp; int rowbase, rowstride, nt;
                if (it < 512) { const int ka = it >> 2; nt = it & 3; Are = MB; Aim = MB + 128 * 256; Bp = Hb + (size_t)ka * 131072 + nt * 128; rowbase = ka; rowstride = 128; }
                else { const int hs = (it - 512) >> 2; nt = it & 3; Are = MC + (size_t)(128 * hs) * 256; Aim = MC + (size_t)(256 + 128 * hs) * 256; Bp = FCb + nt * 128; rowbase = T + 128 * hs; rowstride = 1; }
                __syncthreads();
                load_B_transposed<256>(C, Bp, 512);
                __syncthreads();
                f32x16 are[2], aim[2];
                mma_256x128<256>(C, Are, Aim, are, aim);
                const int l32 = C.lane & 31, hi = C.lane >> 5, mb = C.wid & 3, nh = C.wid >> 2;
#pragma unroll
                for (int s = 0; s < 2; ++s)
#pragma unroll
                    for (int r = 0; r < 16; ++r) { const int kb = 32 * mb + crow(r, hi); const size_t o = (size_t)(rowbase + rowstride * kb) * 1024 + nt * 128 + 64 * nh + 32 * s + l32;
                        YCb[o] = (u16)f2bf(are[s][r]); YCb[o + 512] = (u16)f2bf(aim[s][r]); }
            }
            __syncthreads();
        }
        PH_END
        PH_BEGIN
        {
#pragma unroll 1
            for (int b = 0; b < 3; ++b) {
                pg8::Gemm g{b == 0 ? Qb : (b == 1 ? Sb : YCb), b == 0 ? WBAt : (b == 1 ? WBSt : WBFt), b == 1 ? 512 : 1024, 1024, b == 1 ? 512 : 1024};
                pg8::OrderX S; S.init(D, C.G, (int)blockIdx.x, lastl ? 0 : 4, 0);
                pg8::EpiBr E{Gb + b * 1024, Hb, b == 0};
                pg8::gemm_phase<pg8::EpiBr, pg8::OrderX>(lds3, g, S, E, C.tid);
            }
        }
        PH_END
        PH_BEGIN
        {
            pg8::Gemm g{Hb, WOt, D, D, D}; pg8::OrderX S; S.init(D, C.G, (int)blockIdx.x, lastl ? 0 : 4, 0);
            pg8::EpiRes E{xin_lat, xin_ctx, XLAT, XCTX, modl + 2 * 1024, modc + 2 * 1024};
            pg8::gemm_phase<pg8::EpiRes, pg8::OrderX>(lds3, g, S, E, C.tid);
        }
        PH_END
        PH_BEGIN
        ln_pass(C, lastl ? T : R, XLAT, XCTX, XLAT, XCTX, ln1_g + l * D, ln1_b + l * D, true, modl, modc, 3 * 1024, 4 * 1024, Hb);
        PH_END
        PH_BEGIN
        {
            pg8::Gemm g{Hb, WUPt, D, D, D}; pg8::OrderX S; S.init(2 * FFH, C.G, (int)blockIdx.x, lastl ? 0 : 22, 0);
            pg8::EpiUp E{ACTb};
            pg8::gemm_phase<pg8::EpiUp, pg8::OrderX>(lds3, g, S, E, C.tid);
        }
        PH_END
        PH_BEGIN
        {
            pg8::Gemm g{ACTb, WDNt, FFH, FFH, FFH}; pg8::OrderX S; S.init(D, C.G, (int)blockIdx.x, lastl ? 0 : 4, 0);
            pg8::EpiRes E{XLAT, XCTX, XLAT, XCTX, modl + 5 * 1024, modc + 5 * 1024};
            pg8::gemm_phase<pg8::EpiRes, pg8::OrderX>(lds3, g, S, E, C.tid);
        }
        PH_END
        PH_BEGIN
        {
            ln_pass(C, lastl ? T : R, XLAT, XCTX, XLAT, XCTX, ln2_g + l * D, ln2_b + l * D, !lastl, modl + 2 * INW, modc + 2 * INW, 0, 1024, Hb);
            if (!lastl) {
                __syncthreads();
                transpose_job<0>(C, w_in + (size_t)(l + 1) * D * INW, D, INW, WINt);
                transpose_job<0>(C, w_bra + (size_t)(l + 1) * D * D, D, D, WBAt);
                transpose_job<0>(C, w_brs + (size_t)(l + 1) * 512 * D, 512, D, WBSt);
                transpose_job<0>(C, w_out + (size_t)(l + 1) * D * D, D, D, WOt);
                fold_fourier_job(C, w_brf + (size_t)(l + 1) * 512 * D, WBFt);
            }
        }
        PH_END
    }
#undef PH_BEGIN
#undef PH_END
#undef p
}

extern "C" void kernel_launch(void* const* d_in, const int* in_sizes, int n_in, void* d_out, int out_size, void* d_ws, size_t ws_size, hipStream_t stream) {
    static int grid = 0;
    if (grid == 0) {
        if (n_in != 23 || out_size != T * D || ws_size < WS_END) { fprintf(stderr, "kernel_launch: unexpected shapes (n_in %d out %d ws %zu need %zu)\n", n_in, out_size, ws_size, (size_t)WS_END); grid = -1; return; }
        int dev = 0, cus = 0, per_cu = 0;
        hipGetDevice(&dev); hipDeviceGetAttribute(&cus, hipDeviceAttributeMultiprocessorCount, dev);
        if (hipFuncSetAttribute((const void*)fwd_megakernel, hipFuncAttributeMaxDynamicSharedMemorySize, LDS_BYTES) != hipSuccess) { fprintf(stderr, "kernel_launch: hipFuncSetAttribute failed\n"); grid = -1; return; }
        if (hipOccupancyMaxActiveBlocksPerMultiprocessor(&per_cu, (const void*)fwd_megakernel, 512, LDS_BYTES) != hipSuccess || per_cu < 1) { fprintf(stderr, "kernel_launch: occupancy query says %d\n", per_cu); per_cu = 1; }
        (void)hipGetLastError();
        grid = cus * 1;
        fprintf(stderr, "kernel_launch: cus %d per_cu %d grid %d\n", cus, per_cu, grid);
    }
    if (grid < 0) return;
    Params p{};
    for (int i = 0; i < 23; ++i) p.in[i] = (const float*)d_in[i];
    p.out = (float*)d_out; p.ws = (unsigned char*)d_ws; p.ph_lo = 0; p.ph_hi = 1000;
    void* args[] = {&p};
    hipError_t e = hipLaunchCooperativeKernel((const void*)fwd_megakernel, dim3(grid), dim3(512), args, LDS_BYTES, stream);
    if (e != hipSuccess) fprintf(stderr, "kernel_launch: cooperative launch failed: %s (grid %d)\n", hipGetErrorString(e), grid);
}
```

```cpp
#include <hip/hip_runtime.h>
#include <hip/hip_bf16.h>
#include <hip/hip_cooperative_groups.h>
#include <cstdio>
#include <cstdint>
namespace cg = cooperative_groups;

constexpr int T = 16384, CTX = 256, R = T + CTX, D = 1024, INW = 6144, FFH = 2816, NL = 2;
constexpr float ALPHA = 1.4142135623730951f;
constexpr float LN_EPS = 1e-6f, RMS_EPS = 1e-6f;

typedef unsigned short u16;
typedef short bf16x8 __attribute__((ext_vector_type(8)));
typedef short s16x4 __attribute__((ext_vector_type(4)));
typedef float f32x4 __attribute__((ext_vector_type(4)));
typedef float f32x2 __attribute__((ext_vector_type(2)));
typedef float f32x16 __attribute__((ext_vector_type(16)));
typedef unsigned u32x4 __attribute__((ext_vector_type(4)));
typedef unsigned u32x2 __attribute__((ext_vector_type(2)));
#define LAS __attribute__((address_space(3)))

constexpr size_t SZ_RD = (size_t)R * D * 2;
constexpr size_t OFF_H = 0;
constexpr size_t OFF_Q = OFF_H + SZ_RD;
constexpr size_t OFF_F = OFF_Q + SZ_RD;
constexpr size_t OFF_K = OFF_F + (size_t)R * 512 * 2;
constexpr size_t OFF_V = OFF_K + (size_t)R * 256 * 2;
constexpr size_t OFF_YC = OFF_F;
constexpr size_t OFF_S = OFF_F + SZ_RD;
constexpr size_t OFF_G = OFF_S + SZ_RD;
constexpr size_t OFF_W1 = OFF_G + (size_t)R * 3072 * 2;
constexpr size_t SZ_W1 = (size_t)5632 * 1024 * 2 + (size_t)1024 * 2816 * 2;
constexpr size_t OFF_WUP = OFF_W1, OFF_WDN = OFF_W1 + (size_t)5632 * 1024 * 2;
constexpr size_t OFF_WBA = OFF_W1 + SZ_W1;
constexpr size_t OFF_WBS = OFF_WBA + 2097152;
constexpr size_t OFF_WBF = OFF_WBS + 1048576;
constexpr size_t OFF_WO = OFF_WBF + 2097152;
constexpr size_t OFF_XCTX = OFF_WO + 2097152;
constexpr size_t OFF_MODP = OFF_XCTX + 1048576;
constexpr size_t OFF_MOD = OFF_MODP + 1572864;
constexpr size_t OFF_MA = OFF_MOD + 98304;
constexpr size_t OFF_MB = OFF_MA + 65536;
constexpr size_t OFF_MC = OFF_MB + 131072;
constexpr size_t OFF_TW = OFF_MC + 262144;
constexpr size_t OFF_ROPE = OFF_TW + 131072;
constexpr size_t OFF_WSP = OFF_ROPE + 65536;
constexpr size_t OFF_FC = OFF_WSP + 524288;
constexpr size_t OFF_BAR = OFF_FC + 262144;
constexpr size_t BAR_BYTES = 16384;
constexpr size_t OFF_PROBE = OFF_BAR + BAR_BYTES;
constexpr size_t OFF_ST1 = OFF_PROBE + 256;
constexpr size_t OFF_ST2 = OFF_ST1 + (size_t)R * 8;
constexpr size_t WS_END = OFF_ST2 + (size_t)R * 8;
static_assert(WS_END <= 268435456ull, "workspace map exceeds 256 MiB");
static_assert(SZ_W1 >= (size_t)INW * D * 2, "w_in_t fits the shared weight region");

constexpr int LDS_BYTES = 131072 + 2048;

typedef __bf16 bf16x2_t __attribute__((ext_vector_type(2)));
__device__ __forceinline__ unsigned f2bf(float f) { const __bf16 b = (__bf16)f; return (unsigned)__builtin_bit_cast(unsigned short, b); }
__device__ __forceinline__ unsigned pk2(float lo, float hi) { const f32x2 v = {lo, hi}; const bf16x2_t b = __builtin_convertvector(v, bf16x2_t); return __builtin_bit_cast(unsigned, b); }
__device__ __forceinline__ float bflo(unsigned w) { return __builtin_bit_cast(float, w << 16); }
__device__ __forceinline__ float bfhi(unsigned w) { return __builtin_bit_cast(float, w & 0xffff0000u); }
__device__ __forceinline__ float bf2f(u16 b) { return __builtin_bit_cast(float, ((unsigned)b) << 16); }
__device__ __forceinline__ float wave_sum(float v) {
#pragma unroll
    for (int o = 1; o < 64; o <<= 1) v += __shfl_xor(v, o);
    return v;
}
__device__ __forceinline__ float fsigmoid(float x) { return __builtin_amdgcn_rcpf(1.0f + __builtin_amdgcn_exp2f(-1.4426950408889634f * x)); }
__device__ __forceinline__ float fgelu_tanh(float x) { const float y2 = 1.5957691216057308f * (x + 0.044715f * x * x * x); return x * fsigmoid(y2); }
__device__ __forceinline__ int crow(int r, int hi) { return (r & 3) + 8 * (r >> 2) + 4 * hi; }

namespace pg8 {
#define PG8_LAS __attribute__((address_space(3)))
typedef unsigned short bf16_t;
constexpr int BM = 256, BK = 64, HALF = 128, HTB = HALF * BK * 2, STAGE_BYTES = 8 * HTB, NXCD = 8, WGM = 8;
__host__ __device__ __forceinline__ int lds_byte(int r, int c) { const int st = (r >> 4) * 2 + (c >> 5), rr = r & 15, cc = c & 31, ob = rr * 64 + cc * 2; return st * 1024 + (ob ^ (((ob >> 9) & 1) << 5)); }
__host__ __device__ __forceinline__ void stage_rc(int b, int& Rr, int& C) { const int st = b / 1024, sb = b % 1024, swz = sb ^ (((sb >> 9) & 1) << 5); Rr = (st >> 1) * 16 + swz / 64; C = (st & 1) * 32 + (swz % 64) / 2; }
__host__ __device__ __forceinline__ int perm32(int rho) { const int n = rho >> 4, i = rho & 15; return 8 * (i >> 2) + 4 * n + (i & 3); }
struct Unit { int pm, pn, b; };
struct Gemm { const bf16_t* A; const bf16_t* Bt; int K, lda, ldb;
              const bf16_t* A1; const bf16_t* Bt1; int K1; const bf16_t* A2; const bf16_t* Bt2; int K2; };
struct StaticOrder {
    int nM, nN, nwg, G, c;
    __device__ void init(int M, int N, int G_, int c_) { nM = M / BM; nN = N / BM; nwg = nM * nN; G = G_; c = c_; }
    __device__ bool next(int i, Unit& u) const {
        const long L = (long)i * G + c; if (L >= nwg) return false;
        int wgid = (int)L; { const int q = nwg / NXCD, r = nwg % NXCD, xcd = wgid % NXCD, off = wgid / NXCD; wgid = (xcd < r ? xcd * (q + 1) : r * (q + 1) + (xcd - r) * q) + off; }
        const int nig = WGM * nN, gid = wgid / nig, fm = gid * WGM, gsz = (nM - fm) < WGM ? (nM - fm) : WGM;
        u.pm = fm + ((wgid % nig) % gsz); u.pn = (wgid % nig) / gsz; u.b = 0; return true;
    }
};
struct OrderX {
    StaticOrder so; int nextra, pn0;
    __device__ void init(int N, int G_, int c_, int nextra_, int pn0_) { so.init(T, N, G_, c_); nextra = nextra_; pn0 = pn0_; }
    __device__ bool next(int i, Unit& u) const {
        const long L = (long)i * so.G + so.c;
        if (L < so.nwg) return so.next(i, u);
        const int e = (int)(L - so.nwg); if (e >= nextra) return false;
        u.pm = 64; u.pn = pn0 + e; u.b = 0; return true;
    }
    __device__ __forceinline__ void a_ready(const Unit&) const {}
    __device__ __forceinline__ void done(const Unit&) const {}
};

struct OrderBr {
    StaticOrder so;
    __device__ void init(int N, int G_, int c_) { so.init(T, N, G_, c_); }
    __device__ bool next(int i, Unit& u) const { const int q = i / 3; if (!so.next(q, u)) return false; u.b = i - 3 * q; return true; }
    __device__ __forceinline__ void a_ready(const Unit&) const {}
    __device__ __forceinline__ void done(const Unit&) const {}
};

template <class Epi, class Sched, bool ALIGN_EPI = true, bool SP2 = true>
__device__ __forceinline__ void gemm_phase(PG8_LAS unsigned char* lds, const Gemm g, const Sched& S, const Epi& E, const int tid) {
    const int wid = __builtin_amdgcn_readfirstlane(tid >> 6), lane = tid & 63, wr = wid >> 2, wc = wid & 3, fr = lane & 15, fq = lane >> 4;
#define PG8_UA(u) ((const char*)((u).b == 0 ? g.A : ((u).b == 1 ? g.A1 : g.A2)))
#define PG8_UB(u) ((const char*)((u).b == 0 ? g.Bt : ((u).b == 1 ? g.Bt1 : g.Bt2)))
#define PG8_UNT(u) (((u).b == 0 ? g.K : ((u).b == 1 ? g.K1 : g.K2)) / BK)
    unsigned voffA[2], voffB[2];
#pragma unroll
    for (int i = 0; i < 2; ++i) { int Rr, C; stage_rc(tid * 16 + i * 8192, Rr, C); const int Rb = Epi::PERM ? ((Rr & ~31) + perm32(Rr & 31)) : Rr;
        voffA[i] = (unsigned)(Rr * g.lda + C) * 2u; voffB[i] = (unsigned)(Rb * g.ldb + C) * 2u; }
    const size_t kstep = (size_t)(BK * 2);
    const size_t hstepA = (size_t)HALF * g.lda * 2, hstepB = (size_t)HALF * g.ldb * 2;
    const size_t tstepA = 2 * hstepA, tstepB = 2 * hstepB;
    const unsigned ldsw = (unsigned)wid * 1024u;
    const int aoff = lds_byte(wr * 64 + fr, fq * 8), boff = lds_byte(wc * 32 + fr, fq * 8);
#define PG8_SA(b, h) (((b) * 2 + (h)) * HTB)
#define PG8_SB(b, h) ((4 + (b) * 2 + (h)) * HTB)
#define PG8_STAGE(bufoff, gbase, voff) do { _Pragma("unroll") for (int _i = 0; _i < 2; ++_i) \
        __builtin_amdgcn_global_load_lds((const unsigned*)((const char*)(gbase) + (voff)[_i]), (PG8_LAS unsigned*)(lds + (bufoff) + ldsw + _i * 8192), 16, 0, 0); } while (0)
#define PG8_LDA(dst, b, h) do { _Pragma("unroll") for (int m = 0; m < 4; ++m) _Pragma("unroll") for (int k = 0; k < 2; ++k) dst[m][k] = *(const PG8_LAS bf16x8*)(lds + PG8_SA(b, h) + aoff + m * 2048 + k * 1024); } while (0)
#define PG8_LDB(dst, b, h) do { _Pragma("unroll") for (int n = 0; n < 2; ++n) _Pragma("unroll") for (int k = 0; k < 2; ++k) dst[n][k] = *(const PG8_LAS bf16x8*)(lds + PG8_SB(b, h) + boff + n * 2048 + k * 1024); } while (0)
#define PG8_MMA(ai, bj, At, Bt) do { __builtin_amdgcn_s_setprio(1); _Pragma("unroll") for (int m = 0; m < 4; ++m) _Pragma("unroll") for (int n = 0; n < 2; ++n) _Pragma("unroll") for (int k = 0; k < 2; ++k) \
        acc[ai][bj][m][n] = __builtin_amdgcn_mfma_f32_16x16x32_bf16(Bt[n][k], At[m][k], acc[ai][bj][m][n], 0, 0, 0); __builtin_amdgcn_s_setprio(0); } while (0)
#define PG8_WAIT_V(n) asm volatile("s_waitcnt vmcnt(" #n ")" ::: "memory")
#define PG8_WAIT_L(n) asm volatile("s_waitcnt lgkmcnt(" #n ")" ::: "memory")
#define PG8_BAR __builtin_amdgcn_s_barrier()
#define PG8_SCHED __builtin_amdgcn_sched_barrier(0)
    Unit cur, nxt; int ui = 0;
    if (!S.next(0, cur)) return;
    f32x4 acc[2][2][4][2];
#pragma unroll
    for (int a = 0; a < 2; ++a)
#pragma unroll
        for (int b = 0; b < 2; ++b)
#pragma unroll
            for (int m = 0; m < 4; ++m)
#pragma unroll
                for (int n = 0; n < 2; ++n) acc[a][b][m][n] = (f32x4){0.f, 0.f, 0.f, 0.f};
    bf16x8 At[4][2], B0[2][2], B1[2][2];
    const char* cA = PG8_UA(cur) + (size_t)cur.pm * tstepA; const char* cB = PG8_UB(cur) + (size_t)cur.pn * tstepB;
    S.a_ready(cur);
    if constexpr (SP2) {
        PG8_STAGE(PG8_SB(0, 0), cB, voffB); PG8_STAGE(PG8_SB(0, 1), cB + hstepB, voffB); PG8_STAGE(PG8_SA(0, 0), cA, voffA); PG8_STAGE(PG8_SA(0, 1), cA + hstepA, voffA);
        if (wr == 1) PG8_BAR;
        PG8_WAIT_V(2); PG8_BAR;
        PG8_STAGE(PG8_SB(1, 0), cB + kstep, voffB); PG8_STAGE(PG8_SA(1, 0), cA + kstep, voffA); PG8_STAGE(PG8_SB(1, 1), cB + hstepB + kstep, voffB);
        PG8_WAIT_V(6); PG8_BAR;
    } else {
        PG8_STAGE(PG8_SB(0, 0), cB, voffB); PG8_STAGE(PG8_SA(0, 0), cA, voffA); PG8_STAGE(PG8_SB(0, 1), cB + hstepB, voffB); PG8_STAGE(PG8_SA(0, 1), cA + hstepA, voffA);
        if (wr == 1) PG8_BAR;
        PG8_WAIT_V(4); PG8_BAR;
        PG8_STAGE(PG8_SB(1, 0), cB + kstep, voffB); PG8_STAGE(PG8_SA(1, 0), cA + kstep, voffA); PG8_STAGE(PG8_SB(1, 1), cB + hstepB + kstep, voffB);
        PG8_WAIT_V(6); PG8_BAR;
    }
    for (;;) {
        const bool has_next = S.next(ui + 1, nxt);
        const char* nA = has_next ? PG8_UA(nxt) + (size_t)nxt.pm * tstepA : cA; const char* nB = has_next ? PG8_UB(nxt) + (size_t)nxt.pn * tstepB : cB;
        const int nt = PG8_UNT(cur);
        for (int t = 0; t < nt; t += 2) {
            const bool last = (t == nt - 2);
            const char* a1 = cA + (size_t)(t + 1) * kstep;
            const char* a2 = last ? nA : cA + (size_t)(t + 2) * kstep; const char* b2 = last ? nB : cB + (size_t)(t + 2) * kstep;
            const char* a3 = a2 + kstep; const char* b3 = b2 + kstep;
            if (last && has_next) S.a_ready(nxt);
            if constexpr (SP2) {
            PG8_LDB(B0, 0, 0); PG8_LDB(B1, 0, 1); PG8_SCHED; PG8_LDA(At, 0, 0); PG8_STAGE(PG8_SA(1, 1), a1 + hstepA, voffA);
            PG8_WAIT_V(8); PG8_WAIT_L(0); PG8_BAR; PG8_MMA(0, 0, At, B0); PG8_MMA(0, 1, At, B1); PG8_BAR; PG8_SCHED;
            PG8_LDA(At, 0, 1); PG8_STAGE(PG8_SB(0, 0), b2, voffB); PG8_STAGE(PG8_SB(0, 1), b2 + hstepB, voffB); PG8_STAGE(PG8_SA(0, 0), a2, voffA);
            PG8_WAIT_V(8); PG8_WAIT_L(0); PG8_BAR; PG8_MMA(1, 0, At, B0); PG8_MMA(1, 1, At, B1); PG8_BAR; PG8_SCHED;
            PG8_LDB(B0, 1, 0); PG8_LDB(B1, 1, 1); PG8_SCHED; PG8_LDA(At, 1, 0); PG8_STAGE(PG8_SA(0, 1), a2 + hstepA, voffA);
            PG8_WAIT_V(8); PG8_WAIT_L(0); PG8_BAR; PG8_MMA(0, 0, At, B0); PG8_MMA(0, 1, At, B1); PG8_BAR; PG8_SCHED;
            PG8_LDA(At, 1, 1); PG8_STAGE(PG8_SB(1, 0), b3, voffB); PG8_STAGE(PG8_SB(1, 1), b3 + hstepB, voffB); PG8_STAGE(PG8_SA(1, 0), a3, voffA);
            PG8_WAIT_V(8); PG8_WAIT_L(0); PG8_BAR; PG8_MMA(1, 0, At, B0); PG8_MMA(1, 1, At, B1); PG8_BAR; PG8_SCHED;
            } else {
            PG8_LDB(B0, 0, 0); PG8_SCHED; PG8_LDA(At, 0, 0); PG8_STAGE(PG8_SA(1, 1), a1 + hstepA, voffA);
            PG8_WAIT_L(8); PG8_BAR; PG8_WAIT_L(0); PG8_MMA(0, 0, At, B0); PG8_BAR; PG8_SCHED;
            PG8_LDB(B1, 0, 1); PG8_STAGE(PG8_SB(0, 0), b2, voffB);
            PG8_BAR; PG8_WAIT_L(0); PG8_MMA(0, 1, At, B1); PG8_BAR;
            PG8_LDA(At, 0, 1); PG8_STAGE(PG8_SA(0, 0), a2, voffA);
            PG8_BAR; PG8_WAIT_L(0); PG8_MMA(1, 0, At, B0); PG8_BAR; PG8_SCHED;
            PG8_STAGE(PG8_SB(0, 1), b2 + hstepB, voffB);
            PG8_WAIT_V(6); PG8_BAR; PG8_MMA(1, 1, At, B1); PG8_BAR;
            PG8_LDB(B0, 1, 0); PG8_SCHED; PG8_LDA(At, 1, 0); PG8_STAGE(PG8_SA(0, 1), a2 + hstepA, voffA);
            PG8_WAIT_L(8); PG8_BAR; PG8_WAIT_L(0); PG8_MMA(0, 0, At, B0); PG8_BAR; PG8_SCHED;
            PG8_LDB(B1, 1, 1); PG8_STAGE(PG8_SB(1, 0), b3, voffB);
            PG8_BAR; PG8_WAIT_L(0); PG8_MMA(0, 1, At, B1); PG8_BAR;
            PG8_LDA(At, 1, 1); PG8_STAGE(PG8_SA(1, 0), a3, voffA);
            PG8_BAR; PG8_WAIT_L(0); PG8_MMA(1, 0, At, B0); PG8_BAR; PG8_SCHED;
            PG8_STAGE(PG8_SB(1, 1), b3 + hstepB, voffB);
            PG8_WAIT_V(6); PG8_BAR; PG8_MMA(1, 1, At, B1); PG8_BAR;
            }
        }
        if constexpr (ALIGN_EPI) { if (wr == 0) PG8_BAR; }
        E(acc, cur, wr, wc, fr, fq); S.done(cur);
        if (!has_next) break;
#pragma unroll
        for (int a = 0; a < 2; ++a)
#pragma unroll
            for (int b = 0; b < 2; ++b)
#pragma unroll
                for (int m = 0; m < 4; ++m)
#pragma unroll
                    for (int n = 0; n < 2; ++n) acc[a][b][m][n] = (f32x4){0.f, 0.f, 0.f, 0.f};
        cur = nxt; cA = nA; cB = nB; ++ui;
        if constexpr (ALIGN_EPI) { if (wr == 1) PG8_BAR; }
    }
    PG8_WAIT_V(0);
    if constexpr (!ALIGN_EPI) { if (wr == 0) PG8_BAR; }
    PG8_BAR;
#undef PG8_UA
#undef PG8_UB
#undef PG8_UNT
#undef PG8_SA
#undef PG8_SB
#undef PG8_STAGE
#undef PG8_LDA
#undef PG8_LDB
#undef PG8_MMA
#undef PG8_WAIT_V
#undef PG8_WAIT_L
#undef PG8_BAR
#undef PG8_SCHED
}

struct EpiIn {
    static constexpr bool PERM = true;
    u16 *Q, *Kb, *Vb, *S, *F, *FC, *G;
    __device__ __forceinline__ void operator()(const f32x4 (&acc)[2][2][4][2], const Unit& u, int wr, int wc, int fr, int fq) const {
        const int pn = u.pn; u16* base; int ld, act = 0, radj = 0;
        if (pn < 4) { base = Q + pn * 256; ld = 1024; }
        else if (pn == 4) { base = Kb; ld = 256; }
        else if (pn == 5) { base = Vb; ld = 256; }
        else if (pn < 10) { base = S + (pn - 6) * 256; ld = 1024; act = 1; }
        else if (pn < 12) { if (u.pm == 64) { base = FC + (pn - 10) * 256; radj = T; } else base = F + (pn - 10) * 256; ld = 512; }
        else { base = G + (pn - 12) * 256; ld = 3072; act = 2; }
        const int row0 = u.pm * BM + wr * 64 + fr - radj, col0 = wc * 32 + 8 * fq;
#pragma unroll
        for (int ai = 0; ai < 2; ++ai)
#pragma unroll
            for (int m = 0; m < 4; ++m) { u16* rowp = base + (size_t)(row0 + ai * HALF + m * 16) * ld + col0;
#pragma unroll
                for (int bj = 0; bj < 2; ++bj) { f32x4 v0 = acc[ai][bj][m][0], v1 = acc[ai][bj][m][1];
                    if (act == 1) {
#pragma unroll
                        for (int j = 0; j < 4; ++j) { v0[j] = fgelu_tanh(v0[j]); v1[j] = fgelu_tanh(v1[j]); } }
                    else if (act == 2) {
#pragma unroll
                        for (int j = 0; j < 4; ++j) { v0[j] = fsigmoid(v0[j]); v1[j] = fsigmoid(v1[j]); } }
                    u32x4 w; w.x = pk2(v0[0], v0[1]); w.y = pk2(v0[2], v0[3]); w.z = pk2(v1[0], v1[1]); w.w = pk2(v1[2], v1[3]);
                    *(u32x4*)(rowp + bj * HALF) = w; } }
    }
};
struct EpiBr {
    static constexpr bool PERM = true;
    const u16* G; u16* Mg;
    __device__ __forceinline__ void operator()(const f32x4 (&acc)[2][2][4][2], const Unit& u, int wr, int wc, int fr, int fq) const {
        const int row0 = u.pm * BM + wr * 64 + fr, col0 = u.pn * BM + wc * 32 + 8 * fq; const bool first = (u.b == 0); const u16* G = this->G + u.b * 1024;
#pragma unroll
        for (int ai = 0; ai < 2; ++ai)
#pragma unroll
            for (int m = 0; m < 4; ++m) { const size_t r = (size_t)(row0 + ai * HALF + m * 16);
#pragma unroll
                for (int bj = 0; bj < 2; ++bj) { const int c = col0 + bj * HALF;
                    const u32x4 gw = *(const u32x4*)(G + r * 3072 + c);
                    f32x4 v0 = acc[ai][bj][m][0], v1 = acc[ai][bj][m][1];
                    v0[0] *= bflo(gw.x); v0[1] *= bfhi(gw.x); v0[2] *= bflo(gw.y); v0[3] *= bfhi(gw.y);
                    v1[0] *= bflo(gw.z); v1[1] *= bfhi(gw.z); v1[2] *= bflo(gw.w); v1[3] *= bfhi(gw.w);
                    u16* mp = Mg + r * 1024 + c;
                    if (!first) { const u32x4 pw = *(const u32x4*)mp;
                        v0[0] += bflo(pw.x); v0[1] += bfhi(pw.x); v0[2] += bflo(pw.y); v0[3] += bfhi(pw.y);
                        v1[0] += bflo(pw.z); v1[1] += bfhi(pw.z); v1[2] += bflo(pw.w); v1[3] += bfhi(pw.w); }
                    u32x4 w; w.x = pk2(v0[0], v0[1]); w.y = pk2(v0[2], v0[3]); w.z = pk2(v1[0], v1[1]); w.w = pk2(v1[2], v1[3]);
                    *(u32x4*)mp = w; } }
    }
};
struct EpiRes {
    static constexpr bool PERM = false;
    const float *xin_lat; float *xo_lat; const float *gate_lat; const float* st; const float *lg, *lb;
    __device__ __forceinline__ void operator()(const f32x4 (&acc)[2][2][4][2], const Unit& u, int wr, int wc, int fr, int fq) const {
        const int row0 = u.pm * BM + wr * 64 + fr, col0 = u.pn * BM + wc * 32 + 4 * fq;
        f32x2 sv[2][4];
#pragma unroll
        for (int ai = 0; ai < 2; ++ai)
#pragma unroll
            for (int m = 0; m < 4; ++m) sv[ai][m] = st ? *(const f32x2*)(st + 2 * (size_t)(row0 + ai * HALF + m * 16)) : (f32x2){0.f, 1.f};
#pragma unroll
        for (int bj = 0; bj < 2; ++bj)
#pragma unroll
            for (int n = 0; n < 2; ++n) { const int c = col0 + bj * HALF + n * 16;
                const f32x4 gv = *(const f32x4*)(gate_lat + c);
                f32x4 g4 = (f32x4){1.f, 1.f, 1.f, 1.f}, b4 = (f32x4){0.f, 0.f, 0.f, 0.f};
                if (st) { g4 = *(const f32x4*)(lg + c); b4 = *(const f32x4*)(lb + c); }
#pragma unroll
                for (int ai = 0; ai < 2; ++ai)
#pragma unroll
                    for (int m = 0; m < 4; ++m) { const size_t off = (size_t)(row0 + ai * HALF + m * 16) * D + c;
                        f32x4 xv = *(const f32x4*)(xin_lat + off);
                        xv = (xv - sv[ai][m][0]) * sv[ai][m][1] * g4 + b4;
                        *(f32x4*)(xo_lat + off) = xv * ALPHA + gv * acc[ai][bj][m][n]; } }
    }
};
struct EpiUp {
    static constexpr bool PERM = true;
    u16* ACT;
    __device__ __forceinline__ void operator()(const f32x4 (&acc)[2][2][4][2], const Unit& u, int wr, int wc, int fr, int fq) const {
        const int row0 = u.pm * BM + wr * 64 + fr, col0 = u.pn * HALF + wc * 32 + 8 * fq;
#pragma unroll
        for (int ai = 0; ai < 2; ++ai)
#pragma unroll
            for (int m = 0; m < 4; ++m) { u16* rowp = ACT + (size_t)(row0 + ai * HALF + m * 16) * FFH + col0;
                f32x4 g0 = acc[ai][0][m][0], g1 = acc[ai][0][m][1]; const f32x4 u0 = acc[ai][1][m][0], u1 = acc[ai][1][m][1];
#pragma unroll
                for (int j = 0; j < 4; ++j) { g0[j] = g0[j] * fsigmoid(g0[j]) * u0[j]; g1[j] = g1[j] * fsigmoid(g1[j]) * u1[j]; }
                u32x4 w; w.x = pk2(g0[0], g0[1]); w.y = pk2(g0[2], g0[3]); w.z = pk2(g1[0], g1[1]); w.w = pk2(g1[2], g1[3]);
                *(u32x4*)rowp = w; }
    }
};
}

namespace att {
constexpr int NW = 8, QBLK = 32, KVBLK = 64;
constexpr float SCALE = 0.088388347648318440f, THR = 8.f;
constexpr int LDQ = 1024, LDK = 256, LDO = 1024;
constexpr size_t SHM_V = KVBLK * 128 * 2, SHM_K = KVBLK * 128 * 2, SHM_ATTN = 3 * SHM_V + 2 * SHM_K + NW * 64 * 4;
#define KSWZ(row, colB) ((row) * 256 + ((colB) ^ (((row) & 7) << 4)))
#define SBAR() __builtin_amdgcn_sched_barrier(0)
__device__ __forceinline__ unsigned cvtpk(float lo, float hi) { unsigned r; asm volatile("v_cvt_pk_bf16_f32 %0, %1, %2" : "=v"(r) : "v"(lo), "v"(hi)); return r; }
__device__ __forceinline__ void partialSM(f32x16& p0) {
  for (int r = 0; r < 16; ++r) p0[r] = __builtin_amdgcn_exp2f(p0[r]);
}
__device__ __forceinline__ void finishSM(f32x16& p0, f32x16& p1, float& l_reg, bf16x8& pa0, bf16x8& pa1, bf16x8& pa2, bf16x8& pa3) {
  for (int r = 0; r < 16; ++r) p1[r] = __builtin_amdgcn_exp2f(p1[r]);
  float ps = 0; for (int r = 0; r < 16; ++r) ps += p0[r]; for (int r = 0; r < 16; ++r) ps += p1[r];
  { auto rr = __builtin_amdgcn_permlane32_swap(__float_as_uint(ps), __float_as_uint(ps), false, false);
    ps = __uint_as_float(rr[0]) + __uint_as_float(rr[1]); }
  l_reg += ps;
#define PK4(P, BASE, OUT) do { unsigned a0 = cvtpk(P[BASE + 0], P[BASE + 1]), a1 = cvtpk(P[BASE + 2], P[BASE + 3]);   \
    unsigned b0 = cvtpk(P[BASE + 4], P[BASE + 5]), b1 = cvtpk(P[BASE + 6], P[BASE + 7]);                              \
    auto r0 = __builtin_amdgcn_permlane32_swap(a0, b0, false, false); auto r1 = __builtin_amdgcn_permlane32_swap(a1, b1, false, false); \
    u32x4 w = {r0[0], r1[0], r0[1], r1[1]}; OUT = *reinterpret_cast<bf16x8*>(&w); } while (0)
  PK4(p0, 0, pa0); PK4(p0, 8, pa1); PK4(p1, 0, pa2); PK4(p1, 8, pa3);
#undef PK4
}
__device__ __forceinline__ void qkt(f32x16& p0, f32x16& p1, const u16* Ks, const bf16x8* qr, int r32, int hi, float noff) {
  for (int r = 0; r < 16; ++r) { p0[r] = noff; p1[r] = noff; }
  for (int d0 = 0; d0 < 8; ++d0) { int cb = (d0 * 16 + hi * 8) * 2;
    bf16x8 b0 = *reinterpret_cast<const bf16x8*>((const char*)Ks + KSWZ(r32, cb));
    bf16x8 b1 = *reinterpret_cast<const bf16x8*>((const char*)Ks + KSWZ(32 + r32, cb));
    p0 = __builtin_amdgcn_mfma_f32_32x32x16_bf16(b0, qr[d0], p0, 0, 0, 0);
    p1 = __builtin_amdgcn_mfma_f32_32x32x16_bf16(b1, qr[d0], p1, 0, 0, 0); }
}
__device__ __forceinline__ int v_st(int k, int c) { const int kk = (k & ~0xC) | ((k & 4) << 1) | ((k & 8) >> 1); return ((kk >> 3) * 4 + (c >> 5)) * 512 + ((kk & 7) * 32 + (c & 31)) * 2; }
__device__ __forceinline__ int v_rd_base(int lane) { return ((lane & 3) << 3) | (((lane >> 2) & 3) << 6) | (((lane >> 4) & 1) << 5) | (((lane >> 5) & 1) << 8); }
constexpr int v_rd_off(int d0, int ks, int half) { return d0 * 512 + ks * 4096 + half * 2048; }
template <int OFF> __device__ __forceinline__ s16x4 tr_read(int vb) {
  s16x4 r; asm volatile("ds_read_b64_tr_b16 %0, %1 offset:%2" : "=&v"(r) : "v"(vb), "i"(OFF) : "memory"); return r;
}
struct VFrag { s16x4 l0, h0, l1, h1, l2, h2, l3, h3; };
template <int D0> __device__ __forceinline__ void pv_reads(VFrag& f, int vb) {
  f.l0 = tr_read<v_rd_off(D0, 0, 0)>(vb); f.h0 = tr_read<v_rd_off(D0, 0, 1)>(vb); f.l1 = tr_read<v_rd_off(D0, 1, 0)>(vb); f.h1 = tr_read<v_rd_off(D0, 1, 1)>(vb);
  f.l2 = tr_read<v_rd_off(D0, 2, 0)>(vb); f.h2 = tr_read<v_rd_off(D0, 2, 1)>(vb); f.l3 = tr_read<v_rd_off(D0, 3, 0)>(vb); f.h3 = tr_read<v_rd_off(D0, 3, 1)>(vb);
}
__device__ __forceinline__ void pv_mma(f32x16& od, const VFrag& f, bf16x8 pa0, bf16x8 pa1, bf16x8 pa2, bf16x8 pa3) {
#define PK(L, H) (bf16x8){L[0], L[1], L[2], L[3], H[0], H[1], H[2], H[3]}
  od = __builtin_amdgcn_mfma_f32_32x32x16_bf16(pa0, PK(f.l0, f.h0), od, 0, 0, 0);
  od = __builtin_amdgcn_mfma_f32_32x32x16_bf16(pa1, PK(f.l1, f.h1), od, 0, 0, 0);
  od = __builtin_amdgcn_mfma_f32_32x32x16_bf16(pa2, PK(f.l2, f.h2), od, 0, 0, 0);
  od = __builtin_amdgcn_mfma_f32_32x32x16_bf16(pa3, PK(f.l3, f.h3), od, 0, 0, 0);
#undef PK
}
__device__ __forceinline__ void pv_d0(f32x16* o, int vb, bf16x8 pa0, bf16x8 pa1, bf16x8 pa2, bf16x8 pa3) {
  VFrag fa, fb;
  pv_reads<0>(fa, vb); pv_reads<1>(fb, vb);
  asm volatile("s_waitcnt lgkmcnt(8)" ::: "memory"); SBAR();
  pv_mma(o[0], fa, pa0, pa1, pa2, pa3); SBAR();
  pv_reads<2>(fa, vb);
  asm volatile("s_waitcnt lgkmcnt(8)" ::: "memory"); SBAR();
  pv_mma(o[1], fb, pa0, pa1, pa2, pa3); SBAR();
  pv_reads<3>(fb, vb);
  asm volatile("s_waitcnt lgkmcnt(8)" ::: "memory"); SBAR();
  pv_mma(o[2], fa, pa0, pa1, pa2, pa3); SBAR();
  asm volatile("s_waitcnt lgkmcnt(0)" ::: "memory"); SBAR();
  pv_mma(o[3], fb, pa0, pa1, pa2, pa3);
}
__device__ __forceinline__ void attn_dense_body(const u16* Qb, const u16* __restrict__ Kh, const u16* __restrict__ Vh, u16* Ob, int seq, char* lds, const int tid, const float noff) {
  const int wid = tid >> 6, lane = tid & 63, r32 = lane & 31, hi = lane >> 5;
  LAS unsigned char* l3 = (LAS unsigned char*)lds;
  u16* V_lds = (u16*)lds; u16* K_lds = (u16*)(lds + 3 * SHM_V);
  float* ws = (float*)(lds + 3 * SHM_V + 2 * SHM_K) + wid * 64; float* li_l = ws;
  float l_reg = 0; f32x16 o[4] = {}; bf16x8 qr[8];
  const u16* Qw = Qb + (long)(wid * QBLK + r32) * LDQ + hi * 8;
#pragma unroll
  for (int d0 = 0; d0 < 8; ++d0) qr[d0] = *reinterpret_cast<const bf16x8*>(Qw + d0 * 16);
  const int vb0 = (int)(uintptr_t)V_lds + v_rd_base(lane);
  const int wu = __builtin_amdgcn_readfirstlane(wid);
  unsigned ksrc0, ksrc1, vsrc0, vsrc1;
  { const int r = wid * 4 + (lane >> 4), p = lane & 15, c = p ^ (r & 7); ksrc0 = (unsigned)(r * LDK * 2 + c * 16); ksrc1 = ksrc0 + 32u * LDK * 2u; }
  { const int st = wid * 2 + (lane >> 5), within = lane & 31, kk = (st >> 2) * 8 + (within >> 2), c = (st & 3) * 32 + (within & 3) * 8;
    const int k = (kk & ~0xC) | ((kk & 4) << 1) | ((kk & 8) >> 1); vsrc0 = (unsigned)(k * LDK * 2 + c * 2); vsrc1 = vsrc0 + 32u * LDK * 2u; }
#define DMA_TILE(k0, ks, vs) do { const char* kt_ = (const char*)Kh + (size_t)(k0) * (LDK * 2); const char* vt_ = (const char*)Vh + (size_t)(k0) * (LDK * 2); \
    asm volatile("" : "+s"(kt_), "+s"(vt_));     \
    __builtin_amdgcn_global_load_lds((const unsigned*)(kt_ + ksrc0), (LAS unsigned*)(l3 + 3 * (int)SHM_V + (ks) * (int)SHM_K + wu * 1024), 16, 0, 0); \
    __builtin_amdgcn_global_load_lds((const unsigned*)(kt_ + ksrc1), (LAS unsigned*)(l3 + 3 * (int)SHM_V + (ks) * (int)SHM_K + wu * 1024 + 8192), 16, 0, 0); \
    __builtin_amdgcn_global_load_lds((const unsigned*)(vt_ + vsrc0), (LAS unsigned*)(l3 + (vs) * (int)SHM_V + wu * 1024), 16, 0, 0); \
    __builtin_amdgcn_global_load_lds((const unsigned*)(vt_ + vsrc1), (LAS unsigned*)(l3 + (vs) * (int)SHM_V + wu * 1024 + 8192), 16, 0, 0); } while (0)
#define LANDED() asm volatile("s_waitcnt vmcnt(0)" ::: "memory")
  f32x16 pA0, pA1, pB0, pB1; bf16x8 pa0, pa1, pa2, pa3; const int NT = seq / KVBLK;
  DMA_TILE(0, 0, 0); LANDED(); __syncthreads();
  DMA_TILE(KVBLK, 1, 1);
  qkt(pA0, pA1, K_lds, qr, r32, hi, noff); partialSM(pA0);
  LANDED(); __syncthreads();
  int sv = 0;
  for (int j = 1; j + 1 < NT; j += 2) {
    { const int sn = (sv == 0) ? 2 : sv - 1;
      SBAR(); DMA_TILE((j + 1) * KVBLK, 0, sn); SBAR();
      qkt(pB0, pB1, (u16*)((char*)K_lds + SHM_K), qr, r32, hi, noff);
      finishSM(pA0, pA1, l_reg, pa0, pa1, pa2, pa3); SBAR();
      pv_d0(o, vb0 + sv * (int)SHM_V, pa0, pa1, pa2, pa3); partialSM(pB0);
      LANDED(); __syncthreads(); sv = (sv == 2) ? 0 : sv + 1; }
    { const int sn = (sv == 0) ? 2 : sv - 1;
      SBAR(); DMA_TILE((j + 2) * KVBLK, 1, sn); SBAR();
      qkt(pA0, pA1, K_lds, qr, r32, hi, noff);
      finishSM(pB0, pB1, l_reg, pa0, pa1, pa2, pa3); SBAR();
      pv_d0(o, vb0 + sv * (int)SHM_V, pa0, pa1, pa2, pa3); partialSM(pA0);
      LANDED(); __syncthreads(); sv = (sv == 2) ? 0 : sv + 1; }
  }
  { const int svl = (sv == 2) ? 0 : sv + 1;
    SBAR(); qkt(pB0, pB1, (u16*)((char*)K_lds + SHM_K), qr, r32, hi, noff);
    finishSM(pA0, pA1, l_reg, pa0, pa1, pa2, pa3); SBAR();
    pv_d0(o, vb0 + sv * (int)SHM_V, pa0, pa1, pa2, pa3); partialSM(pB0);
    finishSM(pB0, pB1, l_reg, pa0, pa1, pa2, pa3); SBAR();
    pv_d0(o, vb0 + svl * (int)SHM_V, pa0, pa1, pa2, pa3); }
#undef DMA_TILE
#undef LANDED
  if (hi == 0) li_l[r32] = l_reg; asm volatile("s_waitcnt lgkmcnt(0)" ::: "memory");
  float rli[16];
#pragma unroll
  for (int r = 0; r < 16; ++r) rli[r] = __builtin_amdgcn_rcpf(li_l[crow(r, hi)]);
  u16* Ow = Ob + (long)(wid * QBLK) * LDO;
#pragma unroll
  for (int r = 0; r < 16; ++r) { int orow = crow(r, hi);
    for (int d0 = 0; d0 < 4; ++d0) Ow[(long)orow * LDO + d0 * 32 + r32] = (u16)f2bf(o[d0][r] * rli[r]); }
}
}

#define XB_TMO      128
#define XB_XCNT(j)  (256  + 64 * (j))
#define XB_XSUB(j)  (1280 + 64 * (j))
#define XB_XGEN(j)  (2304 + 64 * (j))
#define XB_TOP      3328
#define XB_TOPGEN   3392
#define XCD_BAR_WORDS 3456
#define XB_SPIN_CAP (1u << 18)
__device__ __forceinline__ unsigned xb_ld(unsigned* p)              { return __hip_atomic_load(p, __ATOMIC_RELAXED, __HIP_MEMORY_SCOPE_AGENT); }
__device__ __forceinline__ unsigned xb_add(unsigned* p, unsigned v) { return __hip_atomic_fetch_add(p, v, __ATOMIC_RELAXED, __HIP_MEMORY_SCOPE_AGENT); }
__device__ __forceinline__ unsigned xb_xcc_id() { return (unsigned)__builtin_amdgcn_s_getreg((3 << 11) | 20) & 0xFu; }
#define XB_SPIN(cond, bar) do { unsigned _sp = 0; while (cond) { __builtin_amdgcn_s_sleep(1); \
    if ((++_sp & 255u) == 0u) { if (xb_ld(&(bar)[XB_TMO])) break; if (_sp > XB_SPIN_CAP) { atomicAdd(&(bar)[XB_TMO], 1u); break; } } } } while (0)
__device__ __forceinline__ void xcd_barrier_complete(unsigned* bar, unsigned x, unsigned& nloc, unsigned& nx) {
    const unsigned G = gridDim.x * gridDim.y * gridDim.z;
    unsigned sum, cnt, mine, sp = 0u;
    for (;;) {
        sum = 0u; cnt = 0u; mine = 0u;
#pragma unroll
        for (unsigned j = 0; j < 16; ++j) { const unsigned c = xb_ld(&bar[XB_XCNT(j)]); sum += c; cnt += (c > 0u) ? 1u : 0u; mine = (j == x) ? c : mine; }
        if (sum == G) break;
        __builtin_amdgcn_s_sleep(1);
        if ((++sp & 255u) == 0u) { if (xb_ld(&bar[XB_TMO])) break; if (sp > XB_SPIN_CAP) { atomicAdd(&bar[XB_TMO], 1u); break; } }
    }
    nloc = mine > 0u ? mine : 1u; nx = cnt > 0u ? cnt : 1u;
}
__device__ __forceinline__ void xcd_barrier(unsigned* bar, volatile LAS unsigned* st, const int tid) {
    asm volatile("s_waitcnt vmcnt(0)" ::: "memory");
    __syncthreads();
    if (tid == 0) {
        const unsigned x = xb_xcc_id();
        __builtin_amdgcn_s_waitcnt(0);
        unsigned nloc = st[0], nx = st[1];
        if (nloc == 0u) { xcd_barrier_complete(bar, x, nloc, nx); st[0] = nloc; st[1] = nx; }
        const unsigned old = xb_add(&bar[XB_XSUB(x)], 1u);
        const unsigned gen = old / nloc;
        if (old + 1u == (gen + 1u) * nloc) {
            __builtin_amdgcn_fence(__ATOMIC_RELEASE, "agent");
            asm volatile("s_waitcnt vmcnt(0)" ::: "memory");
            const unsigned og = xb_add(&bar[XB_TOP], 1u);
            const unsigned tg = og / nx;
            if (og + 1u == (tg + 1u) * nx) xb_add(&bar[XB_TOPGEN], 1u);
            else XB_SPIN(xb_ld(&bar[XB_TOPGEN]) == tg, bar);
            __builtin_amdgcn_fence(__ATOMIC_ACQUIRE, "agent");
            xb_add(&bar[XB_XGEN(x)], 1u);
            asm volatile("s_waitcnt vmcnt(0)" ::: "memory");
        } else {
            XB_SPIN(xb_ld(&bar[XB_XGEN(x)]) == gen, bar);
            __builtin_amdgcn_fence(__ATOMIC_ACQUIRE, "agent");
            asm volatile("s_waitcnt vmcnt(0)" ::: "memory");
        }
    }
    __syncthreads();
}

struct Params { const float* in[23]; float* out; unsigned char* ws; int ph_lo, ph_hi; };
static_assert(sizeof(Params) == 23 * 8 + 8 + 8 + 8, "no padding in Params");

struct Ctx {
    int tid, lane, wid, G, gw, NGW;
    unsigned char* smem;
};

template <int MODE>
__device__ __forceinline__ void transpose_job(const Ctx& C, const float* W, int K, int N, u16* WT, int ldt) {
    float* scr = (float*)(C.smem + C.wid * 16384);
    const int nblk = N / 32, nitems = (K / 64) * nblk, lane = C.lane;
    for (int item = C.gw; item < nitems; item += C.NGW) {
        const int kb = item / nblk, nb = item % nblk, k0 = 64 * kb, n0 = 32 * nb;
        float tv[32];
#pragma unroll
        for (int i = 0; i < 32; ++i) tv[i] = W[(size_t)(k0 + 2 * i + (lane >> 5)) * N + n0 + (lane & 31)];
#pragma unroll
        for (int i = 0; i < 32; ++i) scr[(2 * i + (lane >> 5)) * 33 + (lane & 31)] = tv[i];
        asm volatile("s_waitcnt lgkmcnt(0)" ::: "memory");
        const int c = lane & 7;
#pragma unroll
        for (int j = 0; j < 4; ++j) { const int n = (lane >> 3) + 8 * j; const float* s = scr + (8 * c) * 33 + n;
            u32x4 o; o.x = pk2(s[0 * 33], s[1 * 33]); o.y = pk2(s[2 * 33], s[3 * 33]); o.z = pk2(s[4 * 33], s[5 * 33]); o.w = pk2(s[6 * 33], s[7 * 33]);
            int row = n0 + n;
            if (MODE == 1) { const int b = row / FFH, jj = row % FFH; row = (jj / 128) * 256 + b * 128 + (jj % 128); }
            *(u32x4*)(WT + (size_t)row * ldt + k0 + 8 * c) = o; }
        asm volatile("s_waitcnt lgkmcnt(0)" ::: "memory");
    }
}
__device__ __forceinline__ void fold_fourier_job(const Ctx& C, const float* Wf, u16* Bt) {
    f32x2* tab = (f32x2*)(C.smem + 131072);
    __syncthreads();
    if (C.tid < 128) { float s, c; sincospif(2.0f * (float)C.tid / 128.0f, &s, &c); tab[C.tid] = (f32x2){c, s}; }
    __syncthreads();
    const int gt = blockIdx.x * 512 + C.tid, NT_ = C.G * 512;
    float* ct = (float*)(C.smem + C.wid * 4096);
    for (int id = gt; id < 131072; id += NT_) {
        const int n = id & 1023, combo = id >> 10, c8 = combo & 15, ro = (combo >> 4) & 1, g = combo >> 5;
        const float sc = 0.08838834764831845f;
#pragma unroll
        for (int i = 0; i < 16; ++i) { const int q = C.lane + 64 * i, k2 = q >> 3, e = q & 7; const f32x2 cs = tab[(k2 * (c8 * 8 + e)) & 127]; ct[q] = (ro ? cs.y : cs.x) * sc; }
        asm volatile("s_waitcnt lgkmcnt(0)" ::: "memory");
        float a[8] = {0.f, 0.f, 0.f, 0.f, 0.f, 0.f, 0.f, 0.f};
        const float* wp = Wf + (size_t)(g * 128) * 1024 + n;
        const f32x4* ct4 = (const f32x4*)ct;
#pragma unroll 16
        for (int k2 = 0; k2 < 128; ++k2) { const float w = wp[(size_t)k2 * 1024]; const f32x4 c0 = ct4[2 * k2], c1 = ct4[2 * k2 + 1];
            a[0] += c0[0] * w; a[1] += c0[1] * w; a[2] += c0[2] * w; a[3] += c0[3] * w; a[4] += c1[0] * w; a[5] += c1[1] * w; a[6] += c1[2] * w; a[7] += c1[3] * w; }
        u32x4 o; o.x = pk2(a[0], a[1]); o.y = pk2(a[2], a[3]); o.z = pk2(a[4], a[5]); o.w = pk2(a[6], a[7]);
        *(u32x4*)(Bt + (size_t)n * 2560 + ro * 512 + g * 128 + c8 * 8) = o;
        asm volatile("s_waitcnt lgkmcnt(0)" ::: "memory");
    }
}

__device__ __forceinline__ void ln_norm(f32x4 (&v)[4], float& mean_o, float& rstd_o) {
    float s = 0.f;
#pragma unroll
    for (int j = 0; j < 4; ++j) s += (v[j][0] + v[j][1]) + (v[j][2] + v[j][3]);
    const float mean = wave_sum(s) * (1.f / D); float s2 = 0.f;
#pragma unroll
    for (int j = 0; j < 4; ++j) { v[j] = v[j] - mean; s2 += (v[j][0] * v[j][0] + v[j][1] * v[j][1]) + (v[j][2] * v[j][2] + v[j][3] * v[j][3]); }
    const float rstd = 1.0f / sqrtf(wave_sum(s2) * (1.f / D) + LN_EPS);
#pragma unroll
    for (int j = 0; j < 4; ++j) v[j] = v[j] * rstd;
    mean_o = mean; rstd_o = rstd;
}
__device__ __forceinline__ void ln_rows(const Ctx& C, int nrows, const float* src, float* dst, const float* lg, const float* lb, bool do_h, const float* mod, int shift_off, int scale_off,
                                        u16* H, float* st, bool write_x, bool xmap) {
    f32x4 g4[4], b4[4], sh[4], sc[4];
#pragma unroll
    for (int j = 0; j < 4; ++j) { g4[j] = (f32x4){1.f, 1.f, 1.f, 1.f}; b4[j] = (f32x4){0.f, 0.f, 0.f, 0.f}; sh[j] = b4[j]; sc[j] = g4[j]; }
    if (lg) {
#pragma unroll
        for (int j = 0; j < 4; ++j) { g4[j] = *(const f32x4*)(lg + 4 * C.lane + 256 * j); b4[j] = *(const f32x4*)(lb + 4 * C.lane + 256 * j); } }
    if (do_h) {
#pragma unroll
        for (int j = 0; j < 4; ++j) { sh[j] = *(const f32x4*)(mod + shift_off + 4 * C.lane + 256 * j); sc[j] = *(const f32x4*)(mod + scale_off + 4 * C.lane + 256 * j) + 1.0f; } }
    const bool xm = xmap && C.G == 256 && nrows == T;
    const int mstep = xm ? 256 : C.NGW, mend = xm ? (int)(2048 * (blockIdx.x & 7)) + 2048 : nrows;
    int m = xm ? (int)(2048 * (blockIdx.x & 7) + (blockIdx.x >> 3) * 8) + C.wid : C.gw; f32x4 nv[4];
    if (m < mend) {
#pragma unroll
        for (int j = 0; j < 4; ++j) nv[j] = *(const f32x4*)(src + (size_t)m * D + 4 * C.lane + 256 * j); }
    for (; m < mend; m += mstep) {
        f32x4 v[4];
#pragma unroll
        for (int j = 0; j < 4; ++j) v[j] = nv[j];
        { const int mn = m + mstep;
          if (mn < mend) {
#pragma unroll
              for (int j = 0; j < 4; ++j) nv[j] = *(const f32x4*)(src + (size_t)mn * D + 4 * C.lane + 256 * j); } }
        float mu, rs;
        if (lg) {
            ln_norm(v, mu, rs);
            if (st && C.lane == 0) *(f32x2*)(st + 2 * (size_t)m) = (f32x2){mu, rs};
#pragma unroll
            for (int j = 0; j < 4; ++j) { v[j] = v[j] * g4[j] + b4[j]; if (write_x) *(f32x4*)(dst + (size_t)m * D + 4 * C.lane + 256 * j) = v[j]; }
        }
        if (do_h) {
            ln_norm(v, mu, rs);
            u32x2* hp = (u32x2*)(H + (size_t)m * D) + C.lane;
#pragma unroll
            for (int j = 0; j < 4; ++j) { const f32x4 h = v[j] * sc[j] + sh[j]; u32x2 w; w.x = pk2(h[0], h[1]); w.y = pk2(h[2], h[3]); hp[64 * j] = w; }
        }
    }
}
__device__ __forceinline__ void ln_pass(const Ctx& C, int nrows, const float* src_lat, const float* src_ctx, float* dst_lat, float* dst_ctx,
                                        const float* lg, const float* lb, bool do_h, const float* mod_lat, const float* mod_ctx, int shift_off, int scale_off, u16* H, float* st, bool write_x) {
    ln_rows(C, T, src_lat, dst_lat, lg, lb, do_h, mod_lat, shift_off, scale_off, H, st, write_x, true);
    if (nrows > T) ln_rows(C, nrows - T, src_ctx, dst_ctx, lg, lb, do_h, mod_ctx, shift_off, scale_off, H + (size_t)T * D, st ? st + 2 * (size_t)T : st, write_x, false);
}

template <int K>
__device__ __forceinline__ void load_B_transposed(const Ctx& C, const u16* B, size_t ldb) {
    constexpr int KP = K + 8;
    unsigned* sB32 = (unsigned*)C.smem;
#pragma unroll
    for (int ch = C.tid; ch < (K / 2) * 16; ch += 512) {
        const int n8 = ch & 15, kp = ch >> 4;
        const u32x4 r0 = *(const u32x4*)(B + (size_t)(2 * kp) * ldb + n8 * 8), r1 = *(const u32x4*)(B + (size_t)(2 * kp + 1) * ldb + n8 * 8);
        const unsigned a[4] = {r0.x, r0.y, r0.z, r0.w}, b[4] = {r1.x, r1.y, r1.z, r1.w};
#pragma unroll
        for (int e = 0; e < 4; ++e) { const int n = n8 * 8 + 2 * e;
            const int kps = kp ^ ((n8 & 7) << 2);
            sB32[(n * KP) / 2 + kps] = (a[e] & 0xffffu) | (b[e] << 16);
            sB32[((n + 1) * KP) / 2 + kps] = (a[e] >> 16) | (b[e] & 0xffff0000u); }
    }
}
template <int K>
__device__ __forceinline__ void mma_256x128(const Ctx& C, const u16* A_re, const u16* A_im, f32x16 (&acc_re)[2], f32x16 (&acc_im)[2]) {
    constexpr int KP = K + 8;
    const int l32 = C.lane & 31, hi = C.lane >> 5, mb = C.wid & 3, nh = C.wid >> 2;
    const u16* are = A_re + (size_t)(32 * mb + l32) * K + 8 * hi; const u16* aim = A_im + (size_t)(32 * mb + l32) * K + 8 * hi;
    const u16* sB = (const u16*)C.smem;
    const u16* b0p = sB + (64 * nh + l32) * KP; const u16* b1p = b0p + 32 * KP;
    const int s0 = ((64 * nh + l32) >> 3) & 7, s1 = (s0 + 4) & 7;
    acc_re[0] = f32x16{}; acc_re[1] = f32x16{}; acc_im[0] = f32x16{}; acc_im[1] = f32x16{};
#pragma unroll 8
    for (int k0 = 0; k0 < K; k0 += 16) {
        const bf16x8 ar = *(const bf16x8*)(are + k0), ai = *(const bf16x8*)(aim + k0);
        const int c = (k0 >> 3) + hi;
        const bf16x8 b0 = *(const bf16x8*)(b0p + ((c ^ s0) << 3)), b1 = *(const bf16x8*)(b1p + ((c ^ s1) << 3));
        acc_re[0] = __builtin_amdgcn_mfma_f32_32x32x16_bf16(ar, b0, acc_re[0], 0, 0, 0);
        acc_re[1] = __builtin_amdgcn_mfma_f32_32x32x16_bf16(ar, b1, acc_re[1], 0, 0, 0);
        acc_im[0] = __builtin_amdgcn_mfma_f32_32x32x16_bf16(ai, b0, acc_im[0], 0, 0, 0);
        acc_im[1] = __builtin_amdgcn_mfma_f32_32x32x16_bf16(ai, b1, acc_im[1], 0, 0, 0);
    }
}

__device__ __forceinline__ void ctx_tile(const Ctx& C, const u16* A, int lda, const u16* Bt, int ldb, int K, float (&out)[2]) {
    const int l32 = C.lane & 31, hi = C.lane >> 5, ks = K >> 3;
    const u16* ap = A + (size_t)l32 * lda + C.wid * ks + 8 * hi; const u16* bp = Bt + (size_t)l32 * ldb + C.wid * ks + 8 * hi;
    f32x16 acc = f32x16{};
#pragma unroll 8
    for (int k0 = 0; k0 < ks; k0 += 16) acc = __builtin_amdgcn_mfma_f32_32x32x16_bf16(*(const bf16x8*)(ap + k0), *(const bf16x8*)(bp + k0), acc, 0, 0, 0);
    float* red = (float*)C.smem;
    __syncthreads();
#pragma unroll
    for (int r = 0; r < 16; ++r) red[(C.wid * 32 + crow(r, hi)) * 33 + l32] = acc[r];
    __syncthreads();
#pragma unroll
    for (int i = 0; i < 2; ++i) { const int e = C.tid + 512 * i, rr = e >> 5, cc = e & 31; float s = 0.f;
#pragma unroll
        for (int w = 0; w < 8; ++w) s += red[(w * 32 + rr) * 33 + cc];
        out[i] = s; }
}

__device__ __forceinline__ int lane_id_volatile() { int l; asm volatile("v_mbcnt_lo_u32_b32 %0, -1, 0\n\tv_mbcnt_hi_u32_b32 %0, -1, %0" : "=v"(l)); return l; }
typedef const Params __attribute__((address_space(4))) * KargP;
__global__ void __launch_bounds__(512, 2) fwd_megakernel(Params p_unused) {
    extern __shared__ __attribute__((aligned(16))) unsigned char smem[];
    cg::grid_group grid = cg::this_grid();
    int ph_lo, ph_hi;
    const int WID = __builtin_amdgcn_readfirstlane((int)(threadIdx.x >> 6));
#define MYTID() (WID * 64 + lane_id_volatile())
#define RETID() do { C.lane = lane_id_volatile(); C.tid = WID * 64 + C.lane; } while (0)
    { KargP kp0 = (KargP)__builtin_amdgcn_kernarg_segment_ptr(); ph_lo = kp0->ph_lo; ph_hi = kp0->ph_hi; }
#define p (*KARG)
#define x_in    (p.in[0])
#define c_in    (p.in[1])
#define ctx_in  (p.in[2])
#define cctx_in (p.in[3])
#define w_ada   (p.in[4])
#define b_ada   (p.in[5])
#define w_in    (p.in[6])
#define q_gain  (p.in[7])
#define k_gain  (p.in[8])
#define sgu_g   (p.in[9])
#define sgu_b   (p.in[10])
#define w_sp    (p.in[11])
#define b_sp    (p.in[12])
#define w_bra   (p.in[13])
#define w_brs   (p.in[14])
#define w_brf   (p.in[15])
#define w_out   (p.in[16])
#define ln1_g   (p.in[17])
#define ln1_b   (p.in[18])
#define w_up    (p.in[19])
#define w_down  (p.in[20])
#define ln2_g   (p.in[21])
#define ln2_b   (p.in[22])
#define Hb   ((u16*)(ws + OFF_H))
#define Qb   ((u16*)(ws + OFF_Q))
#define Fb   ((u16*)(ws + OFF_F))
#define Kb   ((u16*)(ws + OFF_K))
#define Vb   ((u16*)(ws + OFF_V))
#define YCb  ((u16*)(ws + OFF_YC))
#define Sb   ((u16*)(ws + OFF_S))
#define Gb   ((u16*)(ws + OFF_G))
#define ACTb ((u16*)(ws + OFF_G))
#define WINt ((u16*)(ws + OFF_W1))
#define WUPt ((u16*)(ws + OFF_WUP))
#define WDNt ((u16*)(ws + OFF_WDN))
#define WBAt ((u16*)(ws + OFF_WBA))
#define WBSt (WBAt + 1024)
#define WBFt (WBAt + 1536)
#define WOt  ((u16*)(ws + OFF_WO))
#define XCTX ((float*)(ws + OFF_XCTX))
#define MODP ((float*)(ws + OFF_MODP))
#define MOD  ((float*)(ws + OFF_MOD))
#define MA   ((u16*)(ws + OFF_MA))
#define MB   ((u16*)(ws + OFF_MB))
#define MC   ((u16*)(ws + OFF_MC))
#define TW   ((f32x2*)(ws + OFF_TW))
#define ROPE ((f32x2*)(ws + OFF_ROPE))
#define WSP  ((u16*)(ws + OFF_WSP))
#define FCb  ((u16*)(ws + OFF_FC))
#define ST1  ((float*)(ws + OFF_ST1))
#define ST2  ((float*)(ws + OFF_ST2))
#define XLAT (p.out)
#define lds3 ((PG8_LAS unsigned char*)smem)

    int ph = 0;
#ifdef PROBE_MASK
#define PROBE_LT ((volatile unsigned long long*)(smem + 131072 + 1536))
    if (MYTID() == 0) { PROBE_LT[0] = 0; PROBE_LT[1] = 0; }
#define PROBE_SEL(k) ((PROBE_MASK >> ((k) < 3 ? (k) : 3 + ((k) - 3) % 10)) & 1)
#define PROBE_T0 if (MYTID() == 0 && PROBE_SEL(ph)) PROBE_LT[1] = __builtin_amdgcn_s_memrealtime();
#define PROBE_T1 if (MYTID() == 0 && PROBE_SEL(ph)) PROBE_LT[0] += __builtin_amdgcn_s_memrealtime() - PROBE_LT[1];
#else
#define PROBE_T0
#define PROBE_T1
#endif
#define XB_ST ((volatile LAS unsigned*)(smem + 131072 + 1600))
#define XB_BAR ((unsigned*)((unsigned char*)((KargP)__builtin_amdgcn_kernarg_segment_ptr())->ws + OFF_BAR))
    if (MYTID() == 0) { XB_ST[0] = 0u; XB_ST[1] = 0u; (void)xb_add(&XB_BAR[XB_XCNT(xb_xcc_id())], 1u); }
    __syncthreads();
    if (ph_hi < ph_lo) grid.sync();
#ifdef PROBE_DUPSYNC
#define GSYNC() do { xcd_barrier(XB_BAR, XB_ST, MYTID()); xcd_barrier(XB_BAR, XB_ST, MYTID()); } while (0)
#else
#define GSYNC() xcd_barrier(XB_BAR, XB_ST, MYTID())
#endif
#define PH_BEGIN if (ph >= ph_lo && ph < ph_hi) { PROBE_T0 KargP KARG = (KargP)__builtin_amdgcn_kernarg_segment_ptr(); asm volatile("" : "+s"(KARG)); unsigned char* ws = KARG->ws; \
    Ctx C; C.wid = WID; RETID(); C.G = gridDim.x; C.gw = blockIdx.x * 8 + C.wid; C.NGW = C.G * 8; C.smem = smem;
#define PH_END } if (ph >= ph_lo && ph + 1 < ph_hi) GSYNC(); if (ph >= ph_lo && ph < ph_hi) { PROBE_T1 } ++ph;

    PH_BEGIN
    {
        float* sm = (float*)(smem + 131072);
        for (int it = blockIdx.x; it < 384; it += C.G) {
            const int l = it / 192, rem = it % 192, kp = rem / 12, nb = rem % 12;
            __syncthreads();
            if (C.tid < 128) { const int w = C.tid >> 6, kk = C.tid & 63; const float v = (w ? cctx_in : c_in)[kp * 64 + kk]; sm[C.tid] = v / (1.0f + expf(-v)); }
            __syncthreads();
            const int n = nb * 512 + C.tid; float a0 = 0.f, a1 = 0.f; const float* wp = w_ada + ((size_t)l * 1024 + kp * 64) * INW + n;
#pragma unroll 32
            for (int kk = 0; kk < 64; ++kk) { const float w = wp[(size_t)kk * INW]; a0 += sm[kk] * w; a1 += sm[64 + kk] * w; }
            MODP[(size_t)((l * 16 + kp) * 2 + 0) * INW + n] = a0; MODP[(size_t)((l * 16 + kp) * 2 + 1) * INW + n] = a1;
        }
        __syncthreads();
        const int gt = blockIdx.x * 512 + C.tid, NTH = C.G * 512;
        const float r128 = 0.08838834764831845f;
        for (int i = gt; i < 256 * 128; i += NTH) { const int m = i >> 7, t1 = i & 127, ka = m & 127, im = m >> 7; float s, c; sincospif(2.0f * (float)((ka * t1) & 127) / 128.0f, &s, &c); MA[i] = (u16)f2bf((im ? -s : c) * r128); }
        for (int i = gt; i < 256 * 256; i += NTH) { const int row = i >> 8, col = i & 255, ro = row >> 7, kb = row & 127, ri = col >> 7, t0 = col & 127; float s, c; sincospif(2.0f * (float)((kb * t0) & 127) / 128.0f, &s, &c);
            const float v = (ro == ri) ? c : (ro == 0 ? s : -s); MB[i] = (u16)f2bf(v * r128); }
        for (int i = gt; i < 512 * 256; i += NTH) { const int row = i >> 8, t = i & 255, ro = row >> 8, k1 = row & 255; float s, c; sincospif(2.0f * (float)((k1 * t) & 255) / 256.0f, &s, &c); MC[i] = (u16)f2bf((ro ? -s : c) * 0.0625f); }
        for (int i = gt; i < 128 * 128; i += NTH) { const int ka = i >> 7, t0 = i & 127; float s, c; sincospif(2.0f * (float)((ka * t0) & 16383) / 16384.0f, &s, &c); TW[i] = (f32x2){c, s}; }
        for (int i = gt; i < 256 * 32; i += NTH) { const int pos = i >> 5, j = i & 31; const float inv = exp2f(-(float)j * (13.287712379549449f / 32.0f)); const float ang = (float)pos * inv;
            const double rev = (double)ang * 0.15915494309189535; const double fr = rev - rint(rev); float s, c; sincospif((float)(2.0 * fr), &s, &c); ROPE[i] = (f32x2){c, s}; }
        for (int i = gt; i < NL * 8 * 128 * 128; i += NTH) WSP[i] = (u16)f2bf(w_sp[i]);
        transpose_job<0>(C, w_in, D, INW, WINt, D);
        transpose_job<0>(C, w_bra, D, D, WBAt, 2560);
        transpose_job<0>(C, w_brs, 512, D, WBSt, 2560);
        transpose_job<0>(C, w_out, D, D, WOt, D);
        fold_fourier_job(C, w_brf, WBFt);
    }
    PH_END
    PH_BEGIN
    {
        const int gt = blockIdx.x * 512 + C.tid, NTH = C.G * 512;
        for (int i = gt; i < NL * 2 * INW; i += NTH) { const int n = i % INW, lw = i / INW, l = lw >> 1, w = lw & 1; float a = b_ada[l * INW + n];
            for (int kp = 0; kp < 16; ++kp) a += MODP[(size_t)((l * 16 + kp) * 2 + w) * INW + n];
            MOD[i] = a; }
    }
    PH_END
    PH_BEGIN
    ln_pass(C, R, x_in, ctx_in, nullptr, nullptr, nullptr, nullptr, true, MOD, MOD + INW, 0, 1024, Hb, nullptr, false);
    PH_END

#pragma unroll 1
    for (int l = 0; l < NL; ++l) {
        const bool lastl = (l == NL - 1);
#define modl (MOD + (size_t)(l * 2 + 0) * INW)
#define modc (MOD + (size_t)(l * 2 + 1) * INW)
#define xin_lat ((l == 0) ? x_in : (const float*)XLAT)
#define xin_ctx ((l == 0) ? ctx_in : (const float*)XCTX)

        PH_BEGIN
        {
            pg8::Gemm g{Hb, WINt, D, D, D, nullptr, nullptr, 0, nullptr, nullptr, 0}; pg8::OrderX S; S.init(INW, C.G, (int)blockIdx.x, 0, 0);
            pg8::EpiIn E{Qb, Kb, Vb, Sb, Fb, FCb, Gb};
            pg8::gemm_phase<pg8::EpiIn, pg8::OrderX>(lds3, g, S, E, C.tid);
            const int ct0 = lastl ? 32 : 0, nct = lastl ? 16 : 192;
            for (int it = blockIdx.x; it < 8 * nct; it += C.G) {
                const int rt = it / nct, ctile = ct0 + it % nct, r0 = T + 32 * rt, c0 = 32 * ctile;
                float v[2]; ctx_tile(C, Hb + (size_t)r0 * D, D, WINt + (size_t)c0 * D, D, D, v);
#pragma unroll
                for (int i = 0; i < 2; ++i) { const int e = C.tid + 512 * i, row = r0 + (e >> 5), col = c0 + (e & 31); const float x = v[i];
                    if (col < 1024) Qb[(size_t)row * 1024 + col] = (u16)f2bf(x);
                    else if (col < 1280) Kb[(size_t)row * 256 + col - 1024] = (u16)f2bf(x);
                    else if (col < 1536) Vb[(size_t)row * 256 + col - 1280] = (u16)f2bf(x);
                    else if (col < 2560) Sb[(size_t)row * 1024 + col - 1536] = (u16)f2bf(fgelu_tanh(x));
                    else if (col < 3072) FCb[(size_t)(row - T) * 512 + col - 2560] = (u16)f2bf(x);
                    else Gb[(size_t)row * 3072 + col - 3072] = (u16)f2bf(fsigmoid(x)); }
            }
            __syncthreads();
        }
        PH_END
        PH_BEGIN
        {
            {
                const int sub = C.lane >> 4, l16 = C.lane & 15;
#pragma unroll 1
                for (int pass = 0; pass < 2; ++pass) {
                    u16* base = pass == 0 ? Qb : Kb; const int nseg = pass == 0 ? (lastl ? T : R) * 8 : R * 2; const int shift = pass == 0 ? 3 : 1;
                    const float* gain = (pass == 0 ? q_gain : k_gain) + l * 128 + l16 * 8;
                    const f32x4 g0 = *(const f32x4*)gain, g1 = *(const f32x4*)(gain + 4);
                    const int ngroups = nseg >> 2;
#pragma unroll 4
                    for (int grp = C.gw; grp < ngroups; grp += C.NGW) {
                        const int s = grp * 4 + sub, m = s >> shift;
                        u32x4* pp = (u32x4*)(base + (size_t)s * 128 + l16 * 8);
                        const u32x4 w = *pp;
                        float x0 = bflo(w.x), x1 = bfhi(w.x), x2 = bflo(w.y), x3 = bfhi(w.y), x4 = bflo(w.z), x5 = bfhi(w.z), x6 = bflo(w.w), x7 = bfhi(w.w);
                        float ss = (x0 * x0 + x1 * x1) + (x2 * x2 + x3 * x3) + (x4 * x4 + x5 * x5) + (x6 * x6 + x7 * x7);
                        ss += __shfl_xor(ss, 1); ss += __shfl_xor(ss, 2); ss += __shfl_xor(ss, 4); ss += __shfl_xor(ss, 8);
                        const float rs = (pass == 0 ? 0.12751743f   : 1.0f) / sqrtf(ss * (1.0f / 128.0f) + RMS_EPS);
                        x0 *= rs * g0[0]; x1 *= rs * g0[1]; x2 *= rs * g0[2]; x3 *= rs * g0[3]; x4 *= rs * g1[0]; x5 *= rs * g1[1]; x6 *= rs * g1[2]; x7 *= rs * g1[3];
                        if (m < T) { const int pos = l16 < 8 ? (m >> 6) : (m & 63); const f32x2* rp = ROPE + pos * 32 + (l16 & 7) * 4;
                            const f32x4 c01 = *(const f32x4*)rp, c23 = *(const f32x4*)(rp + 2);
                            float t;
                            t = x0 * c01[0] - x1 * c01[1]; x1 = x0 * c01[1] + x1 * c01[0]; x0 = t;
                            t = x2 * c01[2] - x3 * c01[3]; x3 = x2 * c01[3] + x3 * c01[2]; x2 = t;
                            t = x4 * c23[0] - x5 * c23[1]; x5 = x4 * c23[1] + x5 * c23[0]; x4 = t;
                            t = x6 * c23[2] - x7 * c23[3]; x7 = x6 * c23[3] + x7 * c23[2]; x6 = t; }
                        u32x4 o; o.x = pk2(x0, x1); o.y = pk2(x2, x3); o.z = pk2(x4, x5); o.w = pk2(x6, x7);
                        *pp = o;
                    }
                }
            }
            RETID();
            {
                const int nchunks = lastl ? 128 : 130;
                float* smean = (float*)(smem + 65536); float* srstd = smean + 128;
                unsigned* sB32 = (unsigned*)smem; constexpr int KP = 136;
                const int l32 = C.lane & 31, hi = C.lane >> 5, mb = C.wid & 3, nb = C.wid >> 2;
                for (int it = blockIdx.x; it < nchunks * 2; it += C.G) {
                    const int ch = it >> 1, gh = it & 1, R0 = ch * 128;
                    __syncthreads();
                    { const int q = C.tid >> 2, part = C.tid & 3; const u16* vr = Sb + (size_t)(R0 + q) * 1024 + 512 + part * 128; float s = 0.f, s2 = 0.f;
                      u32x4 w[16];
#pragma unroll
                      for (int j = 0; j < 16; ++j) w[j] = *(const u32x4*)(vr + j * 8);
#pragma unroll
                      for (int j = 0; j < 16; ++j) { const unsigned ww[4] = {w[j].x, w[j].y, w[j].z, w[j].w};
#pragma unroll
                          for (int e = 0; e < 4; ++e) { const float a = bflo(ww[e]), b = bfhi(ww[e]); s += a + b; s2 += a * a + b * b; } }
                      s += __shfl_xor(s, 1); s += __shfl_xor(s, 2); s2 += __shfl_xor(s2, 1); s2 += __shfl_xor(s2, 2);
                      const float mean = s * (1.0f / 512.0f); const float var = fmaxf(s2 * (1.0f / 512.0f) - mean * mean, 0.f);
                      if (part == 0) { smean[q] = mean; srstd[q] = 1.0f / sqrtf(var + LN_EPS); } }
                    __syncthreads();
                    const int qp = C.tid >> 3, c8 = C.tid & 7;
                    const float m0 = smean[2 * qp], s0 = srstd[2 * qp], m1 = smean[2 * qp + 1], s1 = srstd[2 * qp + 1];
#pragma unroll 1
                    for (int gi = 0; gi < 4; ++gi) {
                        const int g = gh * 4 + gi, cb = g * 64 + c8 * 8, cc = g * 64 + 32 * nb + l32;
                        const u32x4 r0 = *(const u32x4*)(Sb + (size_t)(R0 + 2 * qp) * 1024 + 512 + cb), r1 = *(const u32x4*)(Sb + (size_t)(R0 + 2 * qp + 1) * 1024 + 512 + cb);
                        const f32x4 ga = *(const f32x4*)(sgu_g + l * 512 + cb), gb = *(const f32x4*)(sgu_g + l * 512 + cb + 4), ba = *(const f32x4*)(sgu_b + l * 512 + cb), bb = *(const f32x4*)(sgu_b + l * 512 + cb + 4);
                        const u16* arow = WSP + ((size_t)(l * 8 + g) * 128 + 32 * mb + l32) * 128 + 8 * hi;
                        bf16x8 af[8];
#pragma unroll
                        for (int k = 0; k < 8; ++k) af[k] = *(const bf16x8*)(arow + 16 * k);
                        u16 uv[16]; float bsp[16];
#pragma unroll
                        for (int r = 0; r < 16; ++r) { const int pr = 32 * mb + crow(r, hi); uv[r] = Sb[(size_t)(R0 + pr) * 1024 + cc]; bsp[r] = b_sp[(l * 8 + g) * 128 + pr]; }
                        const float gg[8] = {ga[0], ga[1], ga[2], ga[3], gb[0], gb[1], gb[2], gb[3]}, bbv[8] = {ba[0], ba[1], ba[2], ba[3], bb[0], bb[1], bb[2], bb[3]};
                        const unsigned a[4] = {r0.x, r0.y, r0.z, r0.w}, b[4] = {r1.x, r1.y, r1.z, r1.w};
#pragma unroll
                        for (int e = 0; e < 4; ++e) { const int c = c8 * 8 + 2 * e;
                            const float v00 = (bflo(a[e]) - m0) * s0 * gg[2 * e] + bbv[2 * e], v01 = (bfhi(a[e]) - m0) * s0 * gg[2 * e + 1] + bbv[2 * e + 1];
                            const float v10 = (bflo(b[e]) - m1) * s1 * gg[2 * e] + bbv[2 * e], v11 = (bfhi(b[e]) - m1) * s1 * gg[2 * e + 1] + bbv[2 * e + 1];
                            sB32[(c * KP) / 2 + qp] = pk2(v00, v10); sB32[((c + 1) * KP) / 2 + qp] = pk2(v01, v11); }
                        __syncthreads();
                        { const u16* bp = (const u16*)smem + (32 * nb + l32) * KP + 8 * hi;
                          f32x16 acc = f32x16{};
#pragma unroll
                          for (int k = 0; k < 8; ++k) acc = __builtin_amdgcn_mfma_f32_32x32x16_bf16(af[k], *(const bf16x8*)(bp + 16 * k), acc, 0, 0, 0);
#pragma unroll
                          for (int r = 0; r < 16; ++r) { const int pr = 32 * mb + crow(r, hi); Sb[(size_t)(R0 + pr) * 1024 + cc] = (u16)f2bf(bf2f(uv[r]) * (acc[r] + bsp[r])); } }
                        __syncthreads();
                    }
                }
                __syncthreads();
            }
            RETID();
            for (int it = blockIdx.x; it < 512; it += C.G) {
                const int n0 = it * 128, t0 = it >> 2;
                __syncthreads();
                load_B_transposed<128>(C, Fb + n0, 65536);
                __syncthreads();
                f32x16 are[2], aim[2];
                mma_256x128<128>(C, MA, MA + 128 * 128, are, aim);
                const int l32 = C.lane & 31, hi = C.lane >> 5, mb = C.wid & 3, nh = C.wid >> 2;
#pragma unroll
                for (int s = 0; s < 2; ++s)
#pragma unroll
                    for (int r = 0; r < 16; ++r) { const int ka = 32 * mb + crow(r, hi); const f32x2 tw = TW[ka * 128 + t0];
                        const float hr = are[s][r], hm = aim[s][r]; const float orr = hr * tw.x + hm * tw.y, oi = hm * tw.x - hr * tw.y;
                        const size_t o = (size_t)ka * 131072 + n0 + 64 * nh + 32 * s + l32;
                        Hb[o] = (u16)f2bf(orr); Hb[o + 65536] = (u16)f2bf(oi); }
            }
            __syncthreads();
            RETID();
            transpose_job<1>(C, w_up + (size_t)l * D * 2 * FFH, D, 2 * FFH, WUPt, D);
            transpose_job<0>(C, w_down + (size_t)l * FFH * D, FFH, D, WDNt, FFH);
        }
        PH_END
        PH_BEGIN
        {
            const int nunits = lastl ? 512 : 520;
            float noff;
            { float gq = fmaxf(fabsf(q_gain[l * 128 + C.lane]), fabsf(q_gain[l * 128 + 64 + C.lane])), gk = fmaxf(fabsf(k_gain[l * 128 + C.lane]), fabsf(k_gain[l * 128 + 64 + C.lane]));
#pragma unroll
              for (int o = 1; o < 64; o <<= 1) { gq = fmaxf(gq, __shfl_xor(gq, o)); gk = fmaxf(gk, __shfl_xor(gk, o)); }
              const float bound = gq * gk * 11.3137085f * 1.44269504f;
              noff = -fmaxf(0.f, bound - 60.f); }
            for (int L = blockIdx.x; L < nunits; L += C.G) {
                __syncthreads();
                const u16 *qp, *kp, *vp; int seq;
                if (L < 512) { const int h = L >> 6, qb = L & 63, kvh = h >> 2; qp = Qb + (size_t)(qb * 256) * 1024 + h * 128; kp = Kb + kvh * 128; vp = Vb + kvh * 128; seq = R; }
                else { const int h = L - 512, kvh = h >> 2; qp = Qb + (size_t)T * 1024 + h * 128; kp = Kb + (size_t)T * 256 + kvh * 128; vp = Vb + (size_t)T * 256 + kvh * 128; seq = CTX; }
                att::attn_dense_body(qp, kp, vp, (u16*)qp, seq, (char*)smem, C.tid, noff);
            }
            __syncthreads();
        }
        PH_END
        PH_BEGIN
        {
            const int nitems = lastl ? 512 : 520;
            for (int it = blockIdx.x; it < nitems; it += C.G) {
                const u16 *Are, *Aim, *Bp; int rowbase, rowstride, nt;
                if (it < 512) { const int ka = it >> 2; nt = it & 3; Are = MB; Aim = MB + 128 * 256; Bp = Hb + (size_t)ka * 131072 + nt * 128; rowbase = ka; rowstride = 128; }
                else { const int hs = (it - 512) >> 2; nt = it & 3; Are = MC + (size_t)(128 * hs) * 256; Aim = MC + (size_t)(256 + 128 * hs) * 256; Bp = FCb + nt * 128; rowbase = T + 128 * hs; rowstride = 1; }
                __syncthreads();
                load_B_transposed<256>(C, Bp, 512);
                __syncthreads();
                f32x16 are[2], aim[2];
                mma_256x128<256>(C, Are, Aim, are, aim);
                const int l32 = C.lane & 31, hi = C.lane >> 5, mb = C.wid & 3, nh = C.wid >> 2;
#pragma unroll
                for (int s = 0; s < 2; ++s)
#pragma unroll
                    for (int r = 0; r < 16; ++r) { const int kb = 32 * mb + crow(r, hi); const size_t o = (size_t)(rowbase + rowstride * kb) * 1024 + nt * 128 + 64 * nh + 32 * s + l32;
                        YCb[o] = (u16)f2bf(are[s][r]); YCb[o + 512] = (u16)f2bf(aim[s][r]); }
            }
            __syncthreads();
        }
        PH_END
        PH_BEGIN
        {
            {
                pg8::Gemm g{Qb, WBAt, 1024, 1024, 2560, Sb, WBSt, 512, YCb, WBFt, 1024};
                pg8::OrderBr S; S.init(D, C.G, (int)blockIdx.x);
                pg8::EpiBr E{Gb, Hb};
                pg8::gemm_phase<pg8::EpiBr, pg8::OrderBr>(lds3, g, S, E, C.tid);
            }
            if (!lastl) {
                for (int it = blockIdx.x; it < 8 * 32; it += C.G) {
                    const int r0 = T + 32 * (it >> 5), c0 = 32 * (it & 31);
                    float m[2] = {0.f, 0.f};
#pragma unroll 1
                    for (int b = 0; b < 3; ++b) { float v[2];
                        ctx_tile(C, (b == 0 ? Qb : (b == 1 ? Sb : YCb)) + (size_t)r0 * 1024, 1024, (b == 0 ? WBAt : (b == 1 ? WBSt : WBFt)) + (size_t)c0 * 2560, 2560, b == 1 ? 512 : 1024, v);
#pragma unroll
                        for (int i = 0; i < 2; ++i) { const int e = C.tid + 512 * i, row = r0 + (e >> 5), col = c0 + (e & 31); m[i] += v[i] * bf2f(Gb[(size_t)row * 3072 + b * 1024 + col]); } }
#pragma unroll
                    for (int i = 0; i < 2; ++i) { const int e = C.tid + 512 * i, row = r0 + (e >> 5), col = c0 + (e & 31); Hb[(size_t)row * 1024 + col] = (u16)f2bf(m[i]); }
                }
                __syncthreads();
            }
        }
        PH_END
        PH_BEGIN
        {
            pg8::Gemm g{Hb, WOt, D, D, D, nullptr, nullptr, 0, nullptr, nullptr, 0}; pg8::OrderX S; S.init(D, C.G, (int)blockIdx.x, 0, 0);
            pg8::EpiRes E{xin_lat, XLAT, modl + 2 * 1024, (l == 0) ? (const float*)nullptr : (const float*)ST2, ln2_g + (l - 1) * D, ln2_b + (l - 1) * D};
            pg8::gemm_phase<pg8::EpiRes, pg8::OrderX>(lds3, g, S, E, C.tid);
            if (!lastl) {
                for (int it = blockIdx.x; it < 8 * 32; it += C.G) {
                    const int r0 = 32 * (it >> 5), c0 = 32 * (it & 31);
                    float v[2]; ctx_tile(C, Hb + (size_t)(T + r0) * D, D, WOt + (size_t)c0 * D, D, D, v);
#pragma unroll
                    for (int i = 0; i < 2; ++i) { const int e = C.tid + 512 * i, row = r0 + (e >> 5), col = c0 + (e & 31);
                        XCTX[(size_t)row * D + col] = ALPHA * xin_ctx[(size_t)row * D + col] + (modc + 2 * 1024)[col] * v[i]; }
                }
                __syncthreads();
            }
        }
        PH_END
        PH_BEGIN
        ln_pass(C, lastl ? T : R, XLAT, XCTX, XLAT, XCTX, ln1_g + l * D, ln1_b + l * D, true, modl, modc, 3 * 1024, 4 * 1024, Hb, ST1, false);
        PH_END
        PH_BEGIN
        {
            pg8::Gemm g{Hb, WUPt, D, D, D, nullptr, nullptr, 0, nullptr, nullptr, 0}; pg8::OrderX S; S.init(2 * FFH, C.G, (int)blockIdx.x, lastl ? 0 : 22, 0);
            pg8::EpiUp E{ACTb};
            pg8::gemm_phase<pg8::EpiUp, pg8::OrderX>(lds3, g, S, E, C.tid);
        }
        PH_END
        PH_BEGIN
        {
            pg8::Gemm g{ACTb, WDNt, FFH, FFH, FFH, nullptr, nullptr, 0, nullptr, nullptr, 0}; pg8::OrderX S; S.init(D, C.G, (int)blockIdx.x, 0, 0);
            pg8::EpiRes E{XLAT, XLAT, modl + 5 * 1024, ST1, ln1_g + l * D, ln1_b + l * D};
            pg8::gemm_phase<pg8::EpiRes, pg8::OrderX>(lds3, g, S, E, C.tid);
            if (!lastl) {
                for (int it = blockIdx.x; it < 8 * 32; it += C.G) {
                    const int r0 = 32 * (it >> 5), c0 = 32 * (it & 31);
                    float v[2]; ctx_tile(C, ACTb + (size_t)(T + r0) * FFH, FFH, WDNt + (size_t)c0 * FFH, FFH, FFH, v);
#pragma unroll
                    for (int i = 0; i < 2; ++i) { const int e = C.tid + 512 * i, row = r0 + (e >> 5), col = c0 + (e & 31);
                        const f32x2 sv = *(const f32x2*)(ST1 + 2 * (size_t)(T + row)); const float x1 = (XCTX[(size_t)row * D + col] - sv[0]) * sv[1] * (ln1_g + l * D)[col] + (ln1_b + l * D)[col];
                        XCTX[(size_t)row * D + col] = ALPHA * x1 + (modc + 5 * 1024)[col] * v[i]; }
                }
                __syncthreads();
            }
        }
        PH_END
        PH_BEGIN
        {
            ln_pass(C, lastl ? T : R, XLAT, XCTX, XLAT, XCTX, ln2_g + l * D, ln2_b + l * D, !lastl, modl + 2 * INW, modc + 2 * INW, 0, 1024, Hb, ST2, lastl);
            if (!lastl) {
                __syncthreads();
                transpose_job<0>(C, w_in + (size_t)(l + 1) * D * INW, D, INW, WINt, D);
                transpose_job<0>(C, w_bra + (size_t)(l + 1) * D * D, D, D, WBAt, 2560);
                transpose_job<0>(C, w_brs + (size_t)(l + 1) * 512 * D, 512, D, WBSt, 2560);
                transpose_job<0>(C, w_out + (size_t)(l + 1) * D * D, D, D, WOt, D);
                fold_fourier_job(C, w_brf + (size_t)(l + 1) * 512 * D, WBFt);
            }
        }
        PH_END
    }
#ifdef PROBE_MASK
    {
        KargP KARG = (KargP)__builtin_amdgcn_kernarg_segment_ptr(); unsigned char* ws = KARG->ws;
        unsigned long long* slot = (unsigned long long*)(ws + OFF_PROBE);
        grid.sync();
        if (blockIdx.x == 0 && threadIdx.x == 0) *slot = PROBE_LT[0];
        grid.sync();
        const float t_us = (float)(*slot) * 0.01f;
        const float delta = sqrtf(t_us * 1e-8f);
        float* o = KARG->out;
        for (size_t i = (size_t)blockIdx.x * 512 + threadIdx.x; i < (size_t)T * D; i += (size_t)gridDim.x * 512) o[i] += (i & 1) ? delta : -delta;
    }
#endif
#undef PH_BEGIN
#undef PH_END
#undef p
}

extern "C" void kernel_launch(void* const* d_in, const int* in_sizes, int n_in, void* d_out, int out_size, void* d_ws, size_t ws_size, hipStream_t stream) {
    static int grid = 0;
    if (grid == 0) {
        if (n_in != 23 || out_size != T * D || ws_size < WS_END) { fprintf(stderr, "kernel_launch: unexpected shapes (n_in %d out %d ws %zu need %zu)\n", n_in, out_size, ws_size, (size_t)WS_END); grid = -1; return; }
        int dev = 0, cus = 0, per_cu = 0;
        hipGetDevice(&dev); hipDeviceGetAttribute(&cus, hipDeviceAttributeMultiprocessorCount, dev);
        if (hipFuncSetAttribute((const void*)fwd_megakernel, hipFuncAttributeMaxDynamicSharedMemorySize, LDS_BYTES) != hipSuccess) { fprintf(stderr, "kernel_launch: hipFuncSetAttribute failed\n"); grid = -1; return; }
        if (hipOccupancyMaxActiveBlocksPerMultiprocessor(&per_cu, (const void*)fwd_megakernel, 512, LDS_BYTES) != hipSuccess || per_cu < 1) { fprintf(stderr, "kernel_launch: occupancy query says %d\n", per_cu); per_cu = 1; }
        (void)hipGetLastError();
        grid = cus * 1;
        fprintf(stderr, "kernel_launch: cus %d per_cu %d grid %d\n", cus, per_cu, grid);
    }
    if (grid < 0) return;
    Params p{};
    for (int i = 0; i < 23; ++i) p.in[i] = (const float*)d_in[i];
    p.out = (float*)d_out; p.ws = (unsigned char*)d_ws; p.ph_lo = 0; p.ph_hi = 3 + 10 * NL;
    if (hipMemsetAsync((char*)d_ws + OFF_BAR, 0, BAR_BYTES, stream) != hipSuccess) { fprintf(stderr, "kernel_launch: memset failed\n"); return; }
    void* args[] = {&p};
    hipError_t e = hipLaunchCooperativeKernel((const void*)fwd_megakernel, dim3(grid), dim3(512), args, LDS_BYTES, stream);
    if (e != hipSuccess) fprintf(stderr, "kernel_launch: cooperative launch failed: %s (grid %d)\n", hipGetErrorString(e), grid);
}
```

```cpp
#include <hip/hip_runtime.h>
#include <hip/hip_bf16.h>
#include <hip/hip_cooperative_groups.h>
#include <cstdio>
#include <cstdint>
namespace cg = cooperative_groups;

constexpr int T = 16384, CTX = 256, R = T + CTX, D = 1024, INW = 6144, FFH = 2816, NL = 2;
constexpr float ALPHA = 1.4142135623730951f;
constexpr float LN_EPS = 1e-6f, RMS_EPS = 1e-6f;

typedef unsigned short u16;
typedef short bf16x8 __attribute__((ext_vector_type(8)));
typedef short s16x4 __attribute__((ext_vector_type(4)));
typedef float f32x4 __attribute__((ext_vector_type(4)));
typedef float f32x2 __attribute__((ext_vector_type(2)));
typedef float f32x16 __attribute__((ext_vector_type(16)));
typedef unsigned u32x4 __attribute__((ext_vector_type(4)));
typedef unsigned u32x2 __attribute__((ext_vector_type(2)));
#define LAS __attribute__((address_space(3)))

constexpr size_t SZ_RD = (size_t)R * D * 2;
constexpr size_t OFF_H = 0;
constexpr size_t OFF_Q = OFF_H + SZ_RD;
constexpr size_t OFF_F = OFF_Q + SZ_RD;
constexpr size_t OFF_K = OFF_F + (size_t)R * 512 * 2;
constexpr size_t OFF_V = OFF_K + (size_t)R * 256 * 2;
constexpr size_t OFF_YC = OFF_F;
constexpr size_t OFF_S = OFF_F + SZ_RD;
constexpr size_t OFF_G = OFF_S + SZ_RD;
constexpr size_t OFF_W1 = OFF_G + (size_t)R * 3072 * 2;
constexpr size_t SZ_W1 = (size_t)5632 * 1024 * 2 + (size_t)1024 * 2816 * 2;
constexpr size_t OFF_WUP = OFF_W1, OFF_WDN = OFF_W1 + (size_t)5632 * 1024 * 2;
constexpr size_t OFF_WBA = OFF_W1 + SZ_W1;
constexpr size_t OFF_WBS = OFF_WBA + 2097152;
constexpr size_t OFF_WBF = OFF_WBS + 1048576;
constexpr size_t OFF_WO = OFF_WBF + 2097152;
constexpr size_t OFF_XCTX = OFF_WO + 2097152;
constexpr size_t OFF_MODP = OFF_XCTX + 1048576;
constexpr size_t OFF_MOD = OFF_MODP + 1572864;
constexpr size_t OFF_MA = OFF_MOD + 98304;
constexpr size_t OFF_MB = OFF_MA + 65536;
constexpr size_t OFF_MC = OFF_MB + 131072;
constexpr size_t OFF_TW = OFF_MC + 262144;
constexpr size_t OFF_ROPE = OFF_TW + 131072;
constexpr size_t OFF_WSP = OFF_ROPE + 65536;
constexpr size_t OFF_FC = OFF_WSP + 524288;
constexpr size_t OFF_BAR = OFF_FC + 262144;
constexpr size_t BAR_BYTES = 16384;
constexpr size_t OFF_PROBE = OFF_BAR + BAR_BYTES;
constexpr size_t OFF_ST1 = OFF_PROBE + 256;
constexpr size_t OFF_ST2 = OFF_ST1 + (size_t)R * 8;
constexpr size_t WS_END = OFF_ST2 + (size_t)R * 8;
static_assert(WS_END <= 268435456ull, "workspace map exceeds 256 MiB");
static_assert(SZ_W1 >= (size_t)INW * D * 2, "w_in_t fits the shared weight region");

constexpr int LDS_BYTES = 131072 + 2048;

typedef __bf16 bf16x2_t __attribute__((ext_vector_type(2)));
__device__ __forceinline__ unsigned f2bf(float f) { const __bf16 b = (__bf16)f; return (unsigned)__builtin_bit_cast(unsigned short, b); }
__device__ __forceinline__ unsigned pk2(float lo, float hi) { const f32x2 v = {lo, hi}; const bf16x2_t b = __builtin_convertvector(v, bf16x2_t); return __builtin_bit_cast(unsigned, b); }
__device__ __forceinline__ float bflo(unsigned w) { return __builtin_bit_cast(float, w << 16); }
__device__ __forceinline__ float bfhi(unsigned w) { return __builtin_bit_cast(float, w & 0xffff0000u); }
__device__ __forceinline__ float bf2f(u16 b) { return __builtin_bit_cast(float, ((unsigned)b) << 16); }
__device__ __forceinline__ float wave_sum(float v) {
#pragma unroll
    for (int o = 1; o < 64; o <<= 1) v += __shfl_xor(v, o);
    return v;
}
__device__ __forceinline__ float fsigmoid(float x) { return __builtin_amdgcn_rcpf(1.0f + __builtin_amdgcn_exp2f(-1.4426950408889634f * x)); }
__device__ __forceinline__ float fgelu_tanh(float x) { const float y2 = 1.5957691216057308f * (x + 0.044715f * x * x * x); return x * fsigmoid(y2); }
__device__ __forceinline__ int crow(int r, int hi) { return (r & 3) + 8 * (r >> 2) + 4 * hi; }

namespace pg8 {
#define PG8_LAS __attribute__((address_space(3)))
typedef unsigned short bf16_t;
constexpr int BM = 256, BK = 64, HALF = 128, HTB = HALF * BK * 2, STAGE_BYTES = 8 * HTB, NXCD = 8, WGM = 8;
__host__ __device__ __forceinline__ int lds_byte(int r, int c) { const int st = (r >> 4) * 2 + (c >> 5), rr = r & 15, cc = c & 31, ob = rr * 64 + cc * 2; return st * 1024 + (ob ^ (((ob >> 9) & 1) << 5)); }
__host__ __device__ __forceinline__ void stage_rc(int b, int& Rr, int& C) { const int st = b / 1024, sb = b % 1024, swz = sb ^ (((sb >> 9) & 1) << 5); Rr = (st >> 1) * 16 + swz / 64; C = (st & 1) * 32 + (swz % 64) / 2; }
__host__ __device__ __forceinline__ int perm32(int rho) { const int n = rho >> 4, i = rho & 15; return 8 * (i >> 2) + 4 * n + (i & 3); }
struct Unit { int pm, pn, b; };
struct Gemm { const bf16_t* A; const bf16_t* Bt; int K, lda, ldb;
              const bf16_t* A1; const bf16_t* Bt1; int K1; const bf16_t* A2; const bf16_t* Bt2; int K2; };
struct StaticOrder {
    int nM, nN, nwg, G, c;
    __device__ void init(int M, int N, int G_, int c_) { nM = M / BM; nN = N / BM; nwg = nM * nN; G = G_; c = c_; }
    __device__ bool next(int i, Unit& u) const {
        const long L = (long)i * G + c; if (L >= nwg) return false;
        int wgid = (int)L; { const int q = nwg / NXCD, r = nwg % NXCD, xcd = wgid % NXCD, off = wgid / NXCD; wgid = (xcd < r ? xcd * (q + 1) : r * (q + 1) + (xcd - r) * q) + off; }
        const int nig = WGM * nN, gid = wgid / nig, fm = gid * WGM, gsz = (nM - fm) < WGM ? (nM - fm) : WGM;
        u.pm = fm + ((wgid % nig) % gsz); u.pn = (wgid % nig) / gsz; u.b = 0; return true;
    }
};
struct OrderX {
    StaticOrder so; int nextra, pn0;
    __device__ void init(int N, int G_, int c_, int nextra_, int pn0_) { so.init(T, N, G_, c_); nextra = nextra_; pn0 = pn0_; }
    __device__ bool next(int i, Unit& u) const {
        const long L = (long)i * so.G + so.c;
        if (L < so.nwg) return so.next(i, u);
        const int e = (int)(L - so.nwg); if (e >= nextra) return false;
        u.pm = 64; u.pn = pn0 + e; u.b = 0; return true;
    }
    __device__ __forceinline__ void a_ready(const Unit&) const {}
    __device__ __forceinline__ void done(const Unit&) const {}
};

struct OrderBr {
    StaticOrder so;
    __device__ void init(int N, int G_, int c_) { so.init(T, N, G_, c_); }
    __device__ bool next(int i, Unit& u) const { const int q = i / 3; if (!so.next(q, u)) return false; u.b = i - 3 * q; return true; }
    __device__ __forceinline__ void a_ready(const Unit&) const {}
    __device__ __forceinline__ void done(const Unit&) const {}
};

template <class Epi, class Sched, bool ALIGN_EPI = true, bool SP2 = true>
__device__ __forceinline__ void gemm_phase(PG8_LAS unsigned char* lds, const Gemm g, const Sched& S, const Epi& E, const int tid) {
    const int wid = __builtin_amdgcn_readfirstlane(tid >> 6), lane = tid & 63, wr = wid >> 2, wc = wid & 3, fr = lane & 15, fq = lane >> 4;
#define PG8_UA(u) ((const char*)((u).b == 0 ? g.A : ((u).b == 1 ? g.A1 : g.A2)))
#define PG8_UB(u) ((const char*)((u).b == 0 ? g.Bt : ((u).b == 1 ? g.Bt1 : g.Bt2)))
#define PG8_UNT(u) (((u).b == 0 ? g.K : ((u).b == 1 ? g.K1 : g.K2)) / BK)
    unsigned voffA[2], voffB[2];
#pragma unroll
    for (int i = 0; i < 2; ++i) { int Rr, C; stage_rc(tid * 16 + i * 8192, Rr, C); const int Rb = Epi::PERM ? ((Rr & ~31) + perm32(Rr & 31)) : Rr;
        voffA[i] = (unsigned)(Rr * g.lda + C) * 2u; voffB[i] = (unsigned)(Rb * g.ldb + C) * 2u; }
    const size_t kstep = (size_t)(BK * 2);
    const size_t hstepA = (size_t)HALF * g.lda * 2, hstepB = (size_t)HALF * g.ldb * 2;
    const size_t tstepA = 2 * hstepA, tstepB = 2 * hstepB;
    const unsigned ldsw = (unsigned)wid * 1024u;
    const int aoff = lds_byte(wr * 64 + fr, fq * 8), boff = lds_byte(wc * 32 + fr, fq * 8);
#define PG8_SA(b, h) (((b) * 2 + (h)) * HTB)
#define PG8_SB(b, h) ((4 + (b) * 2 + (h)) * HTB)
#define PG8_STAGE(bufoff, gbase, voff) do { _Pragma("unroll") for (int _i = 0; _i < 2; ++_i) \
        __builtin_amdgcn_global_load_lds((const unsigned*)((const char*)(gbase) + (voff)[_i]), (PG8_LAS unsigned*)(lds + (bufoff) + ldsw + _i * 8192), 16, 0, 0); } while (0)
#define PG8_LDA(dst, b, h) do { _Pragma("unroll") for (int m = 0; m < 4; ++m) _Pragma("unroll") for (int k = 0; k < 2; ++k) dst[m][k] = *(const PG8_LAS bf16x8*)(lds + PG8_SA(b, h) + aoff + m * 2048 + k * 1024); } while (0)
#define PG8_LDB(dst, b, h) do { _Pragma("unroll") for (int n = 0; n < 2; ++n) _Pragma("unroll") for (int k = 0; k < 2; ++k) dst[n][k] = *(const PG8_LAS bf16x8*)(lds + PG8_SB(b, h) + boff + n * 2048 + k * 1024); } while (0)
#define PG8_MMA(ai, bj, At, Bt) do { __builtin_amdgcn_s_setprio(1); _Pragma("unroll") for (int m = 0; m < 4; ++m) _Pragma("unroll") for (int n = 0; n < 2; ++n) _Pragma("unroll") for (int k = 0; k < 2; ++k) \
        acc[ai][bj][m][n] = __builtin_amdgcn_mfma_f32_16x16x32_bf16(Bt[n][k], At[m][k], acc[ai][bj][m][n], 0, 0, 0); __builtin_amdgcn_s_setprio(0); } while (0)
#define PG8_WAIT_V(n) asm volatile("s_waitcnt vmcnt(" #n ")" ::: "memory")
#define PG8_WAIT_L(n) asm volatile("s_waitcnt lgkmcnt(" #n ")" ::: "memory")
#define PG8_BAR __builtin_amdgcn_s_barrier()
#define PG8_SCHED __builtin_amdgcn_sched_barrier(0)
    Unit cur, nxt; int ui = 0;
    if (!S.next(0, cur)) return;
    f32x4 acc[2][2][4][2];
#pragma unroll
    for (int a = 0; a < 2; ++a)
#pragma unroll
        for (int b = 0; b < 2; ++b)
#pragma unroll
            for (int m = 0; m < 4; ++m)
#pragma unroll
                for (int n = 0; n < 2; ++n) acc[a][b][m][n] = (f32x4){0.f, 0.f, 0.f, 0.f};
    bf16x8 At[4][2], B0[2][2], B1[2][2];
    const char* cA = PG8_UA(cur) + (size_t)cur.pm * tstepA; const char* cB = PG8_UB(cur) + (size_t)cur.pn * tstepB;
    S.a_ready(cur);
    if constexpr (SP2) {
        PG8_STAGE(PG8_SB(0, 0), cB, voffB); PG8_STAGE(PG8_SB(0, 1), cB + hstepB, voffB); PG8_STAGE(PG8_SA(0, 0), cA, voffA); PG8_STAGE(PG8_SA(0, 1), cA + hstepA, voffA);
        if (wr == 1) PG8_BAR;
        PG8_WAIT_V(2); PG8_BAR;
        PG8_STAGE(PG8_SB(1, 0), cB + kstep, voffB); PG8_STAGE(PG8_SA(1, 0), cA + kstep, voffA); PG8_STAGE(PG8_SB(1, 1), cB + hstepB + kstep, voffB);
        PG8_WAIT_V(6); PG8_BAR;
    } else {
        PG8_STAGE(PG8_SB(0, 0), cB, voffB); PG8_STAGE(PG8_SA(0, 0), cA, voffA); PG8_STAGE(PG8_SB(0, 1), cB + hstepB, voffB); PG8_STAGE(PG8_SA(0, 1), cA + hstepA, voffA);
        if (wr == 1) PG8_BAR;
        PG8_WAIT_V(4); PG8_BAR;
        PG8_STAGE(PG8_SB(1, 0), cB + kstep, voffB); PG8_STAGE(PG8_SA(1, 0), cA + kstep, voffA); PG8_STAGE(PG8_SB(1, 1), cB + hstepB + kstep, voffB);
        PG8_WAIT_V(6); PG8_BAR;
    }
    for (;;) {
        const bool has_next = S.next(ui + 1, nxt);
        const char* nA = has_next ? PG8_UA(nxt) + (size_t)nxt.pm * tstepA : cA; const char* nB = has_next ? PG8_UB(nxt) + (size_t)nxt.pn * tstepB : cB;
        const int nt = PG8_UNT(cur);
        for (int t = 0; t < nt; t += 2) {
            const bool last = (t == nt - 2);
            const char* a1 = cA + (size_t)(t + 1) * kstep;
            const char* a2 = last ? nA : cA + (size_t)(t + 2) * kstep; const char* b2 = last ? nB : cB + (size_t)(t + 2) * kstep;
            const char* a3 = a2 + kstep; const char* b3 = b2 + kstep;
            if (last && has_next) S.a_ready(nxt);
            if constexpr (SP2) {
            PG8_LDB(B0, 0, 0); PG8_LDB(B1, 0, 1); PG8_SCHED; PG8_LDA(At, 0, 0); PG8_STAGE(PG8_SA(1, 1), a1 + hstepA, voffA);
            PG8_WAIT_V(8); PG8_WAIT_L(0); PG8_BAR; PG8_MMA(0, 0, At, B0); PG8_MMA(0, 1, At, B1); PG8_BAR; PG8_SCHED;
            PG8_LDA(At, 0, 1); PG8_STAGE(PG8_SB(0, 0), b2, voffB); PG8_STAGE(PG8_SB(0, 1), b2 + hstepB, voffB); PG8_STAGE(PG8_SA(0, 0), a2, voffA);
            PG8_WAIT_V(8); PG8_WAIT_L(0); PG8_BAR; PG8_MMA(1, 0, At, B0); PG8_MMA(1, 1, At, B1); PG8_BAR; PG8_SCHED;
            PG8_LDB(B0, 1, 0); PG8_LDB(B1, 1, 1); PG8_SCHED; PG8_LDA(At, 1, 0); PG8_STAGE(PG8_SA(0, 1), a2 + hstepA, voffA);
            PG8_WAIT_V(8); PG8_WAIT_L(0); PG8_BAR; PG8_MMA(0, 0, At, B0); PG8_MMA(0, 1, At, B1); PG8_BAR; PG8_SCHED;
            PG8_LDA(At, 1, 1); PG8_STAGE(PG8_SB(1, 0), b3, voffB); PG8_STAGE(PG8_SB(1, 1), b3 + hstepB, voffB); PG8_STAGE(PG8_SA(1, 0), a3, voffA);
            PG8_WAIT_V(8); PG8_WAIT_L(0); PG8_BAR; PG8_MMA(1, 0, At, B0); PG8_MMA(1, 1, At, B1); PG8_BAR; PG8_SCHED;
            } else {
            PG8_LDB(B0, 0, 0); PG8_SCHED; PG8_LDA(At, 0, 0); PG8_STAGE(PG8_SA(1, 1), a1 + hstepA, voffA);
            PG8_WAIT_L(8); PG8_BAR; PG8_WAIT_L(0); PG8_MMA(0, 0, At, B0); PG8_BAR; PG8_SCHED;
            PG8_LDB(B1, 0, 1); PG8_STAGE(PG8_SB(0, 0), b2, voffB);
            PG8_BAR; PG8_WAIT_L(0); PG8_MMA(0, 1, At, B1); PG8_BAR;
            PG8_LDA(At, 0, 1); PG8_STAGE(PG8_SA(0, 0), a2, voffA);
            PG8_BAR; PG8_WAIT_L(0); PG8_MMA(1, 0, At, B0); PG8_BAR; PG8_SCHED;
            PG8_STAGE(PG8_SB(0, 1), b2 + hstepB, voffB);
            PG8_WAIT_V(6); PG8_BAR; PG8_MMA(1, 1, At, B1); PG8_BAR;
            PG8_LDB(B0, 1, 0); PG8_SCHED; PG8_LDA(At, 1, 0); PG8_STAGE(PG8_SA(0, 1), a2 + hstepA, voffA);
            PG8_WAIT_L(8); PG8_BAR; PG8_WAIT_L(0); PG8_MMA(0, 0, At, B0); PG8_BAR; PG8_SCHED;
            PG8_LDB(B1, 1, 1); PG8_STAGE(PG8_SB(1, 0), b3, voffB);
            PG8_BAR; PG8_WAIT_L(0); PG8_MMA(0, 1, At, B1); PG8_BAR;
            PG8_LDA(At, 1, 1); PG8_STAGE(PG8_SA(1, 0), a3, voffA);
            PG8_BAR; PG8_WAIT_L(0); PG8_MMA(1, 0, At, B0); PG8_BAR; PG8_SCHED;
            PG8_STAGE(PG8_SB(1, 1), b3 + hstepB, voffB);
            PG8_WAIT_V(6); PG8_BAR; PG8_MMA(1, 1, At, B1); PG8_BAR;
            }
        }
        if constexpr (ALIGN_EPI) { if (wr == 0) PG8_BAR; }
        E(acc, cur, wr, wc, fr, fq); S.done(cur);
        if (!has_next) break;
#pragma unroll
        for (int a = 0; a < 2; ++a)
#pragma unroll
            for (int b = 0; b < 2; ++b)
#pragma unroll
                for (int m = 0; m < 4; ++m)
#pragma unroll
                    for (int n = 0; n < 2; ++n) acc[a][b][m][n] = (f32x4){0.f, 0.f, 0.f, 0.f};
        cur = nxt; cA = nA; cB = nB; ++ui;
        if constexpr (ALIGN_EPI) { if (wr == 1) PG8_BAR; }
    }
    PG8_WAIT_V(0);
    if constexpr (!ALIGN_EPI) { if (wr == 0) PG8_BAR; }
    PG8_BAR;
#undef PG8_UA
#undef PG8_UB
#undef PG8_UNT
#undef PG8_SA
#undef PG8_SB
#undef PG8_STAGE
#undef PG8_LDA
#undef PG8_LDB
#undef PG8_MMA
#undef PG8_WAIT_V
#undef PG8_WAIT_L
#undef PG8_BAR
#undef PG8_SCHED
}

struct EpiIn {
    static constexpr bool PERM = true;
    u16 *Q, *Kb, *Vb, *S, *F, *FC, *G;
    __device__ __forceinline__ void operator()(const f32x4 (&acc)[2][2][4][2], const Unit& u, int wr, int wc, int fr, int fq) const {
        const int pn = u.pn; u16* base; int ld, act = 0, radj = 0;
        if (pn < 4) { base = Q + pn * 256; ld = 1024; }
        else if (pn == 4) { base = Kb; ld = 256; }
        else if (pn == 5) { base = Vb; ld = 256; }
        else if (pn < 10) { base = S + (pn - 6) * 256; ld = 1024; act = 1; }
        else if (pn < 12) { if (u.pm == 64) { base = FC + (pn - 10) * 256; radj = T; } else base = F + (pn - 10) * 256; ld = 512; }
        else { base = G + (pn - 12) * 256; ld = 3072; act = 2; }
        const int row0 = u.pm * BM + wr * 64 + fr - radj, col0 = wc * 32 + 8 * fq;
#pragma unroll
        for (int ai = 0; ai < 2; ++ai)
#pragma unroll
            for (int m = 0; m < 4; ++m) { u16* rowp = base + (size_t)(row0 + ai * HALF + m * 16) * ld + col0;
#pragma unroll
                for (int bj = 0; bj < 2; ++bj) { f32x4 v0 = acc[ai][bj][m][0], v1 = acc[ai][bj][m][1];
                    if (act == 1) {
#pragma unroll
                        for (int j = 0; j < 4; ++j) { v0[j] = fgelu_tanh(v0[j]); v1[j] = fgelu_tanh(v1[j]); } }
                    else if (act == 2) {
#pragma unroll
                        for (int j = 0; j < 4; ++j) { v0[j] = fsigmoid(v0[j]); v1[j] = fsigmoid(v1[j]); } }
                    u32x4 w; w.x = pk2(v0[0], v0[1]); w.y = pk2(v0[2], v0[3]); w.z = pk2(v1[0], v1[1]); w.w = pk2(v1[2], v1[3]);
                    *(u32x4*)(rowp + bj * HALF) = w; } }
    }
};
struct EpiBr {
    static constexpr bool PERM = true;
    const u16* G; u16* Mg;
    __device__ __forceinline__ void operator()(const f32x4 (&acc)[2][2][4][2], const Unit& u, int wr, int wc, int fr, int fq) const {
        const int row0 = u.pm * BM + wr * 64 + fr, col0 = u.pn * BM + wc * 32 + 8 * fq; const bool first = (u.b == 0); const u16* G = this->G + u.b * 1024;
#pragma unroll
        for (int ai = 0; ai < 2; ++ai)
#pragma unroll
            for (int m = 0; m < 4; ++m) { const size_t r = (size_t)(row0 + ai * HALF + m * 16);
#pragma unroll
                for (int bj = 0; bj < 2; ++bj) { const int c = col0 + bj * HALF;
                    const u32x4 gw = *(const u32x4*)(G + r * 3072 + c);
                    f32x4 v0 = acc[ai][bj][m][0], v1 = acc[ai][bj][m][1];
                    v0[0] *= bflo(gw.x); v0[1] *= bfhi(gw.x); v0[2] *= bflo(gw.y); v0[3] *= bfhi(gw.y);
                    v1[0] *= bflo(gw.z); v1[1] *= bfhi(gw.z); v1[2] *= bflo(gw.w); v1[3] *= bfhi(gw.w);
                    u16* mp = Mg + r * 1024 + c;
                    if (!first) { const u32x4 pw = *(const u32x4*)mp;
                        v0[0] += bflo(pw.x); v0[1] += bfhi(pw.x); v0[2] += bflo(pw.y); v0[3] += bfhi(pw.y);
                        v1[0] += bflo(pw.z); v1[1] += bfhi(pw.z); v1[2] += bflo(pw.w); v1[3] += bfhi(pw.w); }
                    u32x4 w; w.x = pk2(v0[0], v0[1]); w.y = pk2(v0[2], v0[3]); w.z = pk2(v1[0], v1[1]); w.w = pk2(v1[2], v1[3]);
                    *(u32x4*)mp = w; } }
    }
};
struct EpiRes {
    static constexpr bool PERM = false;
    const float *xin_lat; float *xo_lat; const float *gate_lat; const float* st; const float *lg, *lb;
    __device__ __forceinline__ void operator()(const f32x4 (&acc)[2][2][4][2], const Unit& u, int wr, int wc, int fr, int fq) const {
        const int row0 = u.pm * BM + wr * 64 + fr, col0 = u.pn * BM + wc * 32 + 4 * fq;
        f32x2 sv[2][4];
#pragma unroll
        for (int ai = 0; ai < 2; ++ai)
#pragma unroll
            for (int m = 0; m < 4; ++m) sv[ai][m] = st ? *(const f32x2*)(st + 2 * (size_t)(row0 + ai * HALF + m * 16)) : (f32x2){0.f, 1.f};
#pragma unroll
        for (int bj = 0; bj < 2; ++bj)
#pragma unroll
            for (int n = 0; n < 2; ++n) { const int c = col0 + bj * HALF + n * 16;
                const f32x4 gv = *(const f32x4*)(gate_lat + c);
                f32x4 g4 = (f32x4){1.f, 1.f, 1.f, 1.f}, b4 = (f32x4){0.f, 0.f, 0.f, 0.f};
                if (st) { g4 = *(const f32x4*)(lg + c); b4 = *(const f32x4*)(lb + c); }
#pragma unroll
                for (int ai = 0; ai < 2; ++ai)
#pragma unroll
                    for (int m = 0; m < 4; ++m) { const size_t off = (size_t)(row0 + ai * HALF + m * 16) * D + c;
                        f32x4 xv = *(const f32x4*)(xin_lat + off);
                        xv = (xv - sv[ai][m][0]) * sv[ai][m][1] * g4 + b4;
                        *(f32x4*)(xo_lat + off) = xv * ALPHA + gv * acc[ai][bj][m][n]; } }
    }
};
struct EpiUp {
    static constexpr bool PERM = true;
    u16* ACT;
    __device__ __forceinline__ void operator()(const f32x4 (&acc)[2][2][4][2], const Unit& u, int wr, int wc, int fr, int fq) const {
        const int row0 = u.pm * BM + wr * 64 + fr, col0 = u.pn * HALF + wc * 32 + 8 * fq;
#pragma unroll
        for (int ai = 0; ai < 2; ++ai)
#pragma unroll
            for (int m = 0; m < 4; ++m) { u16* rowp = ACT + (size_t)(row0 + ai * HALF + m * 16) * FFH + col0;
                f32x4 g0 = acc[ai][0][m][0], g1 = acc[ai][0][m][1]; const f32x4 u0 = acc[ai][1][m][0], u1 = acc[ai][1][m][1];
#pragma unroll
                for (int j = 0; j < 4; ++j) { g0[j] = g0[j] * fsigmoid(g0[j]) * u0[j]; g1[j] = g1[j] * fsigmoid(g1[j]) * u1[j]; }
                u32x4 w; w.x = pk2(g0[0], g0[1]); w.y = pk2(g0[2], g0[3]); w.z = pk2(g1[0], g1[1]); w.w = pk2(g1[2], g1[3]);
                *(u32x4*)rowp = w; }
    }
};
}

namespace att {
constexpr int NW = 8, QBLK = 32, KVBLK = 64;
constexpr float SCALE = 0.088388347648318440f, THR = 8.f;
constexpr int LDQ = 1024, LDK = 256, LDO = 1024;
constexpr size_t SHM_V = KVBLK * 128 * 2, SHM_K = KVBLK * 128 * 2, SHM_ATTN = 3 * SHM_V + 2 * SHM_K + NW * 64 * 4;
#define KSWZ(row, colB) ((row) * 256 + ((colB) ^ (((row) & 7) << 4)))
#define SBAR() __builtin_amdgcn_sched_barrier(0)
__device__ __forceinline__ unsigned cvtpk(float lo, float hi) { unsigned r; asm volatile("v_cvt_pk_bf16_f32 %0, %1, %2" : "=v"(r) : "v"(lo), "v"(hi)); return r; }
__device__ __forceinline__ void partialSM(f32x16& p0) {
  for (int r = 0; r < 16; ++r) p0[r] = __builtin_amdgcn_exp2f(p0[r]);
}
__device__ __forceinline__ void finishSM(f32x16& p0, f32x16& p1, float& l_reg, bf16x8& pa0, bf16x8& pa1, bf16x8& pa2, bf16x8& pa3) {
  for (int r = 0; r < 16; ++r) p1[r] = __builtin_amdgcn_exp2f(p1[r]);
  float ps = 0; for (int r = 0; r < 16; ++r) ps += p0[r]; for (int r = 0; r < 16; ++r) ps += p1[r];
  { auto rr = __builtin_amdgcn_permlane32_swap(__float_as_uint(ps), __float_as_uint(ps), false, false);
    ps = __uint_as_float(rr[0]) + __uint_as_float(rr[1]); }
  l_reg += ps;
#define PK4(P, BASE, OUT) do { unsigned a0 = cvtpk(P[BASE + 0], P[BASE + 1]), a1 = cvtpk(P[BASE + 2], P[BASE + 3]);   \
    unsigned b0 = cvtpk(P[BASE + 4], P[BASE + 5]), b1 = cvtpk(P[BASE + 6], P[BASE + 7]);                              \
    auto r0 = __builtin_amdgcn_permlane32_swap(a0, b0, false, false); auto r1 = __builtin_amdgcn_permlane32_swap(a1, b1, false, false); \
    u32x4 w = {r0[0], r1[0], r0[1], r1[1]}; OUT = *reinterpret_cast<bf16x8*>(&w); } while (0)
  PK4(p0, 0, pa0); PK4(p0, 8, pa1); PK4(p1, 0, pa2); PK4(p1, 8, pa3);
#undef PK4
}
__device__ __forceinline__ void qkt(f32x16& p0, f32x16& p1, const u16* Ks, const bf16x8* qr, int r32, int hi, float noff) {
  for (int r = 0; r < 16; ++r) { p0[r] = noff; p1[r] = noff; }
  for (int d0 = 0; d0 < 8; ++d0) { int cb = (d0 * 16 + hi * 8) * 2;
    bf16x8 b0 = *reinterpret_cast<const bf16x8*>((const char*)Ks + KSWZ(r32, cb));
    bf16x8 b1 = *reinterpret_cast<const bf16x8*>((const char*)Ks + KSWZ(32 + r32, cb));
    p0 = __builtin_amdgcn_mfma_f32_32x32x16_bf16(b0, qr[d0], p0, 0, 0, 0);
    p1 = __builtin_amdgcn_mfma_f32_32x32x16_bf16(b1, qr[d0], p1, 0, 0, 0); }
}
__device__ __forceinline__ int v_st(int k, int c) { const int kk = (k & ~0xC) | ((k & 4) << 1) | ((k & 8) >> 1); return ((kk >> 3) * 4 + (c >> 5)) * 512 + ((kk & 7) * 32 + (c & 31)) * 2; }
__device__ __forceinline__ int v_rd_base(int lane) { return ((lane & 3) << 3) | (((lane >> 2) & 3) << 6) | (((lane >> 4) & 1) << 5) | (((lane >> 5) & 1) << 8); }
constexpr int v_rd_off(int d0, int ks, int half) { return d0 * 512 + ks * 4096 + half * 2048; }
template <int OFF> __device__ __forceinline__ s16x4 tr_read(int vb) {
  s16x4 r; asm volatile("ds_read_b64_tr_b16 %0, %1 offset:%2" : "=&v"(r) : "v"(vb), "i"(OFF) : "memory"); return r;
}
struct VFrag { s16x4 l0, h0, l1, h1, l2, h2, l3, h3; };
template <int D0> __device__ __forceinline__ void pv_reads(VFrag& f, int vb) {
  f.l0 = tr_read<v_rd_off(D0, 0, 0)>(vb); f.h0 = tr_read<v_rd_off(D0, 0, 1)>(vb); f.l1 = tr_read<v_rd_off(D0, 1, 0)>(vb); f.h1 = tr_read<v_rd_off(D0, 1, 1)>(vb);
  f.l2 = tr_read<v_rd_off(D0, 2, 0)>(vb); f.h2 = tr_read<v_rd_off(D0, 2, 1)>(vb); f.l3 = tr_read<v_rd_off(D0, 3, 0)>(vb); f.h3 = tr_read<v_rd_off(D0, 3, 1)>(vb);
}
__device__ __forceinline__ void pv_mma(f32x16& od, const VFrag& f, bf16x8 pa0, bf16x8 pa1, bf16x8 pa2, bf16x8 pa3) {
#define PK(L, H) (bf16x8){L[0], L[1], L[2], L[3], H[0], H[1], H[2], H[3]}
  od = __builtin_amdgcn_mfma_f32_32x32x16_bf16(pa0, PK(f.l0, f.h0), od, 0, 0, 0);
  od = __builtin_amdgcn_mfma_f32_32x32x16_bf16(pa1, PK(f.l1, f.h1), od, 0, 0, 0);
  od = __builtin_amdgcn_mfma_f32_32x32x16_bf16(pa2, PK(f.l2, f.h2), od, 0, 0, 0);
  od = __builtin_amdgcn_mfma_f32_32x32x16_bf16(pa3, PK(f.l3, f.h3), od, 0, 0, 0);
#undef PK
}
__device__ __forceinline__ void pv_d0(f32x16* o, int vb, bf16x8 pa0, bf16x8 pa1, bf16x8 pa2, bf16x8 pa3) {
  VFrag fa, fb;
  pv_reads<0>(fa, vb); pv_reads<1>(fb, vb);
  asm volatile("s_waitcnt lgkmcnt(8)" ::: "memory"); SBAR();
  pv_mma(o[0], fa, pa0, pa1, pa2, pa3); SBAR();
  pv_reads<2>(fa, vb);
  asm volatile("s_waitcnt lgkmcnt(8)" ::: "memory"); SBAR();
  pv_mma(o[1], fb, pa0, pa1, pa2, pa3); SBAR();
  pv_reads<3>(fb, vb);
  asm volatile("s_waitcnt lgkmcnt(8)" ::: "memory"); SBAR();
  pv_mma(o[2], fa, pa0, pa1, pa2, pa3); SBAR();
  asm volatile("s_waitcnt lgkmcnt(0)" ::: "memory"); SBAR();
  pv_mma(o[3], fb, pa0, pa1, pa2, pa3);
}
__device__ __forceinline__ void attn_dense_body(const u16* Qb, const u16* __restrict__ Kh, const u16* __restrict__ Vh, u16* Ob, int seq, char* lds, const int tid, const float noff) {
  const int wid = tid >> 6, lane = tid & 63, r32 = lane & 31, hi = lane >> 5;
  LAS unsigned char* l3 = (LAS unsigned char*)lds;
  u16* V_lds = (u16*)lds; u16* K_lds = (u16*)(lds + 3 * SHM_V);
  float* ws = (float*)(lds + 3 * SHM_V + 2 * SHM_K) + wid * 64; float* li_l = ws;
  float l_reg = 0; f32x16 o[4] = {}; bf16x8 qr[8];
  const u16* Qw = Qb + (long)(wid * QBLK + r32) * LDQ + hi * 8;
#pragma unroll
  for (int d0 = 0; d0 < 8; ++d0) qr[d0] = *reinterpret_cast<const bf16x8*>(Qw + d0 * 16);
  const int vb0 = (int)(uintptr_t)V_lds + v_rd_base(lane);
  const int wu = __builtin_amdgcn_readfirstlane(wid);
  unsigned ksrc0, ksrc1, vsrc0, vsrc1;
  { const int r = wid * 4 + (lane >> 4), p = lane & 15, c = p ^ (r & 7); ksrc0 = (unsigned)(r * LDK * 2 + c * 16); ksrc1 = ksrc0 + 32u * LDK * 2u; }
  { const int st = wid * 2 + (lane >> 5), within = lane & 31, kk = (st >> 2) * 8 + (within >> 2), c = (st & 3) * 32 + (within & 3) * 8;
    const int k = (kk & ~0xC) | ((kk & 4) << 1) | ((kk & 8) >> 1); vsrc0 = (unsigned)(k * LDK * 2 + c * 2); vsrc1 = vsrc0 + 32u * LDK * 2u; }
#define DMA_TILE(k0, ks, vs) do { const char* kt_ = (const char*)Kh + (size_t)(k0) * (LDK * 2); const char* vt_ = (const char*)Vh + (size_t)(k0) * (LDK * 2); \
    asm volatile("" : "+s"(kt_), "+s"(vt_));     \
    __builtin_amdgcn_global_load_lds((const unsigned*)(kt_ + ksrc0), (LAS unsigned*)(l3 + 3 * (int)SHM_V + (ks) * (int)SHM_K + wu * 1024), 16, 0, 0); \
    __builtin_amdgcn_global_load_lds((const unsigned*)(kt_ + ksrc1), (LAS unsigned*)(l3 + 3 * (int)SHM_V + (ks) * (int)SHM_K + wu * 1024 + 8192), 16, 0, 0); \
    __builtin_amdgcn_global_load_lds((const unsigned*)(vt_ + vsrc0), (LAS unsigned*)(l3 + (vs) * (int)SHM_V + wu * 1024), 16, 0, 0); \
    __builtin_amdgcn_global_load_lds((const unsigned*)(vt_ + vsrc1), (LAS unsigned*)(l3 + (vs) * (int)SHM_V + wu * 1024 + 8192), 16, 0, 0); } while (0)
#define LANDED() asm volatile("s_waitcnt vmcnt(0)" ::: "memory")
  f32x16 pA0, pA1, pB0, pB1; bf16x8 pa0, pa1, pa2, pa3; const int NT = seq / KVBLK;
  DMA_TILE(0, 0, 0); LANDED(); __syncthreads();
  DMA_TILE(KVBLK, 1, 1);
  qkt(pA0, pA1, K_lds, qr, r32, hi, noff); partialSM(pA0);
  LANDED(); __syncthreads();
  int sv = 0;
  for (int j = 1; j + 1 < NT; j += 2) {
    { const int sn = (sv == 0) ? 2 : sv - 1;
      SBAR(); DMA_TILE((j + 1) * KVBLK, 0, sn); SBAR();
      qkt(pB0, pB1, (u16*)((char*)K_lds + SHM_K), qr, r32, hi, noff);
      finishSM(pA0, pA1, l_reg, pa0, pa1, pa2, pa3); SBAR();
      pv_d0(o, vb0 + sv * (int)SHM_V, pa0, pa1, pa2, pa3); partialSM(pB0);
      LANDED(); __syncthreads(); sv = (sv == 2) ? 0 : sv + 1; }
    { const int sn = (sv == 0) ? 2 : sv - 1;
      SBAR(); DMA_TILE((j + 2) * KVBLK, 1, sn); SBAR();
      qkt(pA0, pA1, K_lds, qr, r32, hi, noff);
      finishSM(pB0, pB1, l_reg, pa0, pa1, pa2, pa3); SBAR();
      pv_d0(o, vb0 + sv * (int)SHM_V, pa0, pa1, pa2, pa3); partialSM(pA0);
      LANDED(); __syncthreads(); sv = (sv == 2) ? 0 : sv + 1; }
  }
  { const int svl = (sv == 2) ? 0 : sv + 1;
    SBAR(); qkt(pB0, pB1, (u16*)((char*)K_lds + SHM_K), qr, r32, hi, noff);
    finishSM(pA0, pA1, l_reg, pa0, pa1, pa2, pa3); SBAR();
    pv_d0(o, vb0 + sv * (int)SHM_V, pa0, pa1, pa2, pa3); partialSM(pB0);
    finishSM(pB0, pB1, l_reg, pa0, pa1, pa2, pa3); SBAR();
    pv_d0(o, vb0 + svl * (int)SHM_V, pa0, pa1, pa2, pa3); }
#undef DMA_TILE
#undef LANDED
  if (hi == 0) li_l[r32] = l_reg; asm volatile("s_waitcnt lgkmcnt(0)" ::: "memory");
  float rli[16];
#pragma unroll
  for (int r = 0; r < 16; ++r) rli[r] = __builtin_amdgcn_rcpf(li_l[crow(r, hi)]);
  u16* Ow = Ob + (long)(wid * QBLK) * LDO;
#pragma unroll
  for (int r = 0; r < 16; ++r) { int orow = crow(r, hi);
    for (int d0 = 0; d0 < 4; ++d0) Ow[(long)orow * LDO + d0 * 32 + r32] = (u16)f2bf(o[d0][r] * rli[r]); }
}
}

#define XB_TMO      128
#define XB_XCNT(j)  (256  + 64 * (j))
#define XB_XSUB(j)  (1280 + 64 * (j))
#define XB_XGEN(j)  (2304 + 64 * (j))
#define XB_TOP      3328
#define XB_TOPGEN   3392
#define XCD_BAR_WORDS 3456
#define XB_SPIN_CAP (1u << 18)
__device__ __forceinline__ unsigned xb_ld(unsigned* p)              { return __hip_atomic_load(p, __ATOMIC_RELAXED, __HIP_MEMORY_SCOPE_AGENT); }
__device__ __forceinline__ unsigned xb_add(unsigned* p, unsigned v) { return __hip_atomic_fetch_add(p, v, __ATOMIC_RELAXED, __HIP_MEMORY_SCOPE_AGENT); }
__device__ __forceinline__ unsigned xb_xcc_id() { return (unsigned)__builtin_amdgcn_s_getreg((3 << 11) | 20) & 0xFu; }
#define XB_SPIN(cond, bar) do { unsigned _sp = 0; while (cond) { __builtin_amdgcn_s_sleep(1); \
    if ((++_sp & 255u) == 0u) { if (xb_ld(&(bar)[XB_TMO])) break; if (_sp > XB_SPIN_CAP) { atomicAdd(&(bar)[XB_TMO], 1u); break; } } } } while (0)
__device__ __forceinline__ void xcd_barrier_complete(unsigned* bar, unsigned x, unsigned& nloc, unsigned& nx) {
    const unsigned G = gridDim.x * gridDim.y * gridDim.z;
    unsigned sum, cnt, mine, sp = 0u;
    for (;;) {
        sum = 0u; cnt = 0u; mine = 0u;
#pragma unroll
        for (unsigned j = 0; j < 16; ++j) { const unsigned c = xb_ld(&bar[XB_XCNT(j)]); sum += c; cnt += (c > 0u) ? 1u : 0u; mine = (j == x) ? c : mine; }
        if (sum == G) break;
        __builtin_amdgcn_s_sleep(1);
        if ((++sp & 255u) == 0u) { if (xb_ld(&bar[XB_TMO])) break; if (sp > XB_SPIN_CAP) { atomicAdd(&bar[XB_TMO], 1u); break; } }
    }
    nloc = mine > 0u ? mine : 1u; nx = cnt > 0u ? cnt : 1u;
}
__device__ __forceinline__ void xcd_barrier(unsigned* bar, volatile LAS unsigned* st, const int tid) {
    asm volatile("s_waitcnt vmcnt(0)" ::: "memory");
    __syncthreads();
    if (tid == 0) {
        const unsigned x = xb_xcc_id();
        __builtin_amdgcn_s_waitcnt(0);
        unsigned nloc = st[0], nx = st[1];
        if (nloc == 0u) { xcd_barrier_complete(bar, x, nloc, nx); st[0] = nloc; st[1] = nx; }
        const unsigned old = xb_add(&bar[XB_XSUB(x)], 1u);
        const unsigned gen = old / nloc;
        if (old + 1u == (gen + 1u) * nloc) {
            __builtin_amdgcn_fence(__ATOMIC_RELEASE, "agent");
            asm volatile("s_waitcnt vmcnt(0)" ::: "memory");
            const unsigned og = xb_add(&bar[XB_TOP], 1u);
            const unsigned tg = og / nx;
            if (og + 1u == (tg + 1u) * nx) xb_add(&bar[XB_TOPGEN], 1u);
            else XB_SPIN(xb_ld(&bar[XB_TOPGEN]) == tg, bar);
            __builtin_amdgcn_fence(__ATOMIC_ACQUIRE, "agent");
            xb_add(&bar[XB_XGEN(x)], 1u);
            asm volatile("s_waitcnt vmcnt(0)" ::: "memory");
        } else {
            XB_SPIN(xb_ld(&bar[XB_XGEN(x)]) == gen, bar);
            __builtin_amdgcn_fence(__ATOMIC_ACQUIRE, "agent");
            asm volatile("s_waitcnt vmcnt(0)" ::: "memory");
        }
    }
    __syncthreads();
}

struct Params { const float* in[23]; float* out; unsigned char* ws; int ph_lo, ph_hi; };
static_assert(sizeof(Params) == 23 * 8 + 8 + 8 + 8, "no padding in Params");

struct Ctx {
    int tid, lane, wid, G, gw, NGW;
    unsigned char* smem;
};

template <int MODE>
__device__ __forceinline__ void transpose_job(const Ctx& C, const float* W, int K, int N, u16* WT, int ldt) {
    float* scr = (float*)(C.smem + C.wid * 16384);
    const int nblk = N / 32, nitems = (K / 64) * nblk, lane = C.lane;
    for (int item = C.gw; item < nitems; item += C.NGW) {
        const int kb = item / nblk, nb = item % nblk, k0 = 64 * kb, n0 = 32 * nb;
        float tv[32];
#pragma unroll
        for (int i = 0; i < 32; ++i) tv[i] = W[(size_t)(k0 + 2 * i + (lane >> 5)) * N + n0 + (lane & 31)];
#pragma unroll
        for (int i = 0; i < 32; ++i) scr[(2 * i + (lane >> 5)) * 33 + (lane & 31)] = tv[i];
        asm volatile("s_waitcnt lgkmcnt(0)" ::: "memory");
        const int c = lane & 7;
#pragma unroll
        for (int j = 0; j < 4; ++j) { const int n = (lane >> 3) + 8 * j; const float* s = scr + (8 * c) * 33 + n;
            u32x4 o; o.x = pk2(s[0 * 33], s[1 * 33]); o.y = pk2(s[2 * 33], s[3 * 33]); o.z = pk2(s[4 * 33], s[5 * 33]); o.w = pk2(s[6 * 33], s[7 * 33]);
            int row = n0 + n;
            if (MODE == 1) { const int b = row / FFH, jj = row % FFH; row = (jj / 128) * 256 + b * 128 + (jj % 128); }
            *(u32x4*)(WT + (size_t)row * ldt + k0 + 8 * c) = o; }
        asm volatile("s_waitcnt lgkmcnt(0)" ::: "memory");
    }
}
__device__ __forceinline__ void fold_fourier_job(const Ctx& C, const float* Wf, u16* Bt) {
    f32x2* tab = (f32x2*)(C.smem + 131072);
    __syncthreads();
    if (C.tid < 128) { float s, c; sincospif(2.0f * (float)C.tid / 128.0f, &s, &c); tab[C.tid] = (f32x2){c, s}; }
    __syncthreads();
    const int gt = blockIdx.x * 512 + C.tid, NT_ = C.G * 512;
    float* ct = (float*)(C.smem + C.wid * 4096);
    for (int id = gt; id < 131072; id += NT_) {
        const int n = id & 1023, combo = id >> 10, c8 = combo & 15, ro = (combo >> 4) & 1, g = combo >> 5;
        const float sc = 0.08838834764831845f;
#pragma unroll
        for (int i = 0; i < 16; ++i) { const int q = C.lane + 64 * i, k2 = q >> 3, e = q & 7; const f32x2 cs = tab[(k2 * (c8 * 8 + e)) & 127]; ct[q] = (ro ? cs.y : cs.x) * sc; }
        asm volatile("s_waitcnt lgkmcnt(0)" ::: "memory");
        float a[8] = {0.f, 0.f, 0.f, 0.f, 0.f, 0.f, 0.f, 0.f};
        const float* wp = Wf + (size_t)(g * 128) * 1024 + n;
        const f32x4* ct4 = (const f32x4*)ct;
#pragma unroll 16
        for (int k2 = 0; k2 < 128; ++k2) { const float w = wp[(size_t)k2 * 1024]; const f32x4 c0 = ct4[2 * k2], c1 = ct4[2 * k2 + 1];
            a[0] += c0[0] * w; a[1] += c0[1] * w; a[2] += c0[2] * w; a[3] += c0[3] * w; a[4] += c1[0] * w; a[5] += c1[1] * w; a[6] += c1[2] * w; a[7] += c1[3] * w; }
        u32x4 o; o.x = pk2(a[0], a[1]); o.y = pk2(a[2], a[3]); o.z = pk2(a[4], a[5]); o.w = pk2(a[6], a[7]);
        *(u32x4*)(Bt + (size_t)n * 2560 + ro * 512 + g * 128 + c8 * 8) = o;
        asm volatile("s_waitcnt lgkmcnt(0)" ::: "memory");
    }
}

__device__ __forceinline__ void ln_norm(f32x4 (&v)[4], float& mean_o, float& rstd_o) {
    float s = 0.f;
#pragma unroll
    for (int j = 0; j < 4; ++j) s += (v[j][0] + v[j][1]) + (v[j][2] + v[j][3]);
    const float mean = wave_sum(s) * (1.f / D); float s2 = 0.f;
#pragma unroll
    for (int j = 0; j < 4; ++j) { v[j] = v[j] - mean; s2 += (v[j][0] * v[j][0] + v[j][1] * v[j][1]) + (v[j][2] * v[j][2] + v[j][3] * v[j][3]); }
    const float rstd = 1.0f / sqrtf(wave_sum(s2) * (1.f / D) + LN_EPS);
#pragma unroll
    for (int j = 0; j < 4; ++j) v[j] = v[j] * rstd;
    mean_o = mean; rstd_o = rstd;
}
__device__ __forceinline__ void ln_rows(const Ctx& C, int nrows, const float* src, float* dst, const float* lg, const float* lb, bool do_h, const float* mod, int shift_off, int scale_off,
                                        u16* H, float* st, bool write_x, bool xmap) {
    f32x4 g4[4], b4[4], sh[4], sc[4];
#pragma unroll
    for (int j = 0; j < 4; ++j) { g4[j] = (f32x4){1.f, 1.f, 1.f, 1.f}; b4[j] = (f32x4){0.f, 0.f, 0.f, 0.f}; sh[j] = b4[j]; sc[j] = g4[j]; }
    if (lg) {
#pragma unroll
        for (int j = 0; j < 4; ++j) { g4[j] = *(const f32x4*)(lg + 4 * C.lane + 256 * j); b4[j] = *(const f32x4*)(lb + 4 * C.lane + 256 * j); } }
    if (do_h) {
#pragma unroll
        for (int j = 0; j < 4; ++j) { sh[j] = *(const f32x4*)(mod + shift_off + 4 * C.lane + 256 * j); sc[j] = *(const f32x4*)(mod + scale_off + 4 * C.lane + 256 * j) + 1.0f; } }
    const bool xm = xmap && C.G == 256 && nrows == T;
    const int mstep = xm ? 256 : C.NGW, mend = xm ? (int)(2048 * (blockIdx.x & 7)) + 2048 : nrows;
    int m = xm ? (int)(2048 * (blockIdx.x & 7) + (blockIdx.x >> 3) * 8) + C.wid : C.gw; f32x4 nv[4];
    if (m < mend) {
#pragma unroll
        for (int j = 0; j < 4; ++j) nv[j] = *(const f32x4*)(src + (size_t)m * D + 4 * C.lane + 256 * j); }
    for (; m < mend; m += mstep) {
        f32x4 v[4];
#pragma unroll
        for (int j = 0; j < 4; ++j) v[j] = nv[j];
        { const int mn = m + mstep;
          if (mn < mend) {
#pragma unroll
              for (int j = 0; j < 4; ++j) nv[j] = *(const f32x4*)(src + (size_t)mn * D + 4 * C.lane + 256 * j); } }
        float mu, rs;
        if (lg) {
            ln_norm(v, mu, rs);
            if (st && C.lane == 0) *(f32x2*)(st + 2 * (size_t)m) = (f32x2){mu, rs};
#pragma unroll
            for (int j = 0; j < 4; ++j) { v[j] = v[j] * g4[j] + b4[j]; if (write_x) *(f32x4*)(dst + (size_t)m * D + 4 * C.lane + 256 * j) = v[j]; }
        }
        if (do_h) {
            ln_norm(v, mu, rs);
            u32x2* hp = (u32x2*)(H + (size_t)m * D) + C.lane;
#pragma unroll
            for (int j = 0; j < 4; ++j) { const f32x4 h = v[j] * sc[j] + sh[j]; u32x2 w; w.x = pk2(h[0], h[1]); w.y = pk2(h[2], h[3]); hp[64 * j] = w; }
        }
    }
}
__device__ __forceinline__ void ln_pass(const Ctx& C, int nrows, const float* src_lat, const float* src_ctx, float* dst_lat, float* dst_ctx,
                                        const float* lg, const float* lb, bool do_h, const float* mod_lat, const float* mod_ctx, int shift_off, int scale_off, u16* H, float* st, bool write_x) {
    ln_rows(C, T, src_lat, dst_lat, lg, lb, do_h, mod_lat, shift_off, scale_off, H, st, write_x, true);
    if (nrows > T) ln_rows(C, nrows - T, src_ctx, dst_ctx, lg, lb, do_h, mod_ctx, shift_off, scale_off, H + (size_t)T * D, st ? st + 2 * (size_t)T : st, write_x, false);
}

template <int K>
__device__ __forceinline__ void load_B_transposed(const Ctx& C, const u16* B, size_t ldb) {
    constexpr int KP = K + 8;
    unsigned* sB32 = (unsigned*)C.smem;
#pragma unroll
    for (int ch = C.tid; ch < (K / 2) * 16; ch += 512) {
        const int n8 = ch & 15, kp = ch >> 4;
        const u32x4 r0 = *(const u32x4*)(B + (size_t)(2 * kp) * ldb + n8 * 8), r1 = *(const u32x4*)(B + (size_t)(2 * kp + 1) * ldb + n8 * 8);
        const unsigned a[4] = {r0.x, r0.y, r0.z, r0.w}, b[4] = {r1.x, r1.y, r1.z, r1.w};
#pragma unroll
        for (int e = 0; e < 4; ++e) { const int n = n8 * 8 + 2 * e;
            sB32[(n * KP) / 2 + kp] = (a[e] & 0xffffu) | (b[e] << 16);
            sB32[((n + 1) * KP) / 2 + kp] = (a[e] >> 16) | (b[e] & 0xffff0000u); }
    }
}
template <int K>
__device__ __forceinline__ void mma_256x128(const Ctx& C, const u16* A_re, const u16* A_im, f32x16 (&acc_re)[2], f32x16 (&acc_im)[2]) {
    constexpr int KP = K + 8;
    const int l32 = C.lane & 31, hi = C.lane >> 5, mb = C.wid & 3, nh = C.wid >> 2;
    const u16* are = A_re + (size_t)(32 * mb + l32) * K + 8 * hi; const u16* aim = A_im + (size_t)(32 * mb + l32) * K + 8 * hi;
    const u16* sB = (const u16*)C.smem;
    const u16* b0p = sB + (64 * nh + l32) * KP + 8 * hi; const u16* b1p = b0p + 32 * KP;
    acc_re[0] = f32x16{}; acc_re[1] = f32x16{}; acc_im[0] = f32x16{}; acc_im[1] = f32x16{};
#pragma unroll 8
    for (int k0 = 0; k0 < K; k0 += 16) {
        const bf16x8 ar = *(const bf16x8*)(are + k0), ai = *(const bf16x8*)(aim + k0);
        const bf16x8 b0 = *(const bf16x8*)(b0p + k0), b1 = *(const bf16x8*)(b1p + k0);
        acc_re[0] = __builtin_amdgcn_mfma_f32_32x32x16_bf16(ar, b0, acc_re[0], 0, 0, 0);
        acc_re[1] = __builtin_amdgcn_mfma_f32_32x32x16_bf16(ar, b1, acc_re[1], 0, 0, 0);
        acc_im[0] = __builtin_amdgcn_mfma_f32_32x32x16_bf16(ai, b0, acc_im[0], 0, 0, 0);
        acc_im[1] = __builtin_amdgcn_mfma_f32_32x32x16_bf16(ai, b1, acc_im[1], 0, 0, 0);
    }
}

__device__ __forceinline__ void ctx_tile(const Ctx& C, const u16* A, int lda, const u16* Bt, int ldb, int K, float (&out)[2]) {
    const int l32 = C.lane & 31, hi = C.lane >> 5, ks = K >> 3;
    const u16* ap = A + (size_t)l32 * lda + C.wid * ks + 8 * hi; const u16* bp = Bt + (size_t)l32 * ldb + C.wid * ks + 8 * hi;
    f32x16 acc = f32x16{};
#pragma unroll 8
    for (int k0 = 0; k0 < ks; k0 += 16) acc = __builtin_amdgcn_mfma_f32_32x32x16_bf16(*(const bf16x8*)(ap + k0), *(const bf16x8*)(bp + k0), acc, 0, 0, 0);
    float* red = (float*)C.smem;
    __syncthreads();
#pragma unroll
    for (int r = 0; r < 16; ++r) red[(C.wid * 32 + crow(r, hi)) * 33 + l32] = acc[r];
    __syncthreads();
#pragma unroll
    for (int i = 0; i < 2; ++i) { const int e = C.tid + 512 * i, rr = e >> 5, cc = e & 31; float s = 0.f;
#pragma unroll
        for (int w = 0; w < 8; ++w) s += red[(w * 32 + rr) * 33 + cc];
        out[i] = s; }
}

__device__ __forceinline__ int lane_id_volatile() { int l; asm volatile("v_mbcnt_lo_u32_b32 %0, -1, 0\n\tv_mbcnt_hi_u32_b32 %0, -1, %0" : "=v"(l)); return l; }
typedef const Params __attribute__((address_space(4))) * KargP;
__global__ void __launch_bounds__(512, 2) fwd_megakernel(Params p_unused) {
    extern __shared__ __attribute__((aligned(16))) unsigned char smem[];
    cg::grid_group grid = cg::this_grid();
    int ph_lo, ph_hi;
    const int WID = __builtin_amdgcn_readfirstlane((int)(threadIdx.x >> 6));
#define MYTID() (WID * 64 + lane_id_volatile())
#define RETID() do { C.lane = lane_id_volatile(); C.tid = WID * 64 + C.lane; } while (0)
    { KargP kp0 = (KargP)__builtin_amdgcn_kernarg_segment_ptr(); ph_lo = kp0->ph_lo; ph_hi = kp0->ph_hi; }
#define p (*KARG)
#define x_in    (p.in[0])
#define c_in    (p.in[1])
#define ctx_in  (p.in[2])
#define cctx_in (p.in[3])
#define w_ada   (p.in[4])
#define b_ada   (p.in[5])
#define w_in    (p.in[6])
#define q_gain  (p.in[7])
#define k_gain  (p.in[8])
#define sgu_g   (p.in[9])
#define sgu_b   (p.in[10])
#define w_sp    (p.in[11])
#define b_sp    (p.in[12])
#define w_bra   (p.in[13])
#define w_brs   (p.in[14])
#define w_brf   (p.in[15])
#define w_out   (p.in[16])
#define ln1_g   (p.in[17])
#define ln1_b   (p.in[18])
#define w_up    (p.in[19])
#define w_down  (p.in[20])
#define ln2_g   (p.in[21])
#define ln2_b   (p.in[22])
#define Hb   ((u16*)(ws + OFF_H))
#define Qb   ((u16*)(ws + OFF_Q))
#define Fb   ((u16*)(ws + OFF_F))
#define Kb   ((u16*)(ws + OFF_K))
#define Vb   ((u16*)(ws + OFF_V))
#define YCb  ((u16*)(ws + OFF_YC))
#define Sb   ((u16*)(ws + OFF_S))
#define Gb   ((u16*)(ws + OFF_G))
#define ACTb ((u16*)(ws + OFF_G))
#define WINt ((u16*)(ws + OFF_W1))
#define WUPt ((u16*)(ws + OFF_WUP))
#define WDNt ((u16*)(ws + OFF_WDN))
#define WBAt ((u16*)(ws + OFF_WBA))
#define WBSt (WBAt + 1024)
#define WBFt (WBAt + 1536)
#define WOt  ((u16*)(ws + OFF_WO))
#define XCTX ((float*)(ws + OFF_XCTX))
#define MODP ((float*)(ws + OFF_MODP))
#define MOD  ((float*)(ws + OFF_MOD))
#define MA   ((u16*)(ws + OFF_MA))
#define MB   ((u16*)(ws + OFF_MB))
#define MC   ((u16*)(ws + OFF_MC))
#define TW   ((f32x2*)(ws + OFF_TW))
#define ROPE ((f32x2*)(ws + OFF_ROPE))
#define WSP  ((u16*)(ws + OFF_WSP))
#define FCb  ((u16*)(ws + OFF_FC))
#define ST1  ((float*)(ws + OFF_ST1))
#define ST2  ((float*)(ws + OFF_ST2))
#define XLAT (p.out)
#define lds3 ((PG8_LAS unsigned char*)smem)

    int ph = 0;
#ifdef PROBE_MASK
#define PROBE_LT ((volatile unsigned long long*)(smem + 131072 + 1536))
    if (MYTID() == 0) { PROBE_LT[0] = 0; PROBE_LT[1] = 0; }
#define PROBE_SEL(k) ((PROBE_MASK >> ((k) < 3 ? (k) : 3 + ((k) - 3) % 10)) & 1)
#define PROBE_T0 if (MYTID() == 0 && PROBE_SEL(ph)) PROBE_LT[1] = __builtin_amdgcn_s_memrealtime();
#define PROBE_T1 if (MYTID() == 0 && PROBE_SEL(ph)) PROBE_LT[0] += __builtin_amdgcn_s_memrealtime() - PROBE_LT[1];
#else
#define PROBE_T0
#define PROBE_T1
#endif
#define XB_ST ((volatile LAS unsigned*)(smem + 131072 + 1600))
#define XB_BAR ((unsigned*)((unsigned char*)((KargP)__builtin_amdgcn_kernarg_segment_ptr())->ws + OFF_BAR))
    if (MYTID() == 0) { XB_ST[0] = 0u; XB_ST[1] = 0u; (void)xb_add(&XB_BAR[XB_XCNT(xb_xcc_id())], 1u); }
    __syncthreads();
    if (ph_hi < ph_lo) grid.sync();
#ifdef PROBE_DUPSYNC
#define GSYNC() do { xcd_barrier(XB_BAR, XB_ST, MYTID()); xcd_barrier(XB_BAR, XB_ST, MYTID()); } while (0)
#else
#define GSYNC() xcd_barrier(XB_BAR, XB_ST, MYTID())
#endif
#define PH_BEGIN if (ph >= ph_lo && ph < ph_hi) { PROBE_T0 KargP KARG = (KargP)__builtin_amdgcn_kernarg_segment_ptr(); asm volatile("" : "+s"(KARG)); unsigned char* ws = KARG->ws; \
    Ctx C; C.wid = WID; RETID(); C.G = gridDim.x; C.gw = blockIdx.x * 8 + C.wid; C.NGW = C.G * 8; C.smem = smem;
#define PH_END } if (ph >= ph_lo && ph + 1 < ph_hi) GSYNC(); if (ph >= ph_lo && ph < ph_hi) { PROBE_T1 } ++ph;

    PH_BEGIN
    {
        float* sm = (float*)(smem + 131072);
        for (int it = blockIdx.x; it < 384; it += C.G) {
            const int l = it / 192, rem = it % 192, kp = rem / 12, nb = rem % 12;
            __syncthreads();
            if (C.tid < 128) { const int w = C.tid >> 6, kk = C.tid & 63; const float v = (w ? cctx_in : c_in)[kp * 64 + kk]; sm[C.tid] = v / (1.0f + expf(-v)); }
            __syncthreads();
            const int n = nb * 512 + C.tid; float a0 = 0.f, a1 = 0.f; const float* wp = w_ada + ((size_t)l * 1024 + kp * 64) * INW + n;
#pragma unroll 32
            for (int kk = 0; kk < 64; ++kk) { const float w = wp[(size_t)kk * INW]; a0 += sm[kk] * w; a1 += sm[64 + kk] * w; }
            MODP[(size_t)((l * 16 + kp) * 2 + 0) * INW + n] = a0; MODP[(size_t)((l * 16 + kp) * 2 + 1) * INW + n] = a1;
        }
        __syncthreads();
        const int gt = blockIdx.x * 512 + C.tid, NTH = C.G * 512;
        const float r128 = 0.08838834764831845f;
        for (int i = gt; i < 256 * 128; i += NTH) { const int m = i >> 7, t1 = i & 127, ka = m & 127, im = m >> 7; float s, c; sincospif(2.0f * (float)((ka * t1) & 127) / 128.0f, &s, &c); MA[i] = (u16)f2bf((im ? -s : c) * r128); }
        for (int i = gt; i < 256 * 256; i += NTH) { const int row = i >> 8, col = i & 255, ro = row >> 7, kb = row & 127, ri = col >> 7, t0 = col & 127; float s, c; sincospif(2.0f * (float)((kb * t0) & 127) / 128.0f, &s, &c);
            const float v = (ro == ri) ? c : (ro == 0 ? s : -s); MB[i] = (u16)f2bf(v * r128); }
        for (int i = gt; i < 512 * 256; i += NTH) { const int row = i >> 8, t = i & 255, ro = row >> 8, k1 = row & 255; float s, c; sincospif(2.0f * (float)((k1 * t) & 255) / 256.0f, &s, &c); MC[i] = (u16)f2bf((ro ? -s : c) * 0.0625f); }
        for (int i = gt; i < 128 * 128; i += NTH) { const int ka = i >> 7, t0 = i & 127; float s, c; sincospif(2.0f * (float)((ka * t0) & 16383) / 16384.0f, &s, &c); TW[i] = (f32x2){c, s}; }
        for (int i = gt; i < 256 * 32; i += NTH) { const int pos = i >> 5, j = i & 31; const float inv = exp2f(-(float)j * (13.287712379549449f / 32.0f)); const float ang = (float)pos * inv;
            const double rev = (double)ang * 0.15915494309189535; const double fr = rev - rint(rev); float s, c; sincospif((float)(2.0 * fr), &s, &c); ROPE[i] = (f32x2){c, s}; }
        for (int i = gt; i < NL * 8 * 128 * 128; i += NTH) WSP[i] = (u16)f2bf(w_sp[i]);
        transpose_job<0>(C, w_in, D, INW, WINt, D);
        transpose_job<0>(C, w_bra, D, D, WBAt, 2560);
        transpose_job<0>(C, w_brs, 512, D, WBSt, 2560);
        transpose_job<0>(C, w_out, D, D, WOt, D);
        fold_fourier_job(C, w_brf, WBFt);
    }
    PH_END
    PH_BEGIN
    {
        const int gt = blockIdx.x * 512 + C.tid, NTH = C.G * 512;
        for (int i = gt; i < NL * 2 * INW; i += NTH) { const int n = i % INW, lw = i / INW, l = lw >> 1, w = lw & 1; float a = b_ada[l * INW + n];
            for (int kp = 0; kp < 16; ++kp) a += MODP[(size_t)((l * 16 + kp) * 2 + w) * INW + n];
            MOD[i] = a; }
    }
    PH_END
    PH_BEGIN
    ln_pass(C, R, x_in, ctx_in, nullptr, nullptr, nullptr, nullptr, true, MOD, MOD + INW, 0, 1024, Hb, nullptr, false);
    PH_END

#pragma unroll 1
    for (int l = 0; l < NL; ++l) {
        const bool lastl = (l == NL - 1);
#define modl (MOD + (size_t)(l * 2 + 0) * INW)
#define modc (MOD + (size_t)(l * 2 + 1) * INW)
#define xin_lat ((l == 0) ? x_in : (const float*)XLAT)
#define xin_ctx ((l == 0) ? ctx_in : (const float*)XCTX)

        PH_BEGIN
        {
            pg8::Gemm g{Hb, WINt, D, D, D, nullptr, nullptr, 0, nullptr, nullptr, 0}; pg8::OrderX S; S.init(INW, C.G, (int)blockIdx.x, 0, 0);
            pg8::EpiIn E{Qb, Kb, Vb, Sb, Fb, FCb, Gb};
            pg8::gemm_phase<pg8::EpiIn, pg8::OrderX>(lds3, g, S, E, C.tid);
            const int ct0 = lastl ? 32 : 0, nct = lastl ? 16 : 192;
            for (int it = blockIdx.x; it < 8 * nct; it += C.G) {
                const int rt = it / nct, ctile = ct0 + it % nct, r0 = T + 32 * rt, c0 = 32 * ctile;
                float v[2]; ctx_tile(C, Hb + (size_t)r0 * D, D, WINt + (size_t)c0 * D, D, D, v);
#pragma unroll
                for (int i = 0; i < 2; ++i) { const int e = C.tid + 512 * i, row = r0 + (e >> 5), col = c0 + (e & 31); const float x = v[i];
                    if (col < 1024) Qb[(size_t)row * 1024 + col] = (u16)f2bf(x);
                    else if (col < 1280) Kb[(size_t)row * 256 + col - 1024] = (u16)f2bf(x);
                    else if (col < 1536) Vb[(size_t)row * 256 + col - 1280] = (u16)f2bf(x);
                    else if (col < 2560) Sb[(size_t)row * 1024 + col - 1536] = (u16)f2bf(fgelu_tanh(x));
                    else if (col < 3072) FCb[(size_t)(row - T) * 512 + col - 2560] = (u16)f2bf(x);
                    else Gb[(size_t)row * 3072 + col - 3072] = (u16)f2bf(fsigmoid(x)); }
            }
            __syncthreads();
        }
        PH_END
        PH_BEGIN
        {
            {
                const int sub = C.lane >> 4, l16 = C.lane & 15;
#pragma unroll 1
                for (int pass = 0; pass < 2; ++pass) {
                    u16* base = pass == 0 ? Qb : Kb; const int nseg = pass == 0 ? (lastl ? T : R) * 8 : R * 2; const int shift = pass == 0 ? 3 : 1;
                    const float* gain = (pass == 0 ? q_gain : k_gain) + l * 128 + l16 * 8;
                    const f32x4 g0 = *(const f32x4*)gain, g1 = *(const f32x4*)(gain + 4);
                    const int ngroups = nseg >> 2;
#pragma unroll 4
                    for (int grp = C.gw; grp < ngroups; grp += C.NGW) {
                        const int s = grp * 4 + sub, m = s >> shift;
                        u32x4* pp = (u32x4*)(base + (size_t)s * 128 + l16 * 8);
                        const u32x4 w = *pp;
                        float x0 = bflo(w.x), x1 = bfhi(w.x), x2 = bflo(w.y), x3 = bfhi(w.y), x4 = bflo(w.z), x5 = bfhi(w.z), x6 = bflo(w.w), x7 = bfhi(w.w);
                        float ss = (x0 * x0 + x1 * x1) + (x2 * x2 + x3 * x3) + (x4 * x4 + x5 * x5) + (x6 * x6 + x7 * x7);
                        ss += __shfl_xor(ss, 1); ss += __shfl_xor(ss, 2); ss += __shfl_xor(ss, 4); ss += __shfl_xor(ss, 8);
                        const float rs = (pass == 0 ? 0.12751743f   : 1.0f) / sqrtf(ss * (1.0f / 128.0f) + RMS_EPS);
                        x0 *= rs * g0[0]; x1 *= rs * g0[1]; x2 *= rs * g0[2]; x3 *= rs * g0[3]; x4 *= rs * g1[0]; x5 *= rs * g1[1]; x6 *= rs * g1[2]; x7 *= rs * g1[3];
                        if (m < T) { const int pos = l16 < 8 ? (m >> 6) : (m & 63); const f32x2* rp = ROPE + pos * 32 + (l16 & 7) * 4;
                            const f32x4 c01 = *(const f32x4*)rp, c23 = *(const f32x4*)(rp + 2);
                            float t;
                            t = x0 * c01[0] - x1 * c01[1]; x1 = x0 * c01[1] + x1 * c01[0]; x0 = t;
                            t = x2 * c01[2] - x3 * c01[3]; x3 = x2 * c01[3] + x3 * c01[2]; x2 = t;
                            t = x4 * c23[0] - x5 * c23[1]; x5 = x4 * c23[1] + x5 * c23[0]; x4 = t;
                            t = x6 * c23[2] - x7 * c23[3]; x7 = x6 * c23[3] + x7 * c23[2]; x6 = t; }
                        u32x4 o; o.x = pk2(x0, x1); o.y = pk2(x2, x3); o.z = pk2(x4, x5); o.w = pk2(x6, x7);
                        *pp = o;
                    }
                }
            }
            RETID();
            {
                const int nchunks = lastl ? 128 : 130;
                float* smean = (float*)(smem + 65536); float* srstd = smean + 128;
                unsigned* sB32 = (unsigned*)smem; constexpr int KP = 136;
                const int l32 = C.lane & 31, hi = C.lane >> 5, mb = C.wid & 3, nb = C.wid >> 2;
                const int nitems = 256 + (lastl ? 0 : 16);
                for (int it = blockIdx.x; it < nitems; it += C.G) {
                    const int ch = it < 256 ? (it >> 1) : 128 + ((it - 256) >> 3), g0 = it < 256 ? (it & 1) * 4 : ((it - 256) & 7), ngr = it < 256 ? 4 : 1, R0 = ch * 128;
                    __syncthreads();
                    { const int q = C.tid >> 2, part = C.tid & 3; const u16* vr = Sb + (size_t)(R0 + q) * 1024 + 512 + part * 128; float s = 0.f, s2 = 0.f;
                      u32x4 w[16];
#pragma unroll
                      for (int j = 0; j < 16; ++j) w[j] = *(const u32x4*)(vr + j * 8);
#pragma unroll
                      for (int j = 0; j < 16; ++j) { const unsigned ww[4] = {w[j].x, w[j].y, w[j].z, w[j].w};
#pragma unroll
                          for (int e = 0; e < 4; ++e) { const float a = bflo(ww[e]), b = bfhi(ww[e]); s += a + b; s2 += a * a + b * b; } }
                      s += __shfl_xor(s, 1); s += __shfl_xor(s, 2); s2 += __shfl_xor(s2, 1); s2 += __shfl_xor(s2, 2);
                      const float mean = s * (1.0f / 512.0f); const float var = fmaxf(s2 * (1.0f / 512.0f) - mean * mean, 0.f);
                      if (part == 0) { smean[q] = mean; srstd[q] = 1.0f / sqrtf(var + LN_EPS); } }
                    __syncthreads();
                    const int qp = C.tid >> 3, c8 = C.tid & 7;
                    const float m0 = smean[2 * qp], s0 = srstd[2 * qp], m1 = smean[2 * qp + 1], s1 = srstd[2 * qp + 1];
#pragma unroll 1
                    for (int gi = 0; gi < ngr; ++gi) {
                        const int g = g0 + gi, cb = g * 64 + c8 * 8, cc = g * 64 + 32 * nb + l32;
                        const u32x4 r0 = *(const u32x4*)(Sb + (size_t)(R0 + 2 * qp) * 1024 + 512 + cb), r1 = *(const u32x4*)(Sb + (size_t)(R0 + 2 * qp + 1) * 1024 + 512 + cb);
                        const f32x4 ga = *(const f32x4*)(sgu_g + l * 512 + cb), gb = *(const f32x4*)(sgu_g + l * 512 + cb + 4), ba = *(const f32x4*)(sgu_b + l * 512 + cb), bb = *(const f32x4*)(sgu_b + l * 512 + cb + 4);
                        const u16* arow = WSP + ((size_t)(l * 8 + g) * 128 + 32 * mb + l32) * 128 + 8 * hi;
                        bf16x8 af[8];
#pragma unroll
                        for (int k = 0; k < 8; ++k) af[k] = *(const bf16x8*)(arow + 16 * k);
                        u16 uv[16]; float bsp[16];
#pragma unroll
                        for (int r = 0; r < 16; ++r) { const int pr = 32 * mb + crow(r, hi); uv[r] = Sb[(size_t)(R0 + pr) * 1024 + cc]; bsp[r] = b_sp[(l * 8 + g) * 128 + pr]; }
                        const float gg[8] = {ga[0], ga[1], ga[2], ga[3], gb[0], gb[1], gb[2], gb[3]}, bbv[8] = {ba[0], ba[1], ba[2], ba[3], bb[0], bb[1], bb[2], bb[3]};
                        const unsigned a[4] = {r0.x, r0.y, r0.z, r0.w}, b[4] = {r1.x, r1.y, r1.z, r1.w};
#pragma unroll
                        for (int e = 0; e < 4; ++e) { const int c = c8 * 8 + 2 * e;
                            const float v00 = (bflo(a[e]) - m0) * s0 * gg[2 * e] + bbv[2 * e], v01 = (bfhi(a[e]) - m0) * s0 * gg[2 * e + 1] + bbv[2 * e + 1];
                            const float v10 = (bflo(b[e]) - m1) * s1 * gg[2 * e] + bbv[2 * e], v11 = (bfhi(b[e]) - m1) * s1 * gg[2 * e + 1] + bbv[2 * e + 1];
                            sB32[(c * KP) / 2 + qp] = pk2(v00, v10); sB32[((c + 1) * KP) / 2 + qp] = pk2(v01, v11); }
                        __syncthreads();
                        { const u16* bp = (const u16*)smem + (32 * nb + l32) * KP + 8 * hi;
                          f32x16 acc = f32x16{};
#pragma unroll
                          for (int k = 0; k < 8; ++k) acc = __builtin_amdgcn_mfma_f32_32x32x16_bf16(af[k], *(const bf16x8*)(bp + 16 * k), acc, 0, 0, 0);
#pragma unroll
                          for (int r = 0; r < 16; ++r) { const int pr = 32 * mb + crow(r, hi); Sb[(size_t)(R0 + pr) * 1024 + cc] = (u16)f2bf(bf2f(uv[r]) * (acc[r] + bsp[r])); } }
                        __syncthreads();
                    }
                }
                __syncthreads();
            }
            RETID();
            for (int it = blockIdx.x; it < 512; it += C.G) {
                const int n0 = it * 128, t0 = it >> 2;
                __syncthreads();
                load_B_transposed<128>(C, Fb + n0, 65536);
                __syncthreads();
                f32x16 are[2], aim[2];
                mma_256x128<128>(C, MA, MA + 128 * 128, are, aim);
                const int l32 = C.lane & 31, hi = C.lane >> 5, mb = C.wid & 3, nh = C.wid >> 2;
#pragma unroll
                for (int s = 0; s < 2; ++s)
#pragma unroll
                    for (int r = 0; r < 16; ++r) { const int ka = 32 * mb + crow(r, hi); const f32x2 tw = TW[ka * 128 + t0];
                        const float hr = are[s][r], hm = aim[s][r]; const float orr = hr * tw.x + hm * tw.y, oi = hm * tw.x - hr * tw.y;
                        const size_t o = (size_t)ka * 131072 + n0 + 64 * nh + 32 * s + l32;
                        Hb[o] = (u16)f2bf(orr); Hb[o + 65536] = (u16)f2bf(oi); }
            }
            __syncthreads();
            RETID();
            transpose_job<1>(C, w_up + (size_t)l * D * 2 * FFH, D, 2 * FFH, WUPt, D);
            transpose_job<0>(C, w_down + (size_t)l * FFH * D, FFH, D, WDNt, FFH);
        }
        PH_END
        PH_BEGIN
        {
            const int nunits = lastl ? 512 : 520;
            float noff;
            { float gq = fmaxf(fabsf(q_gain[l * 128 + C.lane]), fabsf(q_gain[l * 128 + 64 + C.lane])), gk = fmaxf(fabsf(k_gain[l * 128 + C.lane]), fabsf(k_gain[l * 128 + 64 + C.lane]));
#pragma unroll
              for (int o = 1; o < 64; o <<= 1) { gq = fmaxf(gq, __shfl_xor(gq, o)); gk = fmaxf(gk, __shfl_xor(gk, o)); }
              const float bound = gq * gk * 11.3137085f * 1.44269504f;
              noff = -fmaxf(0.f, bound - 60.f); }
            for (int L = blockIdx.x; L < nunits; L += C.G) {
                __syncthreads();
                const u16 *qp, *kp, *vp; int seq;
                if (L < 512) { const int h = L >> 6, qb = L & 63, kvh = h >> 2; qp = Qb + (size_t)(qb * 256) * 1024 + h * 128; kp = Kb + kvh * 128; vp = Vb + kvh * 128; seq = R; }
                else { const int h = L - 512, kvh = h >> 2; qp = Qb + (size_t)T * 1024 + h * 128; kp = Kb + (size_t)T * 256 + kvh * 128; vp = Vb + (size_t)T * 256 + kvh * 128; seq = CTX; }
                att::attn_dense_body(qp, kp, vp, (u16*)qp, seq, (char*)smem, C.tid, noff);
            }
            __syncthreads();
        }
        PH_END
        PH_BEGIN
        {
            const int nitems = lastl ? 512 : 520;
            for (int it = blockIdx.x; it < nitems; it += C.G) {
                const u16 *Are, *Aim, *Bp; int rowbase, rowstride, nt;
                if (it < 512) { const int ka = it >> 2; nt = it & 3; Are = MB; Aim = MB + 128 * 256; Bp = Hb + (size_t)ka * 131072 + nt * 128; rowbase = ka; rowstride = 128; }
                else { const int hs = (it - 512) >> 2; nt = it & 3; Are = MC + (size_t)(128 * hs) * 256; Aim = MC + (size_t)(256 + 128 * hs) * 256; Bp = FCb + nt * 128; rowbase = T + 128 * hs; rowstride = 1; }
                __syncthreads();
                load_B_transposed<256>(C, Bp, 512);
                __syncthreads();
                f32x16 are[2], aim[2];
                mma_256x128<256>(C, Are, Aim, are, aim);
                const int l32 = C.lane & 31, hi = C.lane >> 5, mb = C.wid & 3, nh = C.wid >> 2;
#pragma unroll
                for (int s = 0; s < 2; ++s)
#pragma unroll
                    for (int r = 0; r < 16; ++r) { const int kb = 32 * mb + crow(r, hi); const size_t o = (size_t)(rowbase + rowstride * kb) * 1024 + nt * 128 + 64 * nh + 32 * s + l32;
                        YCb[o] = (u16)f2bf(are[s][r]); YCb[o + 512] = (u16)f2bf(aim[s][r]); }
            }
            __syncthreads();
        }
        PH_END
        PH_BEGIN
        {
            {
                pg8::Gemm g{Qb, WBAt, 1024, 1024, 2560, Sb, WBSt, 512, YCb, WBFt, 1024};
                pg8::OrderBr S; S.init(D, C.G, (int)blockIdx.x);
                pg8::EpiBr E{Gb, Hb};
                pg8::gemm_phase<pg8::EpiBr, pg8::OrderBr>(lds3, g, S, E, C.tid);
            }
            if (!lastl) {
                for (int it = blockIdx.x; it < 8 * 32; it += C.G) {
                    const int r0 = T + 32 * (it >> 5), c0 = 32 * (it & 31);
                    float m[2] = {0.f, 0.f};
#pragma unroll 1
                    for (int b = 0; b < 3; ++b) { float v[2];
                        ctx_tile(C, (b == 0 ? Qb : (b == 1 ? Sb : YCb)) + (size_t)r0 * 1024, 1024, (b == 0 ? WBAt : (b == 1 ? WBSt : WBFt)) + (size_t)c0 * 2560, 2560, b == 1 ? 512 : 1024, v);
#pragma unroll
                        for (int i = 0; i < 2; ++i) { const int e = C.tid + 512 * i, row = r0 + (e >> 5), col = c0 + (e & 31); m[i] += v[i] * bf2f(Gb[(size_t)row * 3072 + b * 1024 + col]); } }
#pragma unroll
                    for (int i = 0; i < 2; ++i) { const int e = C.tid + 512 * i, row = r0 + (e >> 5), col = c0 + (e & 31); Hb[(size_t)row * 1024 + col] = (u16)f2bf(m[i]); }
                }
                __syncthreads();
            }
        }
        PH_END
        PH_BEGIN
        {
            pg8::Gemm g{Hb, WOt, D, D, D, nullptr, nullptr, 0, nullptr, nullptr, 0}; pg8::OrderX S; S.init(D, C.G, (int)blockIdx.x, 0, 0);
            pg8::EpiRes E{xin_lat, XLAT, modl + 2 * 1024, (l == 0) ? (const float*)nullptr : (const float*)ST2, ln2_g + (l - 1) * D, ln2_b + (l - 1) * D};
            pg8::gemm_phase<pg8::EpiRes, pg8::OrderX>(lds3, g, S, E, C.tid);
            if (!lastl) {
                for (int it = blockIdx.x; it < 8 * 32; it += C.G) {
                    const int r0 = 32 * (it >> 5), c0 = 32 * (it & 31);
                    float v[2]; ctx_tile(C, Hb + (size_t)(T + r0) * D, D, WOt + (size_t)c0 * D, D, D, v);
#pragma unroll
                    for (int i = 0; i < 2; ++i) { const int e = C.tid + 512 * i, row = r0 + (e >> 5), col = c0 + (e & 31);
                        XCTX[(size_t)row * D + col] = ALPHA * xin_ctx[(size_t)row * D + col] + (modc + 2 * 1024)[col] * v[i]; }
                }
                __syncthreads();
            }
        }
        PH_END
        PH_BEGIN
        ln_pass(C, lastl ? T : R, XLAT, XCTX, XLAT, XCTX, ln1_g + l * D, ln1_b + l * D, true, modl, modc, 3 * 1024, 4 * 1024, Hb, ST1, false);
        PH_END
        PH_BEGIN
        {
            pg8::Gemm g{Hb, WUPt, D, D, D, nullptr, nullptr, 0, nullptr, nullptr, 0}; pg8::OrderX S; S.init(2 * FFH, C.G, (int)blockIdx.x, lastl ? 0 : 22, 0);
            pg8::EpiUp E{ACTb};
            pg8::gemm_phase<pg8::EpiUp, pg8::OrderX>(lds3, g, S, E, C.tid);
        }
        PH_END
        PH_BEGIN
        {
            pg8::Gemm g{ACTb, WDNt, FFH, FFH, FFH, nullptr, nullptr, 0, nullptr, nullptr, 0}; pg8::OrderX S; S.init(D, C.G, (int)blockIdx.x, 0, 0);
            pg8::EpiRes E{XLAT, XLAT, modl + 5 * 1024, ST1, ln1_g + l * D, ln1_b + l * D};
            pg8::gemm_phase<pg8::EpiRes, pg8::OrderX>(lds3, g, S, E, C.tid);
            if (!lastl) {
                for (int it = blockIdx.x; it < 8 * 32; it += C.G) {
                    const int r0 = 32 * (it >> 5), c0 = 32 * (it & 31);
                    float v[2]; ctx_tile(C, ACTb + (size_t)(T + r0) * FFH, FFH, WDNt + (size_t)c0 * FFH, FFH, FFH, v);
#pragma unroll
                    for (int i = 0; i < 2; ++i) { const int e = C.tid + 512 * i, row = r0 + (e >> 5), col = c0 + (e & 31);
                        const f32x2 sv = *(const f32x2*)(ST1 + 2 * (size_t)(T + row)); const float x1 = (XCTX[(size_t)row * D + col] - sv[0]) * sv[1] * (ln1_g + l * D)[col] + (ln1_b + l * D)[col];
                        XCTX[(size_t)row * D + col] = ALPHA * x1 + (modc + 5 * 1024)[col] * v[i]; }
                }
                __syncthreads();
            }
        }
        PH_END
        PH_BEGIN
        {
            ln_pass(C, lastl ? T : R, XLAT, XCTX, XLAT, XCTX, ln2_g + l * D, ln2_b + l * D, !lastl, modl + 2 * INW, modc + 2 * INW, 0, 1024, Hb, ST2, lastl);
            if (!lastl) {
                __syncthreads();
                transpose_job<0>(C, w_in + (size_t)(l + 1) * D * INW, D, INW, WINt, D);
                transpose_job<0>(C, w_bra + (size_t)(l + 1) * D * D, D, D, WBAt, 2560);
                transpose_job<0>(C, w_brs + (size_t)(l + 1) * 512 * D, 512, D, WBSt, 2560);
                transpose_job<0>(C, w_out + (size_t)(l + 1) * D * D, D, D, WOt, D);
                fold_fourier_job(C, w_brf + (size_t)(l + 1) * 512 * D, WBFt);
            }
        }
        PH_END
    }
#ifdef PROBE_MASK
    {
        KargP KARG = (KargP)__builtin_amdgcn_kernarg_segment_ptr(); unsigned char* ws = KARG->ws;
        unsigned long long* slot = (unsigned long long*)(ws + OFF_PROBE);
        grid.sync();
        if (blockIdx.x == 0 && threadIdx.x == 0) *slot = PROBE_LT[0];
        grid.sync();
        const float t_us = (float)(*slot) * 0.01f;
        const float delta = sqrtf(t_us * 1e-8f);
        float* o = KARG->out;
        for (size_t i = (size_t)blockIdx.x * 512 + threadIdx.x; i < (size_t)T * D; i += (size_t)gridDim.x * 512) o[i] += (i & 1) ? delta : -delta;
    }
#endif
#undef PH_BEGIN
#undef PH_END
#undef p
}

extern "C" void kernel_launch(void* const* d_in, const int* in_sizes, int n_in, void* d_out, int out_size, void* d_ws, size_t ws_size, hipStream_t stream) {
    static int grid = 0;
    if (grid == 0) {
        if (n_in != 23 || out_size != T * D || ws_size < WS_END) { fprintf(stderr, "kernel_launch: unexpected shapes (n_in %d out %d ws %zu need %zu)\n", n_in, out_size, ws_size, (size_t)WS_END); grid = -1; return; }
        int dev = 0, cus = 0, per_cu = 0;
        hipGetDevice(&dev); hipDeviceGetAttribute(&cus, hipDeviceAttributeMultiprocessorCount, dev);
        if (hipFuncSetAttribute((const void*)fwd_megakernel, hipFuncAttributeMaxDynamicSharedMemorySize, LDS_BYTES) != hipSuccess) { fprintf(stderr, "kernel_launch: hipFuncSetAttribute failed\n"); grid = -1; return; }
        if (hipOccupancyMaxActiveBlocksPerMultiprocessor(&per_cu, (const void*)fwd_megakernel, 512, LDS_BYTES) != hipSuccess || per_cu < 1) { fprintf(stderr, "kernel_launch: occupancy query says %d\n", per_cu); per_cu = 1; }
        (void)hipGetLastError();
        grid = cus * 1;
        fprintf(stderr, "kernel_launch: cus %d per_cu %d grid %d\n", cus, per_cu, grid);
    }
    if (grid < 0) return;
    Params p{};
    for (int i = 0; i < 23; ++i) p.in[i] = (const float*)d_in[i];
    p.out = (float*)d_out; p.ws = (unsigned char*)d_ws; p.ph_lo = 0; p.ph_hi = 3 + 10 * NL;
    if (hipMemsetAsync((char*)d_ws + OFF_BAR, 0, BAR_BYTES, stream) != hipSuccess) { fprintf(stderr, "kernel_launch: memset failed\n"); return; }
    void* args[] = {&p};
    hipError_t e = hipLaunchCooperativeKernel((const void*)fwd_megakernel, dim3(grid), dim3(512), args, LDS_BYTES, stream);
    if (e != hipSuccess) fprintf(stderr, "kernel_launch: cooperative launch failed: %s (grid %d)\n", hipGetErrorString(e), grid);
}
```

```cpp
#include <hip/hip_runtime.h>
#include <hip/hip_bf16.h>
#include <hip/hip_cooperative_groups.h>
#include <cstdio>
#include <cstdint>
namespace cg = cooperative_groups;

constexpr int T = 16384, CTX = 256, R = T + CTX, D = 1024, INW = 6144, FFH = 2816, NL = 2;
constexpr float ALPHA = 1.4142135623730951f;
constexpr float LN_EPS = 1e-6f, RMS_EPS = 1e-6f;

typedef unsigned short u16;
typedef short bf16x8 __attribute__((ext_vector_type(8)));
typedef short s16x4 __attribute__((ext_vector_type(4)));
typedef float f32x4 __attribute__((ext_vector_type(4)));
typedef float f32x2 __attribute__((ext_vector_type(2)));
typedef float f32x16 __attribute__((ext_vector_type(16)));
typedef unsigned u32x4 __attribute__((ext_vector_type(4)));
typedef unsigned u32x2 __attribute__((ext_vector_type(2)));
#define LAS __attribute__((address_space(3)))

constexpr size_t SZ_RD = (size_t)R * D * 2;
constexpr size_t OFF_H = 0;
constexpr size_t OFF_Q = OFF_H + SZ_RD;
constexpr size_t OFF_F = OFF_Q + SZ_RD;
constexpr size_t OFF_K = OFF_F + (size_t)R * 512 * 2;
constexpr size_t OFF_V = OFF_K + (size_t)R * 256 * 2;
constexpr size_t OFF_YC = OFF_F;
constexpr size_t OFF_S = OFF_F + SZ_RD;
constexpr size_t OFF_G = OFF_S + SZ_RD;
constexpr size_t OFF_W1 = OFF_G + (size_t)R * 3072 * 2;
constexpr size_t SZ_W1 = (size_t)5632 * 1024 * 2 + (size_t)1024 * 2816 * 2;
constexpr size_t OFF_WUP = OFF_W1, OFF_WDN = OFF_W1 + (size_t)5632 * 1024 * 2;
constexpr size_t OFF_WBA = OFF_W1 + SZ_W1;
constexpr size_t OFF_WBS = OFF_WBA + 2097152;
constexpr size_t OFF_WBF = OFF_WBS + 1048576;
constexpr size_t OFF_WO = OFF_WBF + 2097152;
constexpr size_t OFF_XCTX = OFF_WO + 2097152;
constexpr size_t OFF_MODP = OFF_XCTX + 1048576;
constexpr size_t OFF_MOD = OFF_MODP + 1572864;
constexpr size_t OFF_MA = OFF_MOD + 98304;
constexpr size_t OFF_MB = OFF_MA + 65536;
constexpr size_t OFF_MC = OFF_MB + 131072;
constexpr size_t OFF_TW = OFF_MC + 262144;
constexpr size_t OFF_ROPE = OFF_TW + 131072;
constexpr size_t OFF_WSP = OFF_ROPE + 65536;
constexpr size_t OFF_FC = OFF_WSP + 524288;
constexpr size_t OFF_BAR = OFF_FC + 262144;
constexpr size_t BAR_BYTES = 16384;
constexpr size_t OFF_PROBE = OFF_BAR + BAR_BYTES;
constexpr size_t OFF_ST1 = OFF_PROBE + 256;
constexpr size_t OFF_ST2 = OFF_ST1 + (size_t)R * 8;
constexpr size_t WS_END = OFF_ST2 + (size_t)R * 8;
static_assert(WS_END <= 268435456ull, "workspace map exceeds 256 MiB");
static_assert(SZ_W1 >= (size_t)INW * D * 2, "w_in_t fits the shared weight region");

constexpr int LDS_BYTES = 131072 + 2048;

typedef __bf16 bf16x2_t __attribute__((ext_vector_type(2)));
__device__ __forceinline__ unsigned f2bf(float f) { const __bf16 b = (__bf16)f; return (unsigned)__builtin_bit_cast(unsigned short, b); }
__device__ __forceinline__ unsigned pk2(float lo, float hi) { const f32x2 v = {lo, hi}; const bf16x2_t b = __builtin_convertvector(v, bf16x2_t); return __builtin_bit_cast(unsigned, b); }
__device__ __forceinline__ float bflo(unsigned w) { return __builtin_bit_cast(float, w << 16); }
__device__ __forceinline__ float bfhi(unsigned w) { return __builtin_bit_cast(float, w & 0xffff0000u); }
__device__ __forceinline__ float bf2f(u16 b) { return __builtin_bit_cast(float, ((unsigned)b) << 16); }
__device__ __forceinline__ float wave_sum(float v) {
#pragma unroll
    for (int o = 1; o < 64; o <<= 1) v += __shfl_xor(v, o);
    return v;
}
__device__ __forceinline__ float fsigmoid(float x) { return __builtin_amdgcn_rcpf(1.0f + __builtin_amdgcn_exp2f(-1.4426950408889634f * x)); }
__device__ __forceinline__ float fgelu_tanh(float x) { const float y2 = 1.5957691216057308f * (x + 0.044715f * x * x * x); return x * fsigmoid(y2); }
__device__ __forceinline__ int crow(int r, int hi) { return (r & 3) + 8 * (r >> 2) + 4 * hi; }

namespace pg8 {
#define PG8_LAS __attribute__((address_space(3)))
typedef unsigned short bf16_t;
constexpr int BM = 256, BK = 64, HALF = 128, HTB = HALF * BK * 2, STAGE_BYTES = 8 * HTB, NXCD = 8, WGM = 8;
__host__ __device__ __forceinline__ int lds_byte(int r, int c) { const int st = (r >> 4) * 2 + (c >> 5), rr = r & 15, cc = c & 31, ob = rr * 64 + cc * 2; return st * 1024 + (ob ^ (((ob >> 9) & 1) << 5)); }
__host__ __device__ __forceinline__ void stage_rc(int b, int& Rr, int& C) { const int st = b / 1024, sb = b % 1024, swz = sb ^ (((sb >> 9) & 1) << 5); Rr = (st >> 1) * 16 + swz / 64; C = (st & 1) * 32 + (swz % 64) / 2; }
__host__ __device__ __forceinline__ int perm32(int rho) { const int n = rho >> 4, i = rho & 15; return 8 * (i >> 2) + 4 * n + (i & 3); }
struct Unit { int pm, pn, b; };
struct Gemm { const bf16_t* A; const bf16_t* Bt; int K, lda, ldb;
              const bf16_t* A1; const bf16_t* Bt1; int K1; const bf16_t* A2; const bf16_t* Bt2; int K2; };
struct StaticOrder {
    int nM, nN, nwg, G, c;
    __device__ void init(int M, int N, int G_, int c_) { nM = M / BM; nN = N / BM; nwg = nM * nN; G = G_; c = c_; }
    __device__ bool next(int i, Unit& u) const {
        const long L = (long)i * G + c; if (L >= nwg) return false;
        int wgid = (int)L; { const int q = nwg / NXCD, r = nwg % NXCD, xcd = wgid % NXCD, off = wgid / NXCD; wgid = (xcd < r ? xcd * (q + 1) : r * (q + 1) + (xcd - r) * q) + off; }
        const int nig = WGM * nN, gid = wgid / nig, fm = gid * WGM, gsz = (nM - fm) < WGM ? (nM - fm) : WGM;
        u.pm = fm + ((wgid % nig) % gsz); u.pn = (wgid % nig) / gsz; u.b = 0; return true;
    }
};
struct OrderX {
    StaticOrder so; int nextra, pn0;
    __device__ void init(int N, int G_, int c_, int nextra_, int pn0_) { so.init(T, N, G_, c_); nextra = nextra_; pn0 = pn0_; }
    __device__ bool next(int i, Unit& u) const {
        const long L = (long)i * so.G + so.c;
        if (L < so.nwg) return so.next(i, u);
        const int e = (int)(L - so.nwg); if (e >= nextra) return false;
        u.pm = 64; u.pn = pn0 + e; u.b = 0; return true;
    }
    __device__ __forceinline__ void a_ready(const Unit&) const {}
    __device__ __forceinline__ void done(const Unit&) const {}
};

struct OrderBr {
    StaticOrder so;
    __device__ void init(int N, int G_, int c_) { so.init(T, N, G_, c_); }
    __device__ bool next(int i, Unit& u) const { const int q = i / 3; if (!so.next(q, u)) return false; u.b = i - 3 * q; return true; }
    __device__ __forceinline__ void a_ready(const Unit&) const {}
    __device__ __forceinline__ void done(const Unit&) const {}
};

template <class Epi, class Sched, bool ALIGN_EPI = true, bool SP2 = true>
__device__ __forceinline__ void gemm_phase(PG8_LAS unsigned char* lds, const Gemm g, const Sched& S, const Epi& E, const int tid) {
    const int wid = __builtin_amdgcn_readfirstlane(tid >> 6), lane = tid & 63, wr = wid >> 2, wc = wid & 3, fr = lane & 15, fq = lane >> 4;
#define PG8_UA(u) ((const char*)((u).b == 0 ? g.A : ((u).b == 1 ? g.A1 : g.A2)))
#define PG8_UB(u) ((const char*)((u).b == 0 ? g.Bt : ((u).b == 1 ? g.Bt1 : g.Bt2)))
#define PG8_UNT(u) (((u).b == 0 ? g.K : ((u).b == 1 ? g.K1 : g.K2)) / BK)
    unsigned voffA[2], voffB[2];
#pragma unroll
    for (int i = 0; i < 2; ++i) { int Rr, C; stage_rc(tid * 16 + i * 8192, Rr, C); const int Rb = Epi::PERM ? ((Rr & ~31) + perm32(Rr & 31)) : Rr;
        voffA[i] = (unsigned)(Rr * g.lda + C) * 2u; voffB[i] = (unsigned)(Rb * g.ldb + C) * 2u; }
    const size_t kstep = (size_t)(BK * 2);
    const size_t hstepA = (size_t)HALF * g.lda * 2, hstepB = (size_t)HALF * g.ldb * 2;
    const size_t tstepA = 2 * hstepA, tstepB = 2 * hstepB;
    const unsigned ldsw = (unsigned)wid * 1024u;
    const int aoff = lds_byte(wr * 64 + fr, fq * 8), boff = lds_byte(wc * 32 + fr, fq * 8);
#define PG8_SA(b, h) (((b) * 2 + (h)) * HTB)
#define PG8_SB(b, h) ((4 + (b) * 2 + (h)) * HTB)
#define PG8_STAGE(bufoff, gbase, voff) do { _Pragma("unroll") for (int _i = 0; _i < 2; ++_i) \
        __builtin_amdgcn_global_load_lds((const unsigned*)((const char*)(gbase) + (voff)[_i]), (PG8_LAS unsigned*)(lds + (bufoff) + ldsw + _i * 8192), 16, 0, 0); } while (0)
#define PG8_LDA(dst, b, h) do { _Pragma("unroll") for (int m = 0; m < 4; ++m) _Pragma("unroll") for (int k = 0; k < 2; ++k) dst[m][k] = *(const PG8_LAS bf16x8*)(lds + PG8_SA(b, h) + aoff + m * 2048 + k * 1024); } while (0)
#define PG8_LDB(dst, b, h) do { _Pragma("unroll") for (int n = 0; n < 2; ++n) _Pragma("unroll") for (int k = 0; k < 2; ++k) dst[n][k] = *(const PG8_LAS bf16x8*)(lds + PG8_SB(b, h) + boff + n * 2048 + k * 1024); } while (0)
#define PG8_MMA(ai, bj, At, Bt) do { __builtin_amdgcn_s_setprio(1); _Pragma("unroll") for (int m = 0; m < 4; ++m) _Pragma("unroll") for (int n = 0; n < 2; ++n) _Pragma("unroll") for (int k = 0; k < 2; ++k) \
        acc[ai][bj][m][n] = __builtin_amdgcn_mfma_f32_16x16x32_bf16(Bt[n][k], At[m][k], acc[ai][bj][m][n], 0, 0, 0); __builtin_amdgcn_s_setprio(0); } while (0)
#define PG8_WAIT_V(n) asm volatile("s_waitcnt vmcnt(" #n ")" ::: "memory")
#define PG8_WAIT_L(n) asm volatile("s_waitcnt lgkmcnt(" #n ")" ::: "memory")
#define PG8_BAR __builtin_amdgcn_s_barrier()
#define PG8_SCHED __builtin_amdgcn_sched_barrier(0)
    Unit cur, nxt; int ui = 0;
    if (!S.next(0, cur)) return;
    f32x4 acc[2][2][4][2];
#pragma unroll
    for (int a = 0; a < 2; ++a)
#pragma unroll
        for (int b = 0; b < 2; ++b)
#pragma unroll
            for (int m = 0; m < 4; ++m)
#pragma unroll
                for (int n = 0; n < 2; ++n) acc[a][b][m][n] = (f32x4){0.f, 0.f, 0.f, 0.f};
    bf16x8 At[4][2], B0[2][2], B1[2][2];
    const char* cA = PG8_UA(cur) + (size_t)cur.pm * tstepA; const char* cB = PG8_UB(cur) + (size_t)cur.pn * tstepB;
    S.a_ready(cur);
    if constexpr (SP2) {
        PG8_STAGE(PG8_SB(0, 0), cB, voffB); PG8_STAGE(PG8_SB(0, 1), cB + hstepB, voffB); PG8_STAGE(PG8_SA(0, 0), cA, voffA); PG8_STAGE(PG8_SA(0, 1), cA + hstepA, voffA);
        if (wr == 1) PG8_BAR;
        PG8_WAIT_V(2); PG8_BAR;
        PG8_STAGE(PG8_SB(1, 0), cB + kstep, voffB); PG8_STAGE(PG8_SA(1, 0), cA + kstep, voffA); PG8_STAGE(PG8_SB(1, 1), cB + hstepB + kstep, voffB);
        PG8_WAIT_V(6); PG8_BAR;
    } else {
        PG8_STAGE(PG8_SB(0, 0), cB, voffB); PG8_STAGE(PG8_SA(0, 0), cA, voffA); PG8_STAGE(PG8_SB(0, 1), cB + hstepB, voffB); PG8_STAGE(PG8_SA(0, 1), cA + hstepA, voffA);
        if (wr == 1) PG8_BAR;
        PG8_WAIT_V(4); PG8_BAR;
        PG8_STAGE(PG8_SB(1, 0), cB + kstep, voffB); PG8_STAGE(PG8_SA(1, 0), cA + kstep, voffA); PG8_STAGE(PG8_SB(1, 1), cB + hstepB + kstep, voffB);
        PG8_WAIT_V(6); PG8_BAR;
    }
    for (;;) {
        const bool has_next = S.next(ui + 1, nxt);
        const char* nA = has_next ? PG8_UA(nxt) + (size_t)nxt.pm * tstepA : cA; const char* nB = has_next ? PG8_UB(nxt) + (size_t)nxt.pn * tstepB : cB;
        const int nt = PG8_UNT(cur);
        for (int t = 0; t < nt; t += 2) {
            const bool last = (t == nt - 2);
            const char* a1 = cA + (size_t)(t + 1) * kstep;
            const char* a2 = last ? nA : cA + (size_t)(t + 2) * kstep; const char* b2 = last ? nB : cB + (size_t)(t + 2) * kstep;
            const char* a3 = a2 + kstep; const char* b3 = b2 + kstep;
            if (last && has_next) S.a_ready(nxt);
            if constexpr (SP2) {
            PG8_LDB(B0, 0, 0); PG8_LDB(B1, 0, 1); PG8_SCHED; PG8_LDA(At, 0, 0); PG8_STAGE(PG8_SA(1, 1), a1 + hstepA, voffA);
            PG8_WAIT_V(8); PG8_WAIT_L(0); PG8_BAR; PG8_MMA(0, 0, At, B0); PG8_MMA(0, 1, At, B1); PG8_BAR; PG8_SCHED;
            PG8_LDA(At, 0, 1); PG8_STAGE(PG8_SB(0, 0), b2, voffB); PG8_STAGE(PG8_SB(0, 1), b2 + hstepB, voffB); PG8_STAGE(PG8_SA(0, 0), a2, voffA);
            PG8_WAIT_V(8); PG8_WAIT_L(0); PG8_BAR; PG8_MMA(1, 0, At, B0); PG8_MMA(1, 1, At, B1); PG8_BAR; PG8_SCHED;
            PG8_LDB(B0, 1, 0); PG8_LDB(B1, 1, 1); PG8_SCHED; PG8_LDA(At, 1, 0); PG8_STAGE(PG8_SA(0, 1), a2 + hstepA, voffA);
            PG8_WAIT_V(8); PG8_WAIT_L(0); PG8_BAR; PG8_MMA(0, 0, At, B0); PG8_MMA(0, 1, At, B1); PG8_BAR; PG8_SCHED;
            PG8_LDA(At, 1, 1); PG8_STAGE(PG8_SB(1, 0), b3, voffB); PG8_STAGE(PG8_SB(1, 1), b3 + hstepB, voffB); PG8_STAGE(PG8_SA(1, 0), a3, voffA);
            PG8_WAIT_V(8); PG8_WAIT_L(0); PG8_BAR; PG8_MMA(1, 0, At, B0); PG8_MMA(1, 1, At, B1); PG8_BAR; PG8_SCHED;
            } else {
            PG8_LDB(B0, 0, 0); PG8_SCHED; PG8_LDA(At, 0, 0); PG8_STAGE(PG8_SA(1, 1), a1 + hstepA, voffA);
            PG8_WAIT_L(8); PG8_BAR; PG8_WAIT_L(0); PG8_MMA(0, 0, At, B0); PG8_BAR; PG8_SCHED;
            PG8_LDB(B1, 0, 1); PG8_STAGE(PG8_SB(0, 0), b2, voffB);
            PG8_BAR; PG8_WAIT_L(0); PG8_MMA(0, 1, At, B1); PG8_BAR;
            PG8_LDA(At, 0, 1); PG8_STAGE(PG8_SA(0, 0), a2, voffA);
            PG8_BAR; PG8_WAIT_L(0); PG8_MMA(1, 0, At, B0); PG8_BAR; PG8_SCHED;
            PG8_STAGE(PG8_SB(0, 1), b2 + hstepB, voffB);
            PG8_WAIT_V(6); PG8_BAR; PG8_MMA(1, 1, At, B1); PG8_BAR;
            PG8_LDB(B0, 1, 0); PG8_SCHED; PG8_LDA(At, 1, 0); PG8_STAGE(PG8_SA(0, 1), a2 + hstepA, voffA);
            PG8_WAIT_L(8); PG8_BAR; PG8_WAIT_L(0); PG8_MMA(0, 0, At, B0); PG8_BAR; PG8_SCHED;
            PG8_LDB(B1, 1, 1); PG8_STAGE(PG8_SB(1, 0), b3, voffB);
            PG8_BAR; PG8_WAIT_L(0); PG8_MMA(0, 1, At, B1); PG8_BAR;
            PG8_LDA(At, 1, 1); PG8_STAGE(PG8_SA(1, 0), a3, voffA);
            PG8_BAR; PG8_WAIT_L(0); PG8_MMA(1, 0, At, B0); PG8_BAR; PG8_SCHED;
            PG8_STAGE(PG8_SB(1, 1), b3 + hstepB, voffB);
            PG8_WAIT_V(6); PG8_BAR; PG8_MMA(1, 1, At, B1); PG8_BAR;
            }
        }
        if constexpr (ALIGN_EPI) { if (wr == 0) PG8_BAR; }
        E(acc, cur, wr, wc, fr, fq); S.done(cur);
        if (!has_next) break;
#pragma unroll
        for (int a = 0; a < 2; ++a)
#pragma unroll
            for (int b = 0; b < 2; ++b)
#pragma unroll
                for (int m = 0; m < 4; ++m)
#pragma unroll
                    for (int n = 0; n < 2; ++n) acc[a][b][m][n] = (f32x4){0.f, 0.f, 0.f, 0.f};
        cur = nxt; cA = nA; cB = nB; ++ui;
        if constexpr (ALIGN_EPI) { if (wr == 1) PG8_BAR; }
    }
    PG8_WAIT_V(0);
    if constexpr (!ALIGN_EPI) { if (wr == 0) PG8_BAR; }
    PG8_BAR;
#undef PG8_UA
#undef PG8_UB
#undef PG8_UNT
#undef PG8_SA
#undef PG8_SB
#undef PG8_STAGE
#undef PG8_LDA
#undef PG8_LDB
#undef PG8_MMA
#undef PG8_WAIT_V
#undef PG8_WAIT_L
#undef PG8_BAR
#undef PG8_SCHED
}

struct EpiIn {
    static constexpr bool PERM = true;
    u16 *Q, *Kb, *Vb, *S, *F, *FC, *G;
    __device__ __forceinline__ void operator()(const f32x4 (&acc)[2][2][4][2], const Unit& u, int wr, int wc, int fr, int fq) const {
        const int pn = u.pn; u16* base; int ld, act = 0, radj = 0;
        if (pn < 4) { base = Q + pn * 256; ld = 1024; }
        else if (pn == 4) { base = Kb; ld = 256; }
        else if (pn == 5) { base = Vb; ld = 256; }
        else if (pn < 10) { base = S + (pn - 6) * 256; ld = 1024; act = 1; }
        else if (pn < 12) { if (u.pm == 64) { base = FC + (pn - 10) * 256; radj = T; } else base = F + (pn - 10) * 256; ld = 512; }
        else { base = G + (pn - 12) * 256; ld = 3072; act = 2; }
        const int row0 = u.pm * BM + wr * 64 + fr - radj, col0 = wc * 32 + 8 * fq;
#pragma unroll
        for (int ai = 0; ai < 2; ++ai)
#pragma unroll
            for (int m = 0; m < 4; ++m) { u16* rowp = base + (size_t)(row0 + ai * HALF + m * 16) * ld + col0;
#pragma unroll
                for (int bj = 0; bj < 2; ++bj) { f32x4 v0 = acc[ai][bj][m][0], v1 = acc[ai][bj][m][1];
                    if (act == 1) {
#pragma unroll
                        for (int j = 0; j < 4; ++j) { v0[j] = fgelu_tanh(v0[j]); v1[j] = fgelu_tanh(v1[j]); } }
                    else if (act == 2) {
#pragma unroll
                        for (int j = 0; j < 4; ++j) { v0[j] = fsigmoid(v0[j]); v1[j] = fsigmoid(v1[j]); } }
                    u32x4 w; w.x = pk2(v0[0], v0[1]); w.y = pk2(v0[2], v0[3]); w.z = pk2(v1[0], v1[1]); w.w = pk2(v1[2], v1[3]);
                    *(u32x4*)(rowp + bj * HALF) = w; } }
    }
};
struct EpiBr {
    static constexpr bool PERM = true;
    const u16* G; u16* Mg;
    __device__ __forceinline__ void operator()(const f32x4 (&acc)[2][2][4][2], const Unit& u, int wr, int wc, int fr, int fq) const {
        const int row0 = u.pm * BM + wr * 64 + fr, col0 = u.pn * BM + wc * 32 + 8 * fq; const bool first = (u.b == 0); const u16* G = this->G + u.b * 1024;
#pragma unroll
        for (int ai = 0; ai < 2; ++ai)
#pragma unroll
            for (int m = 0; m < 4; ++m) { const size_t r = (size_t)(row0 + ai * HALF + m * 16);
#pragma unroll
                for (int bj = 0; bj < 2; ++bj) { const int c = col0 + bj * HALF;
                    const u32x4 gw = *(const u32x4*)(G + r * 3072 + c);
                    f32x4 v0 = acc[ai][bj][m][0], v1 = acc[ai][bj][m][1];
                    v0[0] *= bflo(gw.x); v0[1] *= bfhi(gw.x); v0[2] *= bflo(gw.y); v0[3] *= bfhi(gw.y);
                    v1[0] *= bflo(gw.z); v1[1] *= bfhi(gw.z); v1[2] *= bflo(gw.w); v1[3] *= bfhi(gw.w);
                    u16* mp = Mg + r * 1024 + c;
                    if (!first) { const u32x4 pw = *(const u32x4*)mp;
                        v0[0] += bflo(pw.x); v0[1] += bfhi(pw.x); v0[2] += bflo(pw.y); v0[3] += bfhi(pw.y);
                        v1[0] += bflo(pw.z); v1[1] += bfhi(pw.z); v1[2] += bflo(pw.w); v1[3] += bfhi(pw.w); }
                    u32x4 w; w.x = pk2(v0[0], v0[1]); w.y = pk2(v0[2], v0[3]); w.z = pk2(v1[0], v1[1]); w.w = pk2(v1[2], v1[3]);
                    *(u32x4*)mp = w; } }
    }
};
struct EpiRes {
    static constexpr bool PERM = false;
    const float *xin_lat; float *xo_lat; const float *gate_lat; const float* st; const float *lg, *lb;
    __device__ __forceinline__ void operator()(const f32x4 (&acc)[2][2][4][2], const Unit& u, int wr, int wc, int fr, int fq) const {
        const int row0 = u.pm * BM + wr * 64 + fr, col0 = u.pn * BM + wc * 32 + 4 * fq;
        f32x2 sv[2][4];
#pragma unroll
        for (int ai = 0; ai < 2; ++ai)
#pragma unroll
            for (int m = 0; m < 4; ++m) sv[ai][m] = st ? *(const f32x2*)(st + 2 * (size_t)(row0 + ai * HALF + m * 16)) : (f32x2){0.f, 1.f};
#pragma unroll
        for (int bj = 0; bj < 2; ++bj)
#pragma unroll
            for (int n = 0; n < 2; ++n) { const int c = col0 + bj * HALF + n * 16;
                const f32x4 gv = *(const f32x4*)(gate_lat + c);
                f32x4 g4 = (f32x4){1.f, 1.f, 1.f, 1.f}, b4 = (f32x4){0.f, 0.f, 0.f, 0.f};
                if (st) { g4 = *(const f32x4*)(lg + c); b4 = *(const f32x4*)(lb + c); }
#pragma unroll
                for (int ai = 0; ai < 2; ++ai)
#pragma unroll
                    for (int m = 0; m < 4; ++m) { const size_t off = (size_t)(row0 + ai * HALF + m * 16) * D + c;
                        f32x4 xv = *(const f32x4*)(xin_lat + off);
                        xv = (xv - sv[ai][m][0]) * sv[ai][m][1] * g4 + b4;
                        *(f32x4*)(xo_lat + off) = xv * ALPHA + gv * acc[ai][bj][m][n]; } }
    }
};
struct EpiUp {
    static constexpr bool PERM = true;
    u16* ACT;
    __device__ __forceinline__ void operator()(const f32x4 (&acc)[2][2][4][2], const Unit& u, int wr, int wc, int fr, int fq) const {
        const int row0 = u.pm * BM + wr * 64 + fr, col0 = u.pn * HALF + wc * 32 + 8 * fq;
#pragma unroll
        for (int ai = 0; ai < 2; ++ai)
#pragma unroll
            for (int m = 0; m < 4; ++m) { u16* rowp = ACT + (size_t)(row0 + ai * HALF + m * 16) * FFH + col0;
                f32x4 g0 = acc[ai][0][m][0], g1 = acc[ai][0][m][1]; const f32x4 u0 = acc[ai][1][m][0], u1 = acc[ai][1][m][1];
#pragma unroll
                for (int j = 0; j < 4; ++j) { g0[j] = g0[j] * fsigmoid(g0[j]) * u0[j]; g1[j] = g1[j] * fsigmoid(g1[j]) * u1[j]; }
                u32x4 w; w.x = pk2(g0[0], g0[1]); w.y = pk2(g0[2], g0[3]); w.z = pk2(g1[0], g1[1]); w.w = pk2(g1[2], g1[3]);
                *(u32x4*)rowp = w; }
    }
};
}

namespace att {
constexpr int NW = 8, QBLK = 32, KVBLK = 64;
constexpr float SCALE = 0.088388347648318440f, THR = 8.f;
constexpr int LDQ = 1024, LDK = 256, LDO = 1024;
constexpr size_t SHM_V = KVBLK * 128 * 2, SHM_K = KVBLK * 128 * 2, SHM_ATTN = 3 * SHM_V + 2 * SHM_K + NW * 64 * 4;
#define KSWZ(row, colB) ((row) * 256 + ((colB) ^ (((row) & 7) << 4)))
#define SBAR() __builtin_amdgcn_sched_barrier(0)
__device__ __forceinline__ unsigned cvtpk(float lo, float hi) { unsigned r; asm volatile("v_cvt_pk_bf16_f32 %0, %1, %2" : "=v"(r) : "v"(lo), "v"(hi)); return r; }
__device__ __forceinline__ void partialSM(f32x16& p0) {
  for (int r = 0; r < 16; ++r) p0[r] = __builtin_amdgcn_exp2f(p0[r]);
}
__device__ __forceinline__ void finishSM(f32x16& p0, f32x16& p1, float& l_reg, bf16x8& pa0, bf16x8& pa1, bf16x8& pa2, bf16x8& pa3) {
  for (int r = 0; r < 16; ++r) p1[r] = __builtin_amdgcn_exp2f(p1[r]);
  float ps = 0; for (int r = 0; r < 16; ++r) ps += p0[r]; for (int r = 0; r < 16; ++r) ps += p1[r];
  { auto rr = __builtin_amdgcn_permlane32_swap(__float_as_uint(ps), __float_as_uint(ps), false, false);
    ps = __uint_as_float(rr[0]) + __uint_as_float(rr[1]); }
  l_reg += ps;
#define PK4(P, BASE, OUT) do { unsigned a0 = cvtpk(P[BASE + 0], P[BASE + 1]), a1 = cvtpk(P[BASE + 2], P[BASE + 3]);   \
    unsigned b0 = cvtpk(P[BASE + 4], P[BASE + 5]), b1 = cvtpk(P[BASE + 6], P[BASE + 7]);                              \
    auto r0 = __builtin_amdgcn_permlane32_swap(a0, b0, false, false); auto r1 = __builtin_amdgcn_permlane32_swap(a1, b1, false, false); \
    u32x4 w = {r0[0], r1[0], r0[1], r1[1]}; OUT = *reinterpret_cast<bf16x8*>(&w); } while (0)
  PK4(p0, 0, pa0); PK4(p0, 8, pa1); PK4(p1, 0, pa2); PK4(p1, 8, pa3);
#undef PK4
}
__device__ __forceinline__ void qkt(f32x16& p0, f32x16& p1, const u16* Ks, const bf16x8* qr, int r32, int hi, float noff) {
  for (int r = 0; r < 16; ++r) { p0[r] = noff; p1[r] = noff; }
  for (int d0 = 0; d0 < 8; ++d0) { int cb = (d0 * 16 + hi * 8) * 2;
    bf16x8 b0 = *reinterpret_cast<const bf16x8*>((const char*)Ks + KSWZ(r32, cb));
    bf16x8 b1 = *reinterpret_cast<const bf16x8*>((const char*)Ks + KSWZ(32 + r32, cb));
    p0 = __builtin_amdgcn_mfma_f32_32x32x16_bf16(b0, qr[d0], p0, 0, 0, 0);
    p1 = __builtin_amdgcn_mfma_f32_32x32x16_bf16(b1, qr[d0], p1, 0, 0, 0); }
}
__device__ __forceinline__ int v_st(int k, int c) { const int kk = (k & ~0xC) | ((k & 4) << 1) | ((k & 8) >> 1); return ((kk >> 3) * 4 + (c >> 5)) * 512 + ((kk & 7) * 32 + (c & 31)) * 2; }
__device__ __forceinline__ int v_rd_base(int lane) { return ((lane & 3) << 3) | (((lane >> 2) & 3) << 6) | (((lane >> 4) & 1) << 5) | (((lane >> 5) & 1) << 8); }
constexpr int v_rd_off(int d0, int ks, int half) { return d0 * 512 + ks * 4096 + half * 2048; }
template <int OFF> __device__ __forceinline__ s16x4 tr_read(int vb) {
  s16x4 r; asm volatile("ds_read_b64_tr_b16 %0, %1 offset:%2" : "=&v"(r) : "v"(vb), "i"(OFF) : "memory"); return r;
}
struct VFrag { s16x4 l0, h0, l1, h1, l2, h2, l3, h3; };
template <int D0> __device__ __forceinline__ void pv_reads(VFrag& f, int vb) {
  f.l0 = tr_read<v_rd_off(D0, 0, 0)>(vb); f.h0 = tr_read<v_rd_off(D0, 0, 1)>(vb); f.l1 = tr_read<v_rd_off(D0, 1, 0)>(vb); f.h1 = tr_read<v_rd_off(D0, 1, 1)>(vb);
  f.l2 = tr_read<v_rd_off(D0, 2, 0)>(vb); f.h2 = tr_read<v_rd_off(D0, 2, 1)>(vb); f.l3 = tr_read<v_rd_off(D0, 3, 0)>(vb); f.h3 = tr_read<v_rd_off(D0, 3, 1)>(vb);
}
__device__ __forceinline__ void pv_mma(f32x16& od, const VFrag& f, bf16x8 pa0, bf16x8 pa1, bf16x8 pa2, bf16x8 pa3) {
#define PK(L, H) (bf16x8){L[0], L[1], L[2], L[3], H[0], H[1], H[2], H[3]}
  od = __builtin_amdgcn_mfma_f32_32x32x16_bf16(pa0, PK(f.l0, f.h0), od, 0, 0, 0);
  od = __builtin_amdgcn_mfma_f32_32x32x16_bf16(pa1, PK(f.l1, f.h1), od, 0, 0, 0);
  od = __builtin_amdgcn_mfma_f32_32x32x16_bf16(pa2, PK(f.l2, f.h2), od, 0, 0, 0);
  od = __builtin_amdgcn_mfma_f32_32x32x16_bf16(pa3, PK(f.l3, f.h3), od, 0, 0, 0);
#undef PK
}
__device__ __forceinline__ void pv_d0(f32x16* o, int vb, bf16x8 pa0, bf16x8 pa1, bf16x8 pa2, bf16x8 pa3) {
  VFrag fa, fb;
  pv_reads<0>(fa, vb); pv_reads<1>(fb, vb);
  asm volatile("s_waitcnt lgkmcnt(8)" ::: "memory"); SBAR();
  pv_mma(o[0], fa, pa0, pa1, pa2, pa3); SBAR();
  pv_reads<2>(fa, vb);
  asm volatile("s_waitcnt lgkmcnt(8)" ::: "memory"); SBAR();
  pv_mma(o[1], fb, pa0, pa1, pa2, pa3); SBAR();
  pv_reads<3>(fb, vb);
  asm volatile("s_waitcnt lgkmcnt(8)" ::: "memory"); SBAR();
  pv_mma(o[2], fa, pa0, pa1, pa2, pa3); SBAR();
  asm volatile("s_waitcnt lgkmcnt(0)" ::: "memory"); SBAR();
  pv_mma(o[3], fb, pa0, pa1, pa2, pa3);
}
__device__ __forceinline__ void attn_dense_body(const u16* Qb, const u16* __restrict__ Kh, const u16* __restrict__ Vh, u16* Ob, int seq, char* lds, const int tid, const float noff) {
  const int wid = tid >> 6, lane = tid & 63, r32 = lane & 31, hi = lane >> 5;
  LAS unsigned char* l3 = (LAS unsigned char*)lds;
  u16* V_lds = (u16*)lds; u16* K_lds = (u16*)(lds + 3 * SHM_V);
  float* ws = (float*)(lds + 3 * SHM_V + 2 * SHM_K) + wid * 64; float* li_l = ws;
  float l_reg = 0; f32x16 o[4] = {}; bf16x8 qr[8];
  const u16* Qw = Qb + (long)(wid * QBLK + r32) * LDQ + hi * 8;
#pragma unroll
  for (int d0 = 0; d0 < 8; ++d0) qr[d0] = *reinterpret_cast<const bf16x8*>(Qw + d0 * 16);
  const int vb0 = (int)(uintptr_t)V_lds + v_rd_base(lane);
  const int wu = __builtin_amdgcn_readfirstlane(wid);
  unsigned ksrc0, ksrc1, vsrc0, vsrc1;
  { const int r = wid * 4 + (lane >> 4), p = lane & 15, c = p ^ (r & 7); ksrc0 = (unsigned)(r * LDK * 2 + c * 16); ksrc1 = ksrc0 + 32u * LDK * 2u; }
  { const int st = wid * 2 + (lane >> 5), within = lane & 31, kk = (st >> 2) * 8 + (within >> 2), c = (st & 3) * 32 + (within & 3) * 8;
    const int k = (kk & ~0xC) | ((kk & 4) << 1) | ((kk & 8) >> 1); vsrc0 = (unsigned)(k * LDK * 2 + c * 2); vsrc1 = vsrc0 + 32u * LDK * 2u; }
#define DMA_TILE(k0, ks, vs) do { const char* kt_ = (const char*)Kh + (size_t)(k0) * (LDK * 2); const char* vt_ = (const char*)Vh + (size_t)(k0) * (LDK * 2); \
    asm volatile("" : "+s"(kt_), "+s"(vt_));     \
    __builtin_amdgcn_global_load_lds((const unsigned*)(kt_ + ksrc0), (LAS unsigned*)(l3 + 3 * (int)SHM_V + (ks) * (int)SHM_K + wu * 1024), 16, 0, 0); \
    __builtin_amdgcn_global_load_lds((const unsigned*)(kt_ + ksrc1), (LAS unsigned*)(l3 + 3 * (int)SHM_V + (ks) * (int)SHM_K + wu * 1024 + 8192), 16, 0, 0); \
    __builtin_amdgcn_global_load_lds((const unsigned*)(vt_ + vsrc0), (LAS unsigned*)(l3 + (vs) * (int)SHM_V + wu * 1024), 16, 0, 0); \
    __builtin_amdgcn_global_load_lds((const unsigned*)(vt_ + vsrc1), (LAS unsigned*)(l3 + (vs) * (int)SHM_V + wu * 1024 + 8192), 16, 0, 0); } while (0)
#define LANDED() asm volatile("s_waitcnt vmcnt(0)" ::: "memory")
  f32x16 pA0, pA1, pB0, pB1; bf16x8 pa0, pa1, pa2, pa3; const int NT = seq / KVBLK;
  DMA_TILE(0, 0, 0); LANDED(); __syncthreads();
  DMA_TILE(KVBLK, 1, 1);
  qkt(pA0, pA1, K_lds, qr, r32, hi, noff); partialSM(pA0);
  LANDED(); __syncthreads();
  int sv = 0;
  for (int j = 1; j + 1 < NT; j += 2) {
    { const int sn = (sv == 0) ? 2 : sv - 1;
      SBAR(); DMA_TILE((j + 1) * KVBLK, 0, sn); SBAR();
      qkt(pB0, pB1, (u16*)((char*)K_lds + SHM_K), qr, r32, hi, noff);
      finishSM(pA0, pA1, l_reg, pa0, pa1, pa2, pa3); SBAR();
      pv_d0(o, vb0 + sv * (int)SHM_V, pa0, pa1, pa2, pa3); partialSM(pB0);
      LANDED(); __syncthreads(); sv = (sv == 2) ? 0 : sv + 1; }
    { const int sn = (sv == 0) ? 2 : sv - 1;
      SBAR(); DMA_TILE((j + 2) * KVBLK, 1, sn); SBAR();
      qkt(pA0, pA1, K_lds, qr, r32, hi, noff);
      finishSM(pB0, pB1, l_reg, pa0, pa1, pa2, pa3); SBAR();
      pv_d0(o, vb0 + sv * (int)SHM_V, pa0, pa1, pa2, pa3); partialSM(pA0);
      LANDED(); __syncthreads(); sv = (sv == 2) ? 0 : sv + 1; }
  }
  { const int svl = (sv == 2) ? 0 : sv + 1;
    SBAR(); qkt(pB0, pB1, (u16*)((char*)K_lds + SHM_K), qr, r32, hi, noff);
    finishSM(pA0, pA1, l_reg, pa0, pa1, pa2, pa3); SBAR();
    pv_d0(o, vb0 + sv * (int)SHM_V, pa0, pa1, pa2, pa3); partialSM(pB0);
    finishSM(pB0, pB1, l_reg, pa0, pa1, pa2, pa3); SBAR();
    pv_d0(o, vb0 + svl * (int)SHM_V, pa0, pa1, pa2, pa3); }
#undef DMA_TILE
#undef LANDED
  if (hi == 0) li_l[r32] = l_reg; asm volatile("s_waitcnt lgkmcnt(0)" ::: "memory");
  float rli[16];
#pragma unroll
  for (int r = 0; r < 16; ++r) rli[r] = __builtin_amdgcn_rcpf(li_l[crow(r, hi)]);
  u16* Ow = Ob + (long)(wid * QBLK) * LDO;
#pragma unroll
  for (int r = 0; r < 16; ++r) { int orow = crow(r, hi);
    for (int d0 = 0; d0 < 4; ++d0) Ow[(long)orow * LDO + d0 * 32 + r32] = (u16)f2bf(o[d0][r] * rli[r]); }
}
}

#define XB_TMO      128
#define XB_XCNT(j)  (256  + 64 * (j))
#define XB_XSUB(j)  (1280 + 64 * (j))
#define XB_XGEN(j)  (2304 + 64 * (j))
#define XB_TOP      3328
#define XB_TOPGEN   3392
#define XCD_BAR_WORDS 3456
#define XB_SPIN_CAP (1u << 18)
__device__ __forceinline__ unsigned xb_ld(unsigned* p)              { return __hip_atomic_load(p, __ATOMIC_RELAXED, __HIP_MEMORY_SCOPE_AGENT); }
__device__ __forceinline__ unsigned xb_add(unsigned* p, unsigned v) { return __hip_atomic_fetch_add(p, v, __ATOMIC_RELAXED, __HIP_MEMORY_SCOPE_AGENT); }
__device__ __forceinline__ unsigned xb_xcc_id() { return (unsigned)__builtin_amdgcn_s_getreg((3 << 11) | 20) & 0xFu; }
#define XB_SPIN(cond, bar) do { unsigned _sp = 0; while (cond) { __builtin_amdgcn_s_sleep(1); \
    if ((++_sp & 255u) == 0u) { if (xb_ld(&(bar)[XB_TMO])) break; if (_sp > XB_SPIN_CAP) { atomicAdd(&(bar)[XB_TMO], 1u); break; } } } } while (0)
__device__ __forceinline__ void xcd_barrier_complete(unsigned* bar, unsigned x, unsigned& nloc, unsigned& nx) {
    const unsigned G = gridDim.x * gridDim.y * gridDim.z;
    unsigned sum, cnt, mine, sp = 0u;
    for (;;) {
        sum = 0u; cnt = 0u; mine = 0u;
#pragma unroll
        for (unsigned j = 0; j < 16; ++j) { const unsigned c = xb_ld(&bar[XB_XCNT(j)]); sum += c; cnt += (c > 0u) ? 1u : 0u; mine = (j == x) ? c : mine; }
        if (sum == G) break;
        __builtin_amdgcn_s_sleep(1);
        if ((++sp & 255u) == 0u) { if (xb_ld(&bar[XB_TMO])) break; if (sp > XB_SPIN_CAP) { atomicAdd(&bar[XB_TMO], 1u); break; } }
    }
    nloc = mine > 0u ? mine : 1u; nx = cnt > 0u ? cnt : 1u;
}
__device__ __forceinline__ void xcd_barrier(unsigned* bar, volatile LAS unsigned* st, const int tid) {
    asm volatile("s_waitcnt vmcnt(0)" ::: "memory");
    __syncthreads();
    if (tid == 0) {
        const unsigned x = xb_xcc_id();
        __builtin_amdgcn_s_waitcnt(0);
        unsigned nloc = st[0], nx = st[1];
        if (nloc == 0u) { xcd_barrier_complete(bar, x, nloc, nx); st[0] = nloc; st[1] = nx; }
        const unsigned old = xb_add(&bar[XB_XSUB(x)], 1u);
        const unsigned gen = old / nloc;
        if (old + 1u == (gen + 1u) * nloc) {
            __builtin_amdgcn_fence(__ATOMIC_RELEASE, "agent");
            asm volatile("s_waitcnt vmcnt(0)" ::: "memory");
            const unsigned og = xb_add(&bar[XB_TOP], 1u);
            const unsigned tg = og / nx;
            if (og + 1u == (tg + 1u) * nx) xb_add(&bar[XB_TOPGEN], 1u);
            else XB_SPIN(xb_ld(&bar[XB_TOPGEN]) == tg, bar);
            __builtin_amdgcn_fence(__ATOMIC_ACQUIRE, "agent");
            xb_add(&bar[XB_XGEN(x)], 1u);
            asm volatile("s_waitcnt vmcnt(0)" ::: "memory");
        } else {
            XB_SPIN(xb_ld(&bar[XB_XGEN(x)]) == gen, bar);
            __builtin_amdgcn_fence(__ATOMIC_ACQUIRE, "agent");
            asm volatile("s_waitcnt vmcnt(0)" ::: "memory");
        }
    }
    __syncthreads();
}

struct Params { const float* in[23]; float* out; unsigned char* ws; int ph_lo, ph_hi; };
static_assert(sizeof(Params) == 23 * 8 + 8 + 8 + 8, "no padding in Params");

struct Ctx {
    int tid, lane, wid, G, gw, NGW;
    unsigned char* smem;
};

template <int MODE>
__device__ __forceinline__ void transpose_job(const Ctx& C, const float* W, int K, int N, u16* WT, int ldt) {
    float* scr = (float*)(C.smem + C.wid * 16384);
    const int nblk = N / 32, nitems = (K / 64) * nblk, lane = C.lane;
    for (int item = C.gw; item < nitems; item += C.NGW) {
        const int kb = item / nblk, nb = item % nblk, k0 = 64 * kb, n0 = 32 * nb;
        float tv[32];
#pragma unroll
        for (int i = 0; i < 32; ++i) tv[i] = __builtin_nontemporal_load(&W[(size_t)(k0 + 2 * i + (lane >> 5)) * N + n0 + (lane & 31)]);
#pragma unroll
        for (int i = 0; i < 32; ++i) scr[(2 * i + (lane >> 5)) * 33 + (lane & 31)] = tv[i];
        asm volatile("s_waitcnt lgkmcnt(0)" ::: "memory");
        const int c = lane & 7;
#pragma unroll
        for (int j = 0; j < 4; ++j) { const int n = (lane >> 3) + 8 * j; const float* s = scr + (8 * c) * 33 + n;
            u32x4 o; o.x = pk2(s[0 * 33], s[1 * 33]); o.y = pk2(s[2 * 33], s[3 * 33]); o.z = pk2(s[4 * 33], s[5 * 33]); o.w = pk2(s[6 * 33], s[7 * 33]);
            int row = n0 + n;
            if (MODE == 1) { const int b = row / FFH, jj = row % FFH; row = (jj / 128) * 256 + b * 128 + (jj % 128); }
            *(u32x4*)(WT + (size_t)row * ldt + k0 + 8 * c) = o; }
        asm volatile("s_waitcnt lgkmcnt(0)" ::: "memory");
    }
}
__device__ __forceinline__ void fold_fourier_job(const Ctx& C, const float* Wf, u16* Bt) {
    f32x2* tab = (f32x2*)(C.smem + 131072);
    __syncthreads();
    if (C.tid < 128) { float s, c; sincospif(2.0f * (float)C.tid / 128.0f, &s, &c); tab[C.tid] = (f32x2){c, s}; }
    __syncthreads();
    const int gt = blockIdx.x * 512 + C.tid, NT_ = C.G * 512;
    float* ct = (float*)(C.smem + C.wid * 4096);
    for (int id = gt; id < 131072; id += NT_) {
        const int n = id & 1023, combo = id >> 10, c8 = combo & 15, ro = (combo >> 4) & 1, g = combo >> 5;
        const float sc = 0.08838834764831845f;
#pragma unroll
        for (int i = 0; i < 16; ++i) { const int q = C.lane + 64 * i, k2 = q >> 3, e = q & 7; const f32x2 cs = tab[(k2 * (c8 * 8 + e)) & 127]; ct[q] = (ro ? cs.y : cs.x) * sc; }
        asm volatile("s_waitcnt lgkmcnt(0)" ::: "memory");
        float a[8] = {0.f, 0.f, 0.f, 0.f, 0.f, 0.f, 0.f, 0.f};
        const float* wp = Wf + (size_t)(g * 128) * 1024 + n;
        const f32x4* ct4 = (const f32x4*)ct;
#pragma unroll 16
        for (int k2 = 0; k2 < 128; ++k2) { const float w = wp[(size_t)k2 * 1024]; const f32x4 c0 = ct4[2 * k2], c1 = ct4[2 * k2 + 1];
            a[0] += c0[0] * w; a[1] += c0[1] * w; a[2] += c0[2] * w; a[3] += c0[3] * w; a[4] += c1[0] * w; a[5] += c1[1] * w; a[6] += c1[2] * w; a[7] += c1[3] * w; }
        u32x4 o; o.x = pk2(a[0], a[1]); o.y = pk2(a[2], a[3]); o.z = pk2(a[4], a[5]); o.w = pk2(a[6], a[7]);
        *(u32x4*)(Bt + (size_t)n * 2560 + ro * 512 + g * 128 + c8 * 8) = o;
        asm volatile("s_waitcnt lgkmcnt(0)" ::: "memory");
    }
}

__device__ __forceinline__ void ln_norm(f32x4 (&v)[4], float& mean_o, float& rstd_o) {
    float s = 0.f;
#pragma unroll
    for (int j = 0; j < 4; ++j) s += (v[j][0] + v[j][1]) + (v[j][2] + v[j][3]);
    const float mean = wave_sum(s) * (1.f / D); float s2 = 0.f;
#pragma unroll
    for (int j = 0; j < 4; ++j) { v[j] = v[j] - mean; s2 += (v[j][0] * v[j][0] + v[j][1] * v[j][1]) + (v[j][2] * v[j][2] + v[j][3] * v[j][3]); }
    const float rstd = 1.0f / sqrtf(wave_sum(s2) * (1.f / D) + LN_EPS);
#pragma unroll
    for (int j = 0; j < 4; ++j) v[j] = v[j] * rstd;
    mean_o = mean; rstd_o = rstd;
}
__device__ __forceinline__ void ln_rows(const Ctx& C, int nrows, const float* src, float* dst, const float* lg, const float* lb, bool do_h, const float* mod, int shift_off, int scale_off,
                                        u16* H, float* st, bool write_x, bool xmap) {
    f32x4 g4[4], b4[4], sh[4], sc[4];
#pragma unroll
    for (int j = 0; j < 4; ++j) { g4[j] = (f32x4){1.f, 1.f, 1.f, 1.f}; b4[j] = (f32x4){0.f, 0.f, 0.f, 0.f}; sh[j] = b4[j]; sc[j] = g4[j]; }
    if (lg) {
#pragma unroll
        for (int j = 0; j < 4; ++j) { g4[j] = *(const f32x4*)(lg + 4 * C.lane + 256 * j); b4[j] = *(const f32x4*)(lb + 4 * C.lane + 256 * j); } }
    if (do_h) {
#pragma unroll
        for (int j = 0; j < 4; ++j) { sh[j] = *(const f32x4*)(mod + shift_off + 4 * C.lane + 256 * j); sc[j] = *(const f32x4*)(mod + scale_off + 4 * C.lane + 256 * j) + 1.0f; } }
    const bool xm = xmap && C.G == 256 && nrows == T;
    const int mstep = xm ? 256 : C.NGW, mend = xm ? (int)(2048 * (blockIdx.x & 7)) + 2048 : nrows;
    int m = xm ? (int)(2048 * (blockIdx.x & 7) + (blockIdx.x >> 3) * 8) + C.wid : C.gw; f32x4 nv[4];
    if (m < mend) {
#pragma unroll
        for (int j = 0; j < 4; ++j) nv[j] = *(const f32x4*)(src + (size_t)m * D + 4 * C.lane + 256 * j); }
    for (; m < mend; m += mstep) {
        f32x4 v[4];
#pragma unroll
        for (int j = 0; j < 4; ++j) v[j] = nv[j];
        { const int mn = m + mstep;
          if (mn < mend) {
#pragma unroll
              for (int j = 0; j < 4; ++j) nv[j] = *(const f32x4*)(src + (size_t)mn * D + 4 * C.lane + 256 * j); } }
        float mu, rs;
        if (lg) {
            ln_norm(v, mu, rs);
            if (st && C.lane == 0) *(f32x2*)(st + 2 * (size_t)m) = (f32x2){mu, rs};
#pragma unroll
            for (int j = 0; j < 4; ++j) { v[j] = v[j] * g4[j] + b4[j]; if (write_x) *(f32x4*)(dst + (size_t)m * D + 4 * C.lane + 256 * j) = v[j]; }
        }
        if (do_h) {
            ln_norm(v, mu, rs);
            u32x2* hp = (u32x2*)(H + (size_t)m * D) + C.lane;
#pragma unroll
            for (int j = 0; j < 4; ++j) { const f32x4 h = v[j] * sc[j] + sh[j]; u32x2 w; w.x = pk2(h[0], h[1]); w.y = pk2(h[2], h[3]); hp[64 * j] = w; }
        }
    }
}
__device__ __forceinline__ void ln_pass(const Ctx& C, int nrows, const float* src_lat, const float* src_ctx, float* dst_lat, float* dst_ctx,
                                        const float* lg, const float* lb, bool do_h, const float* mod_lat, const float* mod_ctx, int shift_off, int scale_off, u16* H, float* st, bool write_x) {
    ln_rows(C, T, src_lat, dst_lat, lg, lb, do_h, mod_lat, shift_off, scale_off, H, st, write_x, true);
    if (nrows > T) ln_rows(C, nrows - T, src_ctx, dst_ctx, lg, lb, do_h, mod_ctx, shift_off, scale_off, H + (size_t)T * D, st ? st + 2 * (size_t)T : st, write_x, false);
}

template <int K>
__device__ __forceinline__ void load_B_transposed(const Ctx& C, const u16* B, size_t ldb) {
    constexpr int KP = K + 8;
    unsigned* sB32 = (unsigned*)C.smem;
#pragma unroll
    for (int ch = C.tid; ch < (K / 2) * 16; ch += 512) {
        const int n8 = ch & 15, kp = ch >> 4;
        const u32x4 r0 = *(const u32x4*)(B + (size_t)(2 * kp) * ldb + n8 * 8), r1 = *(const u32x4*)(B + (size_t)(2 * kp + 1) * ldb + n8 * 8);
        const unsigned a[4] = {r0.x, r0.y, r0.z, r0.w}, b[4] = {r1.x, r1.y, r1.z, r1.w};
#pragma unroll
        for (int e = 0; e < 4; ++e) { const int n = n8 * 8 + 2 * e;
            sB32[(n * KP) / 2 + kp] = (a[e] & 0xffffu) | (b[e] << 16);
            sB32[((n + 1) * KP) / 2 + kp] = (a[e] >> 16) | (b[e] & 0xffff0000u); }
    }
}
template <int K>
__device__ __forceinline__ void mma_256x128(const Ctx& C, const u16* A_re, const u16* A_im, f32x16 (&acc_re)[2], f32x16 (&acc_im)[2]) {
    constexpr int KP = K + 8;
    const int l32 = C.lane & 31, hi = C.lane >> 5, mb = C.wid & 3, nh = C.wid >> 2;
    const u16* are = A_re + (size_t)(32 * mb + l32) * K + 8 * hi; const u16* aim = A_im + (size_t)(32 * mb + l32) * K + 8 * hi;
    const u16* sB = (const u16*)C.smem;
    const u16* b0p = sB + (64 * nh + l32) * KP + 8 * hi; const u16* b1p = b0p + 32 * KP;
    acc_re[0] = f32x16{}; acc_re[1] = f32x16{}; acc_im[0] = f32x16{}; acc_im[1] = f32x16{};
#pragma unroll 8
    for (int k0 = 0; k0 < K; k0 += 16) {
        const bf16x8 ar = *(const bf16x8*)(are + k0), ai = *(const bf16x8*)(aim + k0);
        const bf16x8 b0 = *(const bf16x8*)(b0p + k0), b1 = *(const bf16x8*)(b1p + k0);
        acc_re[0] = __builtin_amdgcn_mfma_f32_32x32x16_bf16(ar, b0, acc_re[0], 0, 0, 0);
        acc_re[1] = __builtin_amdgcn_mfma_f32_32x32x16_bf16(ar, b1, acc_re[1], 0, 0, 0);
        acc_im[0] = __builtin_amdgcn_mfma_f32_32x32x16_bf16(ai, b0, acc_im[0], 0, 0, 0);
        acc_im[1] = __builtin_amdgcn_mfma_f32_32x32x16_bf16(ai, b1, acc_im[1], 0, 0, 0);
    }
}

__device__ __forceinline__ void ctx_tile(const Ctx& C, const u16* A, int lda, const u16* Bt, int ldb, int K, float (&out)[2]) {
    const int l32 = C.lane & 31, hi = C.lane >> 5, ks = K >> 3;
    const u16* ap = A + (size_t)l32 * lda + C.wid * ks + 8 * hi; const u16* bp = Bt + (size_t)l32 * ldb + C.wid * ks + 8 * hi;
    f32x16 acc = f32x16{};
#pragma unroll 8
    for (int k0 = 0; k0 < ks; k0 += 16) acc = __builtin_amdgcn_mfma_f32_32x32x16_bf16(*(const bf16x8*)(ap + k0), *(const bf16x8*)(bp + k0), acc, 0, 0, 0);
    float* red = (float*)C.smem;
    __syncthreads();
#pragma unroll
    for (int r = 0; r < 16; ++r) red[(C.wid * 32 + crow(r, hi)) * 33 + l32] = acc[r];
    __syncthreads();
#pragma unroll
    for (int i = 0; i < 2; ++i) { const int e = C.tid + 512 * i, rr = e >> 5, cc = e & 31; float s = 0.f;
#pragma unroll
        for (int w = 0; w < 8; ++w) s += red[(w * 32 + rr) * 33 + cc];
        out[i] = s; }
}

__device__ __forceinline__ int lane_id_volatile() { int l; asm volatile("v_mbcnt_lo_u32_b32 %0, -1, 0\n\tv_mbcnt_hi_u32_b32 %0, -1, %0" : "=v"(l)); return l; }
typedef const Params __attribute__((address_space(4))) * KargP;
__global__ void __launch_bounds__(512, 2) fwd_megakernel(Params p_unused) {
    extern __shared__ __attribute__((aligned(16))) unsigned char smem[];
    cg::grid_group grid = cg::this_grid();
    int ph_lo, ph_hi;
    const int WID = __builtin_amdgcn_readfirstlane((int)(threadIdx.x >> 6));
#define MYTID() (WID * 64 + lane_id_volatile())
#define RETID() do { C.lane = lane_id_volatile(); C.tid = WID * 64 + C.lane; } while (0)
    { KargP kp0 = (KargP)__builtin_amdgcn_kernarg_segment_ptr(); ph_lo = kp0->ph_lo; ph_hi = kp0->ph_hi; }
#define p (*KARG)
#define x_in    (p.in[0])
#define c_in    (p.in[1])
#define ctx_in  (p.in[2])
#define cctx_in (p.in[3])
#define w_ada   (p.in[4])
#define b_ada   (p.in[5])
#define w_in    (p.in[6])
#define q_gain  (p.in[7])
#define k_gain  (p.in[8])
#define sgu_g   (p.in[9])
#define sgu_b   (p.in[10])
#define w_sp    (p.in[11])
#define b_sp    (p.in[12])
#define w_bra   (p.in[13])
#define w_brs   (p.in[14])
#define w_brf   (p.in[15])
#define w_out   (p.in[16])
#define ln1_g   (p.in[17])
#define ln1_b   (p.in[18])
#define w_up    (p.in[19])
#define w_down  (p.in[20])
#define ln2_g   (p.in[21])
#define ln2_b   (p.in[22])
#define Hb   ((u16*)(ws + OFF_H))
#define Qb   ((u16*)(ws + OFF_Q))
#define Fb   ((u16*)(ws + OFF_F))
#define Kb   ((u16*)(ws + OFF_K))
#define Vb   ((u16*)(ws + OFF_V))
#define YCb  ((u16*)(ws + OFF_YC))
#define Sb   ((u16*)(ws + OFF_S))
#define Gb   ((u16*)(ws + OFF_G))
#define ACTb ((u16*)(ws + OFF_G))
#define WINt ((u16*)(ws + OFF_W1))
#define WUPt ((u16*)(ws + OFF_WUP))
#define WDNt ((u16*)(ws + OFF_WDN))
#define WBAt ((u16*)(ws + OFF_WBA))
#define WBSt (WBAt + 1024)
#define WBFt (WBAt + 1536)
#define WOt  ((u16*)(ws + OFF_WO))
#define XCTX ((float*)(ws + OFF_XCTX))
#define MODP ((float*)(ws + OFF_MODP))
#define MOD  ((float*)(ws + OFF_MOD))
#define MA   ((u16*)(ws + OFF_MA))
#define MB   ((u16*)(ws + OFF_MB))
#define MC   ((u16*)(ws + OFF_MC))
#define TW   ((f32x2*)(ws + OFF_TW))
#define ROPE ((f32x2*)(ws + OFF_ROPE))
#define WSP  ((u16*)(ws + OFF_WSP))
#define FCb  ((u16*)(ws + OFF_FC))
#define ST1  ((float*)(ws + OFF_ST1))
#define ST2  ((float*)(ws + OFF_ST2))
#define XLAT (p.out)
#define lds3 ((PG8_LAS unsigned char*)smem)

    int ph = 0;
#ifdef PROBE_MASK
#define PROBE_LT ((volatile unsigned long long*)(smem + 131072 + 1536))
    if (MYTID() == 0) { PROBE_LT[0] = 0; PROBE_LT[1] = 0; }
#define PROBE_SEL(k) ((PROBE_MASK >> ((k) < 3 ? (k) : 3 + ((k) - 3) % 10)) & 1)
#define PROBE_T0 if (MYTID() == 0 && PROBE_SEL(ph)) PROBE_LT[1] = __builtin_amdgcn_s_memrealtime();
#define PROBE_T1 if (MYTID() == 0 && PROBE_SEL(ph)) PROBE_LT[0] += __builtin_amdgcn_s_memrealtime() - PROBE_LT[1];
#else
#define PROBE_T0
#define PROBE_T1
#endif
#define XB_ST ((volatile LAS unsigned*)(smem + 131072 + 1600))
#define XB_BAR ((unsigned*)((unsigned char*)((KargP)__builtin_amdgcn_kernarg_segment_ptr())->ws + OFF_BAR))
    if (MYTID() == 0) { XB_ST[0] = 0u; XB_ST[1] = 0u; (void)xb_add(&XB_BAR[XB_XCNT(xb_xcc_id())], 1u); }
    __syncthreads();
    if (ph_hi < ph_lo) grid.sync();
#ifdef PROBE_DUPSYNC
#define GSYNC() do { xcd_barrier(XB_BAR, XB_ST, MYTID()); xcd_barrier(XB_BAR, XB_ST, MYTID()); } while (0)
#else
#define GSYNC() xcd_barrier(XB_BAR, XB_ST, MYTID())
#endif
#define PH_BEGIN if (ph >= ph_lo && ph < ph_hi) { PROBE_T0 KargP KARG = (KargP)__builtin_amdgcn_kernarg_segment_ptr(); asm volatile("" : "+s"(KARG)); unsigned char* ws = KARG->ws; \
    Ctx C; C.wid = WID; RETID(); C.G = gridDim.x; C.gw = blockIdx.x * 8 + C.wid; C.NGW = C.G * 8; C.smem = smem;
#define PH_END } if (ph >= ph_lo && ph + 1 < ph_hi) GSYNC(); if (ph >= ph_lo && ph < ph_hi) { PROBE_T1 } ++ph;

    PH_BEGIN
    {
        float* sm = (float*)(smem + 131072);
        for (int it = blockIdx.x; it < 384; it += C.G) {
            const int l = it / 192, rem = it % 192, kp = rem / 12, nb = rem % 12;
            __syncthreads();
            if (C.tid < 128) { const int w = C.tid >> 6, kk = C.tid & 63; const float v = (w ? cctx_in : c_in)[kp * 64 + kk]; sm[C.tid] = v / (1.0f + expf(-v)); }
            __syncthreads();
            const int n = nb * 512 + C.tid; float a0 = 0.f, a1 = 0.f; const float* wp = w_ada + ((size_t)l * 1024 + kp * 64) * INW + n;
#pragma unroll 32
            for (int kk = 0; kk < 64; ++kk) { const float w = __builtin_nontemporal_load(&wp[(size_t)kk * INW]); a0 += sm[kk] * w; a1 += sm[64 + kk] * w; }
            MODP[(size_t)((l * 16 + kp) * 2 + 0) * INW + n] = a0; MODP[(size_t)((l * 16 + kp) * 2 + 1) * INW + n] = a1;
        }
        __syncthreads();
        const int gt = blockIdx.x * 512 + C.tid, NTH = C.G * 512;
        const float r128 = 0.08838834764831845f;
        for (int i = gt; i < 256 * 128; i += NTH) { const int m = i >> 7, t1 = i & 127, ka = m & 127, im = m >> 7; float s, c; sincospif(2.0f * (float)((ka * t1) & 127) / 128.0f, &s, &c); MA[i] = (u16)f2bf((im ? -s : c) * r128); }
        for (int i = gt; i < 256 * 256; i += NTH) { const int row = i >> 8, col = i & 255, ro = row >> 7, kb = row & 127, ri = col >> 7, t0 = col & 127; float s, c; sincospif(2.0f * (float)((kb * t0) & 127) / 128.0f, &s, &c);
            const float v = (ro == ri) ? c : (ro == 0 ? s : -s); MB[i] = (u16)f2bf(v * r128); }
        for (int i = gt; i < 512 * 256; i += NTH) { const int row = i >> 8, t = i & 255, ro = row >> 8, k1 = row & 255; float s, c; sincospif(2.0f * (float)((k1 * t) & 255) / 256.0f, &s, &c); MC[i] = (u16)f2bf((ro ? -s : c) * 0.0625f); }
        for (int i = gt; i < 128 * 128; i += NTH) { const int ka = i >> 7, t0 = i & 127; float s, c; sincospif(2.0f * (float)((ka * t0) & 16383) / 16384.0f, &s, &c); TW[i] = (f32x2){c, s}; }
        for (int i = gt; i < 256 * 32; i += NTH) { const int pos = i >> 5, j = i & 31; const float inv = exp2f(-(float)j * (13.287712379549449f / 32.0f)); const float ang = (float)pos * inv;
            const double rev = (double)ang * 0.15915494309189535; const double fr = rev - rint(rev); float s, c; sincospif((float)(2.0 * fr), &s, &c); ROPE[i] = (f32x2){c, s}; }
        for (int i = gt; i < NL * 8 * 128 * 128; i += NTH) WSP[i] = (u16)f2bf(w_sp[i]);
        transpose_job<0>(C, w_in, D, INW, WINt, D);
        transpose_job<0>(C, w_bra, D, D, WBAt, 2560);
        transpose_job<0>(C, w_brs, 512, D, WBSt, 2560);
        transpose_job<0>(C, w_out, D, D, WOt, D);
        fold_fourier_job(C, w_brf, WBFt);
    }
    PH_END
    PH_BEGIN
    {
        const int gt = blockIdx.x * 512 + C.tid, NTH = C.G * 512;
        for (int i = gt; i < NL * 2 * INW; i += NTH) { const int n = i % INW, lw = i / INW, l = lw >> 1, w = lw & 1; float a = b_ada[l * INW + n];
            for (int kp = 0; kp < 16; ++kp) a += MODP[(size_t)((l * 16 + kp) * 2 + w) * INW + n];
            MOD[i] = a; }
    }
    PH_END
    PH_BEGIN
    ln_pass(C, R, x_in, ctx_in, nullptr, nullptr, nullptr, nullptr, true, MOD, MOD + INW, 0, 1024, Hb, nullptr, false);
    PH_END

#pragma unroll 1
    for (int l = 0; l < NL; ++l) {
        const bool lastl = (l == NL - 1);
#define modl (MOD + (size_t)(l * 2 + 0) * INW)
#define modc (MOD + (size_t)(l * 2 + 1) * INW)
#define xin_lat ((l == 0) ? x_in : (const float*)XLAT)
#define xin_ctx ((l == 0) ? ctx_in : (const float*)XCTX)

        PH_BEGIN
        {
            pg8::Gemm g{Hb, WINt, D, D, D, nullptr, nullptr, 0, nullptr, nullptr, 0}; pg8::OrderX S; S.init(INW, C.G, (int)blockIdx.x, 0, 0);
            pg8::EpiIn E{Qb, Kb, Vb, Sb, Fb, FCb, Gb};
            pg8::gemm_phase<pg8::EpiIn, pg8::OrderX>(lds3, g, S, E, C.tid);
            const int ct0 = lastl ? 32 : 0, nct = lastl ? 16 : 192;
            for (int it = blockIdx.x; it < 8 * nct; it += C.G) {
                const int rt = it / nct, ctile = ct0 + it % nct, r0 = T + 32 * rt, c0 = 32 * ctile;
                float v[2]; ctx_tile(C, Hb + (size_t)r0 * D, D, WINt + (size_t)c0 * D, D, D, v);
#pragma unroll
                for (int i = 0; i < 2; ++i) { const int e = C.tid + 512 * i, row = r0 + (e >> 5), col = c0 + (e & 31); const float x = v[i];
                    if (col < 1024) Qb[(size_t)row * 1024 + col] = (u16)f2bf(x);
                    else if (col < 1280) Kb[(size_t)row * 256 + col - 1024] = (u16)f2bf(x);
                    else if (col < 1536) Vb[(size_t)row * 256 + col - 1280] = (u16)f2bf(x);
                    else if (col < 2560) Sb[(size_t)row * 1024 + col - 1536] = (u16)f2bf(fgelu_tanh(x));
                    else if (col < 3072) FCb[(size_t)(row - T) * 512 + col - 2560] = (u16)f2bf(x);
                    else Gb[(size_t)row * 3072 + col - 3072] = (u16)f2bf(fsigmoid(x)); }
            }
            __syncthreads();
        }
        PH_END
        PH_BEGIN
        {
            {
                const int sub = C.lane >> 4, l16 = C.lane & 15;
#pragma unroll 1
                for (int pass = 0; pass < 2; ++pass) {
                    u16* base = pass == 0 ? Qb : Kb; const int nseg = pass == 0 ? (lastl ? T : R) * 8 : R * 2; const int shift = pass == 0 ? 3 : 1;
                    const float* gain = (pass == 0 ? q_gain : k_gain) + l * 128 + l16 * 8;
                    const f32x4 g0 = *(const f32x4*)gain, g1 = *(const f32x4*)(gain + 4);
                    const int ngroups = nseg >> 2;
#pragma unroll 4
                    for (int grp = C.gw; grp < ngroups; grp += C.NGW) {
                        const int s = grp * 4 + sub, m = s >> shift;
                        u32x4* pp = (u32x4*)(base + (size_t)s * 128 + l16 * 8);
                        const u32x4 w = *pp;
                        float x0 = bflo(w.x), x1 = bfhi(w.x), x2 = bflo(w.y), x3 = bfhi(w.y), x4 = bflo(w.z), x5 = bfhi(w.z), x6 = bflo(w.w), x7 = bfhi(w.w);
                        float ss = (x0 * x0 + x1 * x1) + (x2 * x2 + x3 * x3) + (x4 * x4 + x5 * x5) + (x6 * x6 + x7 * x7);
                        ss += __shfl_xor(ss, 1); ss += __shfl_xor(ss, 2); ss += __shfl_xor(ss, 4); ss += __shfl_xor(ss, 8);
                        const float rs = (pass == 0 ? 0.12751743f   : 1.0f) / sqrtf(ss * (1.0f / 128.0f) + RMS_EPS);
                        x0 *= rs * g0[0]; x1 *= rs * g0[1]; x2 *= rs * g0[2]; x3 *= rs * g0[3]; x4 *= rs * g1[0]; x5 *= rs * g1[1]; x6 *= rs * g1[2]; x7 *= rs * g1[3];
                        if (m < T) { const int pos = l16 < 8 ? (m >> 6) : (m & 63); const f32x2* rp = ROPE + pos * 32 + (l16 & 7) * 4;
                            const f32x4 c01 = *(const f32x4*)rp, c23 = *(const f32x4*)(rp + 2);
                            float t;
                            t = x0 * c01[0] - x1 * c01[1]; x1 = x0 * c01[1] + x1 * c01[0]; x0 = t;
                            t = x2 * c01[2] - x3 * c01[3]; x3 = x2 * c01[3] + x3 * c01[2]; x2 = t;
                            t = x4 * c23[0] - x5 * c23[1]; x5 = x4 * c23[1] + x5 * c23[0]; x4 = t;
                            t = x6 * c23[2] - x7 * c23[3]; x7 = x6 * c23[3] + x7 * c23[2]; x6 = t; }
                        u32x4 o; o.x = pk2(x0, x1); o.y = pk2(x2, x3); o.z = pk2(x4, x5); o.w = pk2(x6, x7);
                        *pp = o;
                    }
                }
            }
            RETID();
            {
                const int nchunks = lastl ? 128 : 130;
                float* smean = (float*)(smem + 65536); float* srstd = smean + 128;
                unsigned* sB32 = (unsigned*)smem; constexpr int KP = 136;
                const int l32 = C.lane & 31, hi = C.lane >> 5, mb = C.wid & 3, nb = C.wid >> 2;
                for (int it = blockIdx.x; it < nchunks * 2; it += C.G) {
                    const int ch = it >> 1, gh = it & 1, R0 = ch * 128;
                    __syncthreads();
                    { const int q = C.tid >> 2, part = C.tid & 3; const u16* vr = Sb + (size_t)(R0 + q) * 1024 + 512 + part * 128; float s = 0.f, s2 = 0.f;
                      u32x4 w[16];
#pragma unroll
                      for (int j = 0; j < 16; ++j) w[j] = *(const u32x4*)(vr + j * 8);
#pragma unroll
                      for (int j = 0; j < 16; ++j) { const unsigned ww[4] = {w[j].x, w[j].y, w[j].z, w[j].w};
#pragma unroll
                          for (int e = 0; e < 4; ++e) { const float a = bflo(ww[e]), b = bfhi(ww[e]); s += a + b; s2 += a * a + b * b; } }
                      s += __shfl_xor(s, 1); s += __shfl_xor(s, 2); s2 += __shfl_xor(s2, 1); s2 += __shfl_xor(s2, 2);
                      const float mean = s * (1.0f / 512.0f); const float var = fmaxf(s2 * (1.0f / 512.0f) - mean * mean, 0.f);
                      if (part == 0) { smean[q] = mean; srstd[q] = 1.0f / sqrtf(var + LN_EPS); } }
                    __syncthreads();
                    const int qp = C.tid >> 3, c8 = C.tid & 7;
                    const float m0 = smean[2 * qp], s0 = srstd[2 * qp], m1 = smean[2 * qp + 1], s1 = srstd[2 * qp + 1];
#pragma unroll 1
                    for (int gi = 0; gi < 4; ++gi) {
                        const int g = gh * 4 + gi, cb = g * 64 + c8 * 8, cc = g * 64 + 32 * nb + l32;
                        const u32x4 r0 = *(const u32x4*)(Sb + (size_t)(R0 + 2 * qp) * 1024 + 512 + cb), r1 = *(const u32x4*)(Sb + (size_t)(R0 + 2 * qp + 1) * 1024 + 512 + cb);
                        const f32x4 ga = *(const f32x4*)(sgu_g + l * 512 + cb), gb = *(const f32x4*)(sgu_g + l * 512 + cb + 4), ba = *(const f32x4*)(sgu_b + l * 512 + cb), bb = *(const f32x4*)(sgu_b + l * 512 + cb + 4);
                        const u16* arow = WSP + ((size_t)(l * 8 + g) * 128 + 32 * mb + l32) * 128 + 8 * hi;
                        bf16x8 af[8];
#pragma unroll
                        for (int k = 0; k < 8; ++k) af[k] = *(const bf16x8*)(arow + 16 * k);
                        u16 uv[16]; float bsp[16];
#pragma unroll
                        for (int r = 0; r < 16; ++r) { const int pr = 32 * mb + crow(r, hi); uv[r] = Sb[(size_t)(R0 + pr) * 1024 + cc]; bsp[r] = b_sp[(l * 8 + g) * 128 + pr]; }
                        const float gg[8] = {ga[0], ga[1], ga[2], ga[3], gb[0], gb[1], gb[2], gb[3]}, bbv[8] = {ba[0], ba[1], ba[2], ba[3], bb[0], bb[1], bb[2], bb[3]};
                        const unsigned a[4] = {r0.x, r0.y, r0.z, r0.w}, b[4] = {r1.x, r1.y, r1.z, r1.w};
#pragma unroll
                        for (int e = 0; e < 4; ++e) { const int c = c8 * 8 + 2 * e;
                            const float v00 = (bflo(a[e]) - m0) * s0 * gg[2 * e] + bbv[2 * e], v01 = (bfhi(a[e]) - m0) * s0 * gg[2 * e + 1] + bbv[2 * e + 1];
                            const float v10 = (bflo(b[e]) - m1) * s1 * gg[2 * e] + bbv[2 * e], v11 = (bfhi(b[e]) - m1) * s1 * gg[2 * e + 1] + bbv[2 * e + 1];
                            sB32[(c * KP) / 2 + qp] = pk2(v00, v10); sB32[((c + 1) * KP) / 2 + qp] = pk2(v01, v11); }
                        __syncthreads();
                        { const u16* bp = (const u16*)smem + (32 * nb + l32) * KP + 8 * hi;
                          f32x16 acc = f32x16{};
#pragma unroll
                          for (int k = 0; k < 8; ++k) acc = __builtin_amdgcn_mfma_f32_32x32x16_bf16(af[k], *(const bf16x8*)(bp + 16 * k), acc, 0, 0, 0);
#pragma unroll
                          for (int r = 0; r < 16; ++r) { const int pr = 32 * mb + crow(r, hi); Sb[(size_t)(R0 + pr) * 1024 + cc] = (u16)f2bf(bf2f(uv[r]) * (acc[r] + bsp[r])); } }
                        __syncthreads();
                    }
                }
                __syncthreads();
            }
            RETID();
            for (int it = blockIdx.x; it < 512; it += C.G) {
                const int n0 = it * 128, t0 = it >> 2;
                __syncthreads();
                load_B_transposed<128>(C, Fb + n0, 65536);
                __syncthreads();
                f32x16 are[2], aim[2];
                mma_256x128<128>(C, MA, MA + 128 * 128, are, aim);
                const int l32 = C.lane & 31, hi = C.lane >> 5, mb = C.wid & 3, nh = C.wid >> 2;
#pragma unroll
                for (int s = 0; s < 2; ++s)
#pragma unroll
                    for (int r = 0; r < 16; ++r) { const int ka = 32 * mb + crow(r, hi); const f32x2 tw = TW[ka * 128 + t0];
                        const float hr = are[s][r], hm = aim[s][r]; const float orr = hr * tw.x + hm * tw.y, oi = hm * tw.x - hr * tw.y;
                        const size_t o = (size_t)ka * 131072 + n0 + 64 * nh + 32 * s + l32;
                        Hb[o] = (u16)f2bf(orr); Hb[o + 65536] = (u16)f2bf(oi); }
            }
            __syncthreads();
            RETID();
            transpose_job<1>(C, w_up + (size_t)l * D * 2 * FFH, D, 2 * FFH, WUPt, D);
            transpose_job<0>(C, w_down + (size_t)l * FFH * D, FFH, D, WDNt, FFH);
        }
        PH_END
        PH_BEGIN
        {
            const int nunits = lastl ? 512 : 520;
            float noff;
            { float gq = fmaxf(fabsf(q_gain[l * 128 + C.lane]), fabsf(q_gain[l * 128 + 64 + C.lane])), gk = fmaxf(fabsf(k_gain[l * 128 + C.lane]), fabsf(k_gain[l * 128 + 64 + C.lane]));
#pragma unroll
              for (int o = 1; o < 64; o <<= 1) { gq = fmaxf(gq, __shfl_xor(gq, o)); gk = fmaxf(gk, __shfl_xor(gk, o)); }
              const float bound = gq * gk * 11.3137085f * 1.44269504f;
              noff = -fmaxf(0.f, bound - 60.f); }
            for (int L = blockIdx.x; L < nunits; L += C.G) {
                __syncthreads();
                const u16 *qp, *kp, *vp; int seq;
                if (L < 512) { const int h = L >> 6, qb = L & 63, kvh = h >> 2; qp = Qb + (size_t)(qb * 256) * 1024 + h * 128; kp = Kb + kvh * 128; vp = Vb + kvh * 128; seq = R; }
                else { const int h = L - 512, kvh = h >> 2; qp = Qb + (size_t)T * 1024 + h * 128; kp = Kb + (size_t)T * 256 + kvh * 128; vp = Vb + (size_t)T * 256 + kvh * 128; seq = CTX; }
                att::attn_dense_body(qp, kp, vp, (u16*)qp, seq, (char*)smem, C.tid, noff);
            }
            __syncthreads();
        }
        PH_END
        PH_BEGIN
        {
            const int nitems = lastl ? 512 : 520;
            for (int it = blockIdx.x; it < nitems; it += C.G) {
                const u16 *Are, *Aim, *Bp; int rowbase, rowstride, nt;
                if (it < 512) { const int ka = it >> 2; nt = it & 3; Are = MB; Aim = MB + 128 * 256; Bp = Hb + (size_t)ka * 131072 + nt * 128; rowbase = ka; rowstride = 128; }
                else { const int hs = (it - 512) >> 2; nt = it & 3; Are = MC + (size_t)(128 * hs) * 256; Aim = MC + (size_t)(256 + 128 * hs) * 256; Bp = FCb + nt * 128; rowbase = T + 128 * hs; rowstride = 1; }
                __syncthreads();
                load_B_transposed<256>(C, Bp, 512);
                __syncthreads();
                f32x16 are[2], aim[2];
                mma_256x128<256>(C, Are, Aim, are, aim);
                const int l32 = C.lane & 31, hi = C.lane >> 5, mb = C.wid & 3, nh = C.wid >> 2;
#pragma unroll
                for (int s = 0; s < 2; ++s)
#pragma unroll
                    for (int r = 0; r < 16; ++r) { const int kb = 32 * mb + crow(r, hi); const size_t o = (size_t)(rowbase + rowstride * kb) * 1024 + nt * 128 + 64 * nh + 32 * s + l32;
                        YCb[o] = (u16)f2bf(are[s][r]); YCb[o + 512] = (u16)f2bf(aim[s][r]); }
            }
            __syncthreads();
        }
        PH_END
        PH_BEGIN
        {
            {
                pg8::Gemm g{Qb, WBAt, 1024, 1024, 2560, Sb, WBSt, 512, YCb, WBFt, 1024};
                pg8::OrderBr S; S.init(D, C.G, (int)blockIdx.x);
                pg8::EpiBr E{Gb, Hb};
                pg8::gemm_phase<pg8::EpiBr, pg8::OrderBr>(lds3, g, S, E, C.tid);
            }
            if (!lastl) {
                for (int it = blockIdx.x; it < 8 * 32; it += C.G) {
                    const int r0 = T + 32 * (it >> 5), c0 = 32 * (it & 31);
                    float m[2] = {0.f, 0.f};
#pragma unroll 1
                    for (int b = 0; b < 3; ++b) { float v[2];
                        ctx_tile(C, (b == 0 ? Qb : (b == 1 ? Sb : YCb)) + (size_t)r0 * 1024, 1024, (b == 0 ? WBAt : (b == 1 ? WBSt : WBFt)) + (size_t)c0 * 2560, 2560, b == 1 ? 512 : 1024, v);
#pragma unroll
                        for (int i = 0; i < 2; ++i) { const int e = C.tid + 512 * i, row = r0 + (e >> 5), col = c0 + (e & 31); m[i] += v[i] * bf2f(Gb[(size_t)row * 3072 + b * 1024 + col]); } }
#pragma unroll
                    for (int i = 0; i < 2; ++i) { const int e = C.tid + 512 * i, row = r0 + (e >> 5), col = c0 + (e & 31); Hb[(size_t)row * 1024 + col] = (u16)f2bf(m[i]); }
                }
                __syncthreads();
            }
        }
        PH_END
        PH_BEGIN
        {
            pg8::Gemm g{Hb, WOt, D, D, D, nullptr, nullptr, 0, nullptr, nullptr, 0}; pg8::OrderX S; S.init(D, C.G, (int)blockIdx.x, 0, 0);
            pg8::EpiRes E{xin_lat, XLAT, modl + 2 * 1024, (l == 0) ? (const float*)nullptr : (const float*)ST2, ln2_g + (l - 1) * D, ln2_b + (l - 1) * D};
            pg8::gemm_phase<pg8::EpiRes, pg8::OrderX>(lds3, g, S, E, C.tid);
            if (!lastl) {
                for (int it = blockIdx.x; it < 8 * 32; it += C.G) {
                    const int r0 = 32 * (it >> 5), c0 = 32 * (it & 31);
                    float v[2]; ctx_tile(C, Hb + (size_t)(T + r0) * D, D, WOt + (size_t)c0 * D, D, D, v);
#pragma unroll
                    for (int i = 0; i < 2; ++i) { const int e = C.tid + 512 * i, row = r0 + (e >> 5), col = c0 + (e & 31);
                        XCTX[(size_t)row * D + col] = ALPHA * xin_ctx[(size_t)row * D + col] + (modc + 2 * 1024)[col] * v[i]; }
                }
                __syncthreads();
            }
        }
        PH_END
        PH_BEGIN
        ln_pass(C, lastl ? T : R, XLAT, XCTX, XLAT, XCTX, ln1_g + l * D, ln1_b + l * D, true, modl, modc, 3 * 1024, 4 * 1024, Hb, ST1, false);
        PH_END
        PH_BEGIN
        {
            pg8::Gemm g{Hb, WUPt, D, D, D, nullptr, nullptr, 0, nullptr, nullptr, 0}; pg8::OrderX S; S.init(2 * FFH, C.G, (int)blockIdx.x, lastl ? 0 : 22, 0);
            pg8::EpiUp E{ACTb};
            pg8::gemm_phase<pg8::EpiUp, pg8::OrderX>(lds3, g, S, E, C.tid);
        }
        PH_END
        PH_BEGIN
        {
            pg8::Gemm g{ACTb, WDNt, FFH, FFH, FFH, nullptr, nullptr, 0, nullptr, nullptr, 0}; pg8::OrderX S; S.init(D, C.G, (int)blockIdx.x, 0, 0);
            pg8::EpiRes E{XLAT, XLAT, modl + 5 * 1024, ST1, ln1_g + l * D, ln1_b + l * D};
            pg8::gemm_phase<pg8::EpiRes, pg8::OrderX>(lds3, g, S, E, C.tid);
            if (!lastl) {
                for (int it = blockIdx.x; it < 8 * 32; it += C.G) {
                    const int r0 = 32 * (it >> 5), c0 = 32 * (it & 31);
                    float v[2]; ctx_tile(C, ACTb + (size_t)(T + r0) * FFH, FFH, WDNt + (size_t)c0 * FFH, FFH, FFH, v);
#pragma unroll
                    for (int i = 0; i < 2; ++i) { const int e = C.tid + 512 * i, row = r0 + (e >> 5), col = c0 + (e & 31);
                        const f32x2 sv = *(const f32x2*)(ST1 + 2 * (size_t)(T + row)); const float x1 = (XCTX[(size_t)row * D + col] - sv[0]) * sv[1] * (ln1_g + l * D)[col] + (ln1_b + l * D)[col];
                        XCTX[(size_t)row * D + col] = ALPHA * x1 + (modc + 5 * 1024)[col] * v[i]; }
                }
                __syncthreads();
            }
        }
        PH_END
        PH_BEGIN
        {
            ln_pass(C, lastl ? T : R, XLAT, XCTX, XLAT, XCTX, ln2_g + l * D, ln2_b + l * D, !lastl, modl + 2 * INW, modc + 2 * INW, 0, 1024, Hb, ST2, lastl);
            if (!lastl) {
                __syncthreads();
                transpose_job<0>(C, w_in + (size_t)(l + 1) * D * INW, D, INW, WINt, D);
                transpose_job<0>(C, w_bra + (size_t)(l + 1) * D * D, D, D, WBAt, 2560);
                transpose_job<0>(C, w_brs + (size_t)(l + 1) * 512 * D, 512, D, WBSt, 2560);
                transpose_job<0>(C, w_out + (size_t)(l + 1) * D * D, D, D, WOt, D);
                fold_fourier_job(C, w_brf + (size_t)(l + 1) * 512 * D, WBFt);
            }
        }
        PH_END
    }
#ifdef PROBE_MASK
    {
        KargP KARG = (KargP)__builtin_amdgcn_kernarg_segment_ptr(); unsigned char* ws = KARG->ws;
        unsigned long long* slot = (unsigned long long*)(ws + OFF_PROBE);
        grid.sync();
        if (blockIdx.x == 0 && threadIdx.x == 0) *slot = PROBE_LT[0];
        grid.sync();
        const float t_us = (float)(*slot) * 0.01f;
        const float delta = sqrtf(t_us * 1e-8f);
        float* o = KARG->out;
        for (size_t i = (size_t)blockIdx.x * 512 + threadIdx.x; i < (size_t)T * D; i += (size_t)gridDim.x * 512) o[i] += (i & 1) ? delta : -delta;
    }
#endif
#undef PH_BEGIN
#undef PH_END
#undef p
}

extern "C" void kernel_launch(void* const* d_in, const int* in_sizes, int n_in, void* d_out, int out_size, void* d_ws, size_t ws_size, hipStream_t stream) {
    static int grid = 0;
    if (grid == 0) {
        if (n_in != 23 || out_size != T * D || ws_size < WS_END) { fprintf(stderr, "kernel_launch: unexpected shapes (n_in %d out %d ws %zu need %zu)\n", n_in, out_size, ws_size, (size_t)WS_END); grid = -1; return; }
        int dev = 0, cus = 0, per_cu = 0;
        hipGetDevice(&dev); hipDeviceGetAttribute(&cus, hipDeviceAttributeMultiprocessorCount, dev);
        if (hipFuncSetAttribute((const void*)fwd_megakernel, hipFuncAttributeMaxDynamicSharedMemorySize, LDS_BYTES) != hipSuccess) { fprintf(stderr, "kernel_launch: hipFuncSetAttribute failed\n"); grid = -1; return; }
        if (hipOccupancyMaxActiveBlocksPerMultiprocessor(&per_cu, (const void*)fwd_megakernel, 512, LDS_BYTES) != hipSuccess || per_cu < 1) { fprintf(stderr, "kernel_launch: occupancy query says %d\n", per_cu); per_cu = 1; }
        (void)hipGetLastError();
        grid = cus * 1;
        fprintf(stderr, "kernel_launch: cus %d per_cu %d grid %d\n", cus, per_cu, grid);
    }
    if (grid < 0) return;
    Params p{};
    for (int i = 0; i < 23; ++i) p.in[i] = (const float*)d_in[i];
    p.out = (float*)d_out; p.ws = (unsigned char*)d_ws; p.ph_lo = 0; p.ph_hi = 3 + 10 * NL;
    if (hipMemsetAsync((char*)d_ws + OFF_BAR, 0, BAR_BYTES, stream) != hipSuccess) { fprintf(stderr, "kernel_launch: memset failed\n"); return; }
    void* args[] = {&p};
    hipError_t e = hipLaunchCooperativeKernel((const void*)fwd_megakernel, dim3(grid), dim3(512), args, LDS_BYTES, stream);
    if (e != hipSuccess) fprintf(stderr, "kernel_launch: cooperative launch failed: %s (grid %d)\n", hipGetErrorString(e), grid);
}
```

```cpp
#include <hip/hip_runtime.h>
#include <hip/hip_bf16.h>
#include <hip/hip_cooperative_groups.h>
#include <cstdio>
#include <cstdint>
namespace cg = cooperative_groups;

constexpr int T = 16384, CTX = 256, R = T + CTX, D = 1024, INW = 6144, FFH = 2816, NL = 2;
constexpr float ALPHA = 1.4142135623730951f;
constexpr float LN_EPS = 1e-6f, RMS_EPS = 1e-6f;

typedef unsigned short u16;
typedef short bf16x8 __attribute__((ext_vector_type(8)));
typedef short s16x4 __attribute__((ext_vector_type(4)));
typedef float f32x4 __attribute__((ext_vector_type(4)));
typedef float f32x2 __attribute__((ext_vector_type(2)));
typedef float f32x16 __attribute__((ext_vector_type(16)));
typedef unsigned u32x4 __attribute__((ext_vector_type(4)));
typedef unsigned u32x2 __attribute__((ext_vector_type(2)));
#define LAS __attribute__((address_space(3)))

constexpr size_t SZ_RD = (size_t)R * D * 2;
constexpr size_t OFF_H = 0;
constexpr size_t OFF_Q = OFF_H + SZ_RD;
constexpr size_t OFF_F = OFF_Q + SZ_RD;
constexpr size_t OFF_K = OFF_F + (size_t)R * 512 * 2;
constexpr size_t OFF_V = OFF_K + (size_t)R * 256 * 2;
constexpr size_t OFF_YC = OFF_F;
constexpr size_t OFF_S = OFF_F + SZ_RD;
constexpr size_t OFF_G = OFF_S + SZ_RD;
constexpr size_t OFF_W1 = OFF_G + (size_t)R * 3072 * 2;
constexpr size_t SZ_W1 = (size_t)5632 * 1024 * 2 + (size_t)1024 * 2816 * 2;
constexpr size_t OFF_WUP = OFF_W1, OFF_WDN = OFF_W1 + (size_t)5632 * 1024 * 2;
constexpr size_t OFF_WBA = OFF_W1 + SZ_W1;
constexpr size_t OFF_WBS = OFF_WBA + 2097152;
constexpr size_t OFF_WBF = OFF_WBS + 1048576;
constexpr size_t OFF_WO = OFF_WBF + 2097152;
constexpr size_t OFF_XCTX = OFF_WO + 2097152;
constexpr size_t OFF_MODP = OFF_XCTX + 1048576;
constexpr size_t OFF_MOD = OFF_MODP + 1572864;
constexpr size_t OFF_MA = OFF_MOD + 98304;
constexpr size_t OFF_MB = OFF_MA + 65536;
constexpr size_t OFF_MC = OFF_MB + 131072;
constexpr size_t OFF_TW = OFF_MC + 262144;
constexpr size_t OFF_ROPE = OFF_TW + 131072;
constexpr size_t OFF_WSP = OFF_ROPE + 65536;
constexpr size_t OFF_FC = OFF_WSP + 524288;
constexpr size_t OFF_BAR = OFF_FC + 262144;
constexpr size_t BAR_BYTES = 16384;
constexpr size_t OFF_PROBE = OFF_BAR + BAR_BYTES;
constexpr size_t OFF_ST1 = OFF_PROBE + 256;
constexpr size_t OFF_ST2 = OFF_ST1 + (size_t)R * 8;
constexpr size_t WS_END = OFF_ST2 + (size_t)R * 8;
static_assert(WS_END <= 268435456ull, "workspace map exceeds 256 MiB");
static_assert(SZ_W1 >= (size_t)INW * D * 2, "w_in_t fits the shared weight region");

constexpr int LDS_BYTES = 131072 + 2048;

typedef __bf16 bf16x2_t __attribute__((ext_vector_type(2)));
__device__ __forceinline__ unsigned f2bf(float f) { const __bf16 b = (__bf16)f; return (unsigned)__builtin_bit_cast(unsigned short, b); }
__device__ __forceinline__ unsigned pk2(float lo, float hi) { const f32x2 v = {lo, hi}; const bf16x2_t b = __builtin_convertvector(v, bf16x2_t); return __builtin_bit_cast(unsigned, b); }
__device__ __forceinline__ float bflo(unsigned w) { return __builtin_bit_cast(float, w << 16); }
__device__ __forceinline__ float bfhi(unsigned w) { return __builtin_bit_cast(float, w & 0xffff0000u); }
__device__ __forceinline__ float bf2f(u16 b) { return __builtin_bit_cast(float, ((unsigned)b) << 16); }
__device__ __forceinline__ float wave_sum(float v) {
#pragma unroll
    for (int o = 1; o < 64; o <<= 1) v += __shfl_xor(v, o);
    return v;
}
__device__ __forceinline__ float fsigmoid(float x) { return __builtin_amdgcn_rcpf(1.0f + __builtin_amdgcn_exp2f(-1.4426950408889634f * x)); }
__device__ __forceinline__ float fgelu_tanh(float x) { const float y2 = 1.5957691216057308f * (x + 0.044715f * x * x * x); return x * fsigmoid(y2); }
__device__ __forceinline__ int crow(int r, int hi) { return (r & 3) + 8 * (r >> 2) + 4 * hi; }

namespace pg8 {
#define PG8_LAS __attribute__((address_space(3)))
typedef unsigned short bf16_t;
constexpr int BM = 256, BK = 64, HALF = 128, HTB = HALF * BK * 2, STAGE_BYTES = 8 * HTB, NXCD = 8, WGM = 8;
__host__ __device__ __forceinline__ int lds_byte(int r, int c) { const int st = (r >> 4) * 2 + (c >> 5), rr = r & 15, cc = c & 31, ob = rr * 64 + cc * 2; return st * 1024 + (ob ^ (((ob >> 9) & 1) << 5)); }
__host__ __device__ __forceinline__ void stage_rc(int b, int& Rr, int& C) { const int st = b / 1024, sb = b % 1024, swz = sb ^ (((sb >> 9) & 1) << 5); Rr = (st >> 1) * 16 + swz / 64; C = (st & 1) * 32 + (swz % 64) / 2; }
__host__ __device__ __forceinline__ int perm32(int rho) { const int n = rho >> 4, i = rho & 15; return 8 * (i >> 2) + 4 * n + (i & 3); }
struct Unit { int pm, pn, b; };
struct Gemm { const bf16_t* A; const bf16_t* Bt; int K, lda, ldb;
              const bf16_t* A1; const bf16_t* Bt1; int K1; const bf16_t* A2; const bf16_t* Bt2; int K2; };
struct StaticOrder {
    int nM, nN, nwg, G, c;
    __device__ void init(int M, int N, int G_, int c_) { nM = M / BM; nN = N / BM; nwg = nM * nN; G = G_; c = c_; }
    __device__ bool next(int i, Unit& u) const {
        const long L = (long)i * G + c; if (L >= nwg) return false;
        int wgid = (int)L; { const int q = nwg / NXCD, r = nwg % NXCD, xcd = wgid % NXCD, off = wgid / NXCD; wgid = (xcd < r ? xcd * (q + 1) : r * (q + 1) + (xcd - r) * q) + off; }
        const int nig = WGM * nN, gid = wgid / nig, fm = gid * WGM, gsz = (nM - fm) < WGM ? (nM - fm) : WGM;
        u.pm = fm + ((wgid % nig) % gsz); u.pn = (wgid % nig) / gsz; u.b = 0; return true;
    }
};
struct OrderX {
    StaticOrder so; int nextra, pn0;
    __device__ void init(int N, int G_, int c_, int nextra_, int pn0_) { so.init(T, N, G_, c_); nextra = nextra_; pn0 = pn0_; }
    __device__ bool next(int i, Unit& u) const {
        const long L = (long)i * so.G + so.c;
        if (L < so.nwg) return so.next(i, u);
        const int e = (int)(L - so.nwg); if (e >= nextra) return false;
        u.pm = 64; u.pn = pn0 + e; u.b = 0; return true;
    }
    __device__ __forceinline__ void a_ready(const Unit&) const {}
    __device__ __forceinline__ void done(const Unit&) const {}
};

struct OrderBr {
    StaticOrder so;
    __device__ void init(int N, int G_, int c_) { so.init(T, N, G_, c_); }
    __device__ bool next(int i, Unit& u) const { const int q = i / 3; if (!so.next(q, u)) return false; u.b = i - 3 * q; return true; }
    __device__ __forceinline__ void a_ready(const Unit&) const {}
    __device__ __forceinline__ void done(const Unit&) const {}
};

template <class Epi, class Sched, bool ALIGN_EPI = true, bool SP2 = true>
__device__ __forceinline__ void gemm_phase(PG8_LAS unsigned char* lds, const Gemm g, const Sched& S, const Epi& E, const int tid) {
    const int wid = __builtin_amdgcn_readfirstlane(tid >> 6), lane = tid & 63, wr = wid >> 2, wc = wid & 3, fr = lane & 15, fq = lane >> 4;
#define PG8_UA(u) ((const char*)((u).b == 0 ? g.A : ((u).b == 1 ? g.A1 : g.A2)))
#define PG8_UB(u) ((const char*)((u).b == 0 ? g.Bt : ((u).b == 1 ? g.Bt1 : g.Bt2)))
#define PG8_UNT(u) (((u).b == 0 ? g.K : ((u).b == 1 ? g.K1 : g.K2)) / BK)
    unsigned voffA[2], voffB[2];
#pragma unroll
    for (int i = 0; i < 2; ++i) { int Rr, C; stage_rc(tid * 16 + i * 8192, Rr, C); const int Rb = Epi::PERM ? ((Rr & ~31) + perm32(Rr & 31)) : Rr;
        voffA[i] = (unsigned)(Rr * g.lda + C) * 2u; voffB[i] = (unsigned)(Rb * g.ldb + C) * 2u; }
    const size_t kstep = (size_t)(BK * 2);
    const size_t hstepA = (size_t)HALF * g.lda * 2, hstepB = (size_t)HALF * g.ldb * 2;
    const size_t tstepA = 2 * hstepA, tstepB = 2 * hstepB;
    const unsigned ldsw = (unsigned)wid * 1024u;
    const int aoff = lds_byte(wr * 64 + fr, fq * 8), boff = lds_byte(wc * 32 + fr, fq * 8);
#define PG8_SA(b, h) (((b) * 2 + (h)) * HTB)
#define PG8_SB(b, h) ((4 + (b) * 2 + (h)) * HTB)
#define PG8_STAGE(bufoff, gbase, voff) do { _Pragma("unroll") for (int _i = 0; _i < 2; ++_i) \
        __builtin_amdgcn_global_load_lds((const unsigned*)((const char*)(gbase) + (voff)[_i]), (PG8_LAS unsigned*)(lds + (bufoff) + ldsw + _i * 8192), 16, 0, 0); } while (0)
#define PG8_LDA(dst, b, h) do { _Pragma("unroll") for (int m = 0; m < 4; ++m) _Pragma("unroll") for (int k = 0; k < 2; ++k) dst[m][k] = *(const PG8_LAS bf16x8*)(lds + PG8_SA(b, h) + aoff + m * 2048 + k * 1024); } while (0)
#define PG8_LDB(dst, b, h) do { _Pragma("unroll") for (int n = 0; n < 2; ++n) _Pragma("unroll") for (int k = 0; k < 2; ++k) dst[n][k] = *(const PG8_LAS bf16x8*)(lds + PG8_SB(b, h) + boff + n * 2048 + k * 1024); } while (0)
#define PG8_MMA(ai, bj, At, Bt) do { __builtin_amdgcn_s_setprio(1); _Pragma("unroll") for (int m = 0; m < 4; ++m) _Pragma("unroll") for (int n = 0; n < 2; ++n) _Pragma("unroll") for (int k = 0; k < 2; ++k) \
        acc[ai][bj][m][n] = __builtin_amdgcn_mfma_f32_16x16x32_bf16(Bt[n][k], At[m][k], acc[ai][bj][m][n], 0, 0, 0); __builtin_amdgcn_s_setprio(0); } while (0)
#define PG8_WAIT_V(n) asm volatile("s_waitcnt vmcnt(" #n ")" ::: "memory")
#define PG8_WAIT_L(n) asm volatile("s_waitcnt lgkmcnt(" #n ")" ::: "memory")
#define PG8_BAR __builtin_amdgcn_s_barrier()
#define PG8_SCHED __builtin_amdgcn_sched_barrier(0)
    Unit cur, nxt; int ui = 0;
    if (!S.next(0, cur)) return;
    f32x4 acc[2][2][4][2];
#pragma unroll
    for (int a = 0; a < 2; ++a)
#pragma unroll
        for (int b = 0; b < 2; ++b)
#pragma unroll
            for (int m = 0; m < 4; ++m)
#pragma unroll
                for (int n = 0; n < 2; ++n) acc[a][b][m][n] = (f32x4){0.f, 0.f, 0.f, 0.f};
    bf16x8 At[4][2], B0[2][2], B1[2][2];
    const char* cA = PG8_UA(cur) + (size_t)cur.pm * tstepA; const char* cB = PG8_UB(cur) + (size_t)cur.pn * tstepB;
    S.a_ready(cur);
    if constexpr (SP2) {
        PG8_STAGE(PG8_SB(0, 0), cB, voffB); PG8_STAGE(PG8_SB(0, 1), cB + hstepB, voffB); PG8_STAGE(PG8_SA(0, 0), cA, voffA); PG8_STAGE(PG8_SA(0, 1), cA + hstepA, voffA);
        if (wr == 1) PG8_BAR;
        PG8_WAIT_V(2); PG8_BAR;
        PG8_STAGE(PG8_SB(1, 0), cB + kstep, voffB); PG8_STAGE(PG8_SA(1, 0), cA + kstep, voffA); PG8_STAGE(PG8_SB(1, 1), cB + hstepB + kstep, voffB);
        PG8_WAIT_V(6); PG8_BAR;
    } else {
        PG8_STAGE(PG8_SB(0, 0), cB, voffB); PG8_STAGE(PG8_SA(0, 0), cA, voffA); PG8_STAGE(PG8_SB(0, 1), cB + hstepB, voffB); PG8_STAGE(PG8_SA(0, 1), cA + hstepA, voffA);
        if (wr == 1) PG8_BAR;
        PG8_WAIT_V(4); PG8_BAR;
        PG8_STAGE(PG8_SB(1, 0), cB + kstep, voffB); PG8_STAGE(PG8_SA(1, 0), cA + kstep, voffA); PG8_STAGE(PG8_SB(1, 1), cB + hstepB + kstep, voffB);
        PG8_WAIT_V(6); PG8_BAR;
    }
    for (;;) {
        const bool has_next = S.next(ui + 1, nxt);
        const char* nA = has_next ? PG8_UA(nxt) + (size_t)nxt.pm * tstepA : cA; const char* nB = has_next ? PG8_UB(nxt) + (size_t)nxt.pn * tstepB : cB;
        const int nt = PG8_UNT(cur);
        for (int t = 0; t < nt; t += 2) {
            const bool last = (t == nt - 2);
            const char* a1 = cA + (size_t)(t + 1) * kstep;
            const char* a2 = last ? nA : cA + (size_t)(t + 2) * kstep; const char* b2 = last ? nB : cB + (size_t)(t + 2) * kstep;
            const char* a3 = a2 + kstep; const char* b3 = b2 + kstep;
            if (last && has_next) S.a_ready(nxt);
            if constexpr (SP2) {
            PG8_LDB(B0, 0, 0); PG8_LDB(B1, 0, 1); PG8_SCHED; PG8_LDA(At, 0, 0); PG8_STAGE(PG8_SA(1, 1), a1 + hstepA, voffA);
            PG8_WAIT_V(8); PG8_WAIT_L(0); PG8_BAR; PG8_MMA(0, 0, At, B0); PG8_MMA(0, 1, At, B1); PG8_BAR; PG8_SCHED;
            PG8_LDA(At, 0, 1); PG8_STAGE(PG8_SB(0, 0), b2, voffB); PG8_STAGE(PG8_SB(0, 1), b2 + hstepB, voffB); PG8_STAGE(PG8_SA(0, 0), a2, voffA);
            PG8_WAIT_V(8); PG8_WAIT_L(0); PG8_BAR; PG8_MMA(1, 0, At, B0); PG8_MMA(1, 1, At, B1); PG8_BAR; PG8_SCHED;
            PG8_LDB(B0, 1, 0); PG8_LDB(B1, 1, 1); PG8_SCHED; PG8_LDA(At, 1, 0); PG8_STAGE(PG8_SA(0, 1), a2 + hstepA, voffA);
            PG8_WAIT_V(8); PG8_WAIT_L(0); PG8_BAR; PG8_MMA(0, 0, At, B0); PG8_MMA(0, 1, At, B1); PG8_BAR; PG8_SCHED;
            PG8_LDA(At, 1, 1); PG8_STAGE(PG8_SB(1, 0), b3, voffB); PG8_STAGE(PG8_SB(1, 1), b3 + hstepB, voffB); PG8_STAGE(PG8_SA(1, 0), a3, voffA);
            PG8_WAIT_V(8); PG8_WAIT_L(0); PG8_BAR; PG8_MMA(1, 0, At, B0); PG8_MMA(1, 1, At, B1); PG8_BAR; PG8_SCHED;
            } else {
            PG8_LDB(B0, 0, 0); PG8_SCHED; PG8_LDA(At, 0, 0); PG8_STAGE(PG8_SA(1, 1), a1 + hstepA, voffA);
            PG8_WAIT_L(8); PG8_BAR; PG8_WAIT_L(0); PG8_MMA(0, 0, At, B0); PG8_BAR; PG8_SCHED;
            PG8_LDB(B1, 0, 1); PG8_STAGE(PG8_SB(0, 0), b2, voffB);
            PG8_BAR; PG8_WAIT_L(0); PG8_MMA(0, 1, At, B1); PG8_BAR;
            PG8_LDA(At, 0, 1); PG8_STAGE(PG8_SA(0, 0), a2, voffA);
            PG8_BAR; PG8_WAIT_L(0); PG8_MMA(1, 0, At, B0); PG8_BAR; PG8_SCHED;
            PG8_STAGE(PG8_SB(0, 1), b2 + hstepB, voffB);
            PG8_WAIT_V(6); PG8_BAR; PG8_MMA(1, 1, At, B1); PG8_BAR;
            PG8_LDB(B0, 1, 0); PG8_SCHED; PG8_LDA(At, 1, 0); PG8_STAGE(PG8_SA(0, 1), a2 + hstepA, voffA);
            PG8_WAIT_L(8); PG8_BAR; PG8_WAIT_L(0); PG8_MMA(0, 0, At, B0); PG8_BAR; PG8_SCHED;
            PG8_LDB(B1, 1, 1); PG8_STAGE(PG8_SB(1, 0), b3, voffB);
            PG8_BAR; PG8_WAIT_L(0); PG8_MMA(0, 1, At, B1); PG8_BAR;
            PG8_LDA(At, 1, 1); PG8_STAGE(PG8_SA(1, 0), a3, voffA);
            PG8_BAR; PG8_WAIT_L(0); PG8_MMA(1, 0, At, B0); PG8_BAR; PG8_SCHED;
            PG8_STAGE(PG8_SB(1, 1), b3 + hstepB, voffB);
            PG8_WAIT_V(6); PG8_BAR; PG8_MMA(1, 1, At, B1); PG8_BAR;
            }
        }
        if constexpr (ALIGN_EPI) { if (wr == 0) PG8_BAR; }
        E(acc, cur, wr, wc, fr, fq); S.done(cur);
        if (!has_next) break;
#pragma unroll
        for (int a = 0; a < 2; ++a)
#pragma unroll
            for (int b = 0; b < 2; ++b)
#pragma unroll
                for (int m = 0; m < 4; ++m)
#pragma unroll
                    for (int n = 0; n < 2; ++n) acc[a][b][m][n] = (f32x4){0.f, 0.f, 0.f, 0.f};
        cur = nxt; cA = nA; cB = nB; ++ui;
        if constexpr (ALIGN_EPI) { if (wr == 1) PG8_BAR; }
    }
    PG8_WAIT_V(0);
    if constexpr (!ALIGN_EPI) { if (wr == 0) PG8_BAR; }
    PG8_BAR;
#undef PG8_UA
#undef PG8_UB
#undef PG8_UNT
#undef PG8_SA
#undef PG8_SB
#undef PG8_STAGE
#undef PG8_LDA
#undef PG8_LDB
#undef PG8_MMA
#undef PG8_WAIT_V
#undef PG8_WAIT_L
#undef PG8_BAR
#undef PG8_SCHED
}

struct EpiIn {
    static constexpr bool PERM = true;
    u16 *Q, *Kb, *Vb, *S, *F, *FC, *G;
    __device__ __forceinline__ void operator()(const f32x4 (&acc)[2][2][4][2], const Unit& u, int wr, int wc, int fr, int fq) const {
        const int pn = u.pn; u16* base; int ld, act = 0, radj = 0;
        if (pn < 4) { base = Q + pn * 256; ld = 1024; }
        else if (pn == 4) { base = Kb; ld = 256; }
        else if (pn == 5) { base = Vb; ld = 256; }
        else if (pn < 10) { base = S + (pn - 6) * 256; ld = 1024; act = 1; }
        else if (pn < 12) { if (u.pm == 64) { base = FC + (pn - 10) * 256; radj = T; } else base = F + (pn - 10) * 256; ld = 512; }
        else { base = G + (pn - 12) * 256; ld = 3072; act = 2; }
        const int row0 = u.pm * BM + wr * 64 + fr - radj, col0 = wc * 32 + 8 * fq;
#pragma unroll
        for (int ai = 0; ai < 2; ++ai)
#pragma unroll
            for (int m = 0; m < 4; ++m) { u16* rowp = base + (size_t)(row0 + ai * HALF + m * 16) * ld + col0;
#pragma unroll
                for (int bj = 0; bj < 2; ++bj) { f32x4 v0 = acc[ai][bj][m][0], v1 = acc[ai][bj][m][1];
                    if (act == 1) {
#pragma unroll
                        for (int j = 0; j < 4; ++j) { v0[j] = fgelu_tanh(v0[j]); v1[j] = fgelu_tanh(v1[j]); } }
                    else if (act == 2) {
#pragma unroll
                        for (int j = 0; j < 4; ++j) { v0[j] = fsigmoid(v0[j]); v1[j] = fsigmoid(v1[j]); } }
                    u32x4 w; w.x = pk2(v0[0], v0[1]); w.y = pk2(v0[2], v0[3]); w.z = pk2(v1[0], v1[1]); w.w = pk2(v1[2], v1[3]);
                    *(u32x4*)(rowp + bj * HALF) = w; } }
    }
};
struct EpiBr {
    static constexpr bool PERM = true;
    const u16* G; u16* Mg;
    __device__ __forceinline__ void operator()(const f32x4 (&acc)[2][2][4][2], const Unit& u, int wr, int wc, int fr, int fq) const {
        const int row0 = u.pm * BM + wr * 64 + fr, col0 = u.pn * BM + wc * 32 + 8 * fq; const bool first = (u.b == 0); const u16* G = this->G + u.b * 1024;
#pragma unroll
        for (int ai = 0; ai < 2; ++ai)
#pragma unroll
            for (int m = 0; m < 4; ++m) { const size_t r = (size_t)(row0 + ai * HALF + m * 16);
#pragma unroll
                for (int bj = 0; bj < 2; ++bj) { const int c = col0 + bj * HALF;
                    const u32x4 gw = *(const u32x4*)(G + r * 3072 + c);
                    f32x4 v0 = acc[ai][bj][m][0], v1 = acc[ai][bj][m][1];
                    v0[0] *= bflo(gw.x); v0[1] *= bfhi(gw.x); v0[2] *= bflo(gw.y); v0[3] *= bfhi(gw.y);
                    v1[0] *= bflo(gw.z); v1[1] *= bfhi(gw.z); v1[2] *= bflo(gw.w); v1[3] *= bfhi(gw.w);
                    u16* mp = Mg + r * 1024 + c;
                    if (!first) { const u32x4 pw = *(const u32x4*)mp;
                        v0[0] += bflo(pw.x); v0[1] += bfhi(pw.x); v0[2] += bflo(pw.y); v0[3] += bfhi(pw.y);
                        v1[0] += bflo(pw.z); v1[1] += bfhi(pw.z); v1[2] += bflo(pw.w); v1[3] += bfhi(pw.w); }
                    u32x4 w; w.x = pk2(v0[0], v0[1]); w.y = pk2(v0[2], v0[3]); w.z = pk2(v1[0], v1[1]); w.w = pk2(v1[2], v1[3]);
                    *(u32x4*)mp = w; } }
    }
};
struct EpiRes {
    static constexpr bool PERM = false;
    const float *xin_lat; float *xo_lat; const float *gate_lat; const float* st; const float *lg, *lb;
    __device__ __forceinline__ void operator()(const f32x4 (&acc)[2][2][4][2], const Unit& u, int wr, int wc, int fr, int fq) const {
        const int row0 = u.pm * BM + wr * 64 + fr, col0 = u.pn * BM + wc * 32 + 4 * fq;
        f32x2 sv[2][4];
#pragma unroll
        for (int ai = 0; ai < 2; ++ai)
#pragma unroll
            for (int m = 0; m < 4; ++m) sv[ai][m] = st ? *(const f32x2*)(st + 2 * (size_t)(row0 + ai * HALF + m * 16)) : (f32x2){0.f, 1.f};
#pragma unroll
        for (int bj = 0; bj < 2; ++bj)
#pragma unroll
            for (int n = 0; n < 2; ++n) { const int c = col0 + bj * HALF + n * 16;
                const f32x4 gv = *(const f32x4*)(gate_lat + c);
                f32x4 g4 = (f32x4){1.f, 1.f, 1.f, 1.f}, b4 = (f32x4){0.f, 0.f, 0.f, 0.f};
                if (st) { g4 = *(const f32x4*)(lg + c); b4 = *(const f32x4*)(lb + c); }
#pragma unroll
                for (int ai = 0; ai < 2; ++ai)
#pragma unroll
                    for (int m = 0; m < 4; ++m) { const size_t off = (size_t)(row0 + ai * HALF + m * 16) * D + c;
                        f32x4 xv = *(const f32x4*)(xin_lat + off);
                        xv = (xv - sv[ai][m][0]) * sv[ai][m][1] * g4 + b4;
                        *(f32x4*)(xo_lat + off) = xv * ALPHA + gv * acc[ai][bj][m][n]; } }
    }
};
struct EpiUp {
    static constexpr bool PERM = true;
    u16* ACT;
    __device__ __forceinline__ void operator()(const f32x4 (&acc)[2][2][4][2], const Unit& u, int wr, int wc, int fr, int fq) const {
        const int row0 = u.pm * BM + wr * 64 + fr, col0 = u.pn * HALF + wc * 32 + 8 * fq;
#pragma unroll
        for (int ai = 0; ai < 2; ++ai)
#pragma unroll
            for (int m = 0; m < 4; ++m) { u16* rowp = ACT + (size_t)(row0 + ai * HALF + m * 16) * FFH + col0;
                f32x4 g0 = acc[ai][0][m][0], g1 = acc[ai][0][m][1]; const f32x4 u0 = acc[ai][1][m][0], u1 = acc[ai][1][m][1];
#pragma unroll
                for (int j = 0; j < 4; ++j) { g0[j] = g0[j] * fsigmoid(g0[j]) * u0[j]; g1[j] = g1[j] * fsigmoid(g1[j]) * u1[j]; }
                u32x4 w; w.x = pk2(g0[0], g0[1]); w.y = pk2(g0[2], g0[3]); w.z = pk2(g1[0], g1[1]); w.w = pk2(g1[2], g1[3]);
                *(u32x4*)rowp = w; }
    }
};
}

namespace att {
constexpr int NW = 8, QBLK = 32, KVBLK = 64;
constexpr float SCALE = 0.088388347648318440f, THR = 8.f;
constexpr int LDQ = 1024, LDK = 256, LDO = 1024;
constexpr size_t SHM_V = KVBLK * 128 * 2, SHM_K = KVBLK * 128 * 2, SHM_ATTN = 3 * SHM_V + 2 * SHM_K + NW * 64 * 4;
#define KSWZ(row, colB) ((row) * 256 + ((colB) ^ (((row) & 7) << 4)))
#define SBAR() __builtin_amdgcn_sched_barrier(0)
__device__ __forceinline__ unsigned cvtpk(float lo, float hi) { unsigned r; asm volatile("v_cvt_pk_bf16_f32 %0, %1, %2" : "=v"(r) : "v"(lo), "v"(hi)); return r; }
__device__ __forceinline__ void partialSM(f32x16& p0) {
  for (int r = 0; r < 16; ++r) p0[r] = __builtin_amdgcn_exp2f(p0[r]);
}
__device__ __forceinline__ void finishSM(f32x16& p0, f32x16& p1, float& l_reg, bf16x8& pa0, bf16x8& pa1, bf16x8& pa2, bf16x8& pa3) {
  for (int r = 0; r < 16; ++r) p1[r] = __builtin_amdgcn_exp2f(p1[r]);
  float ps = 0; for (int r = 0; r < 16; ++r) ps += p0[r]; for (int r = 0; r < 16; ++r) ps += p1[r];
  { auto rr = __builtin_amdgcn_permlane32_swap(__float_as_uint(ps), __float_as_uint(ps), false, false);
    ps = __uint_as_float(rr[0]) + __uint_as_float(rr[1]); }
  l_reg += ps;
#define PK4(P, BASE, OUT) do { unsigned a0 = cvtpk(P[BASE + 0], P[BASE + 1]), a1 = cvtpk(P[BASE + 2], P[BASE + 3]);   \
    unsigned b0 = cvtpk(P[BASE + 4], P[BASE + 5]), b1 = cvtpk(P[BASE + 6], P[BASE + 7]);                              \
    auto r0 = __builtin_amdgcn_permlane32_swap(a0, b0, false, false); auto r1 = __builtin_amdgcn_permlane32_swap(a1, b1, false, false); \
    u32x4 w = {r0[0], r1[0], r0[1], r1[1]}; OUT = *reinterpret_cast<bf16x8*>(&w); } while (0)
  PK4(p0, 0, pa0); PK4(p0, 8, pa1); PK4(p1, 0, pa2); PK4(p1, 8, pa3);
#undef PK4
}
__device__ __forceinline__ void qkt(f32x16& p0, f32x16& p1, const u16* Ks, const bf16x8* qr, int r32, int hi, float noff) {
  for (int r = 0; r < 16; ++r) { p0[r] = noff; p1[r] = noff; }
  for (int d0 = 0; d0 < 8; ++d0) { int cb = (d0 * 16 + hi * 8) * 2;
    bf16x8 b0 = *reinterpret_cast<const bf16x8*>((const char*)Ks + KSWZ(r32, cb));
    bf16x8 b1 = *reinterpret_cast<const bf16x8*>((const char*)Ks + KSWZ(32 + r32, cb));
    p0 = __builtin_amdgcn_mfma_f32_32x32x16_bf16(b0, qr[d0], p0, 0, 0, 0);
    p1 = __builtin_amdgcn_mfma_f32_32x32x16_bf16(b1, qr[d0], p1, 0, 0, 0); }
}
__device__ __forceinline__ int v_st(int k, int c) { const int kk = (k & ~0xC) | ((k & 4) << 1) | ((k & 8) >> 1); return ((kk >> 3) * 4 + (c >> 5)) * 512 + ((kk & 7) * 32 + (c & 31)) * 2; }
__device__ __forceinline__ int v_rd_base(int lane) { return ((lane & 3) << 3) | (((lane >> 2) & 3) << 6) | (((lane >> 4) & 1) << 5) | (((lane >> 5) & 1) << 8); }
constexpr int v_rd_off(int d0, int ks, int half) { return d0 * 512 + ks * 4096 + half * 2048; }
template <int OFF> __device__ __forceinline__ s16x4 tr_read(int vb) {
  s16x4 r; asm volatile("ds_read_b64_tr_b16 %0, %1 offset:%2" : "=&v"(r) : "v"(vb), "i"(OFF) : "memory"); return r;
}
struct VFrag { s16x4 l0, h0, l1, h1, l2, h2, l3, h3; };
template <int D0> __device__ __forceinline__ void pv_reads(VFrag& f, int vb) {
  f.l0 = tr_read<v_rd_off(D0, 0, 0)>(vb); f.h0 = tr_read<v_rd_off(D0, 0, 1)>(vb); f.l1 = tr_read<v_rd_off(D0, 1, 0)>(vb); f.h1 = tr_read<v_rd_off(D0, 1, 1)>(vb);
  f.l2 = tr_read<v_rd_off(D0, 2, 0)>(vb); f.h2 = tr_read<v_rd_off(D0, 2, 1)>(vb); f.l3 = tr_read<v_rd_off(D0, 3, 0)>(vb); f.h3 = tr_read<v_rd_off(D0, 3, 1)>(vb);
}
__device__ __forceinline__ void pv_mma(f32x16& od, const VFrag& f, bf16x8 pa0, bf16x8 pa1, bf16x8 pa2, bf16x8 pa3) {
#define PK(L, H) (bf16x8){L[0], L[1], L[2], L[3], H[0], H[1], H[2], H[3]}
  od = __builtin_amdgcn_mfma_f32_32x32x16_bf16(pa0, PK(f.l0, f.h0), od, 0, 0, 0);
  od = __builtin_amdgcn_mfma_f32_32x32x16_bf16(pa1, PK(f.l1, f.h1), od, 0, 0, 0);
  od = __builtin_amdgcn_mfma_f32_32x32x16_bf16(pa2, PK(f.l2, f.h2), od, 0, 0, 0);
  od = __builtin_amdgcn_mfma_f32_32x32x16_bf16(pa3, PK(f.l3, f.h3), od, 0, 0, 0);
#undef PK
}
__device__ __forceinline__ void pv_d0(f32x16* o, int vb, bf16x8 pa0, bf16x8 pa1, bf16x8 pa2, bf16x8 pa3) {
  VFrag fa, fb;
  pv_reads<0>(fa, vb); pv_reads<1>(fb, vb);
  asm volatile("s_waitcnt lgkmcnt(8)" ::: "memory"); SBAR();
  pv_mma(o[0], fa, pa0, pa1, pa2, pa3); SBAR();
  pv_reads<2>(fa, vb);
  asm volatile("s_waitcnt lgkmcnt(8)" ::: "memory"); SBAR();
  pv_mma(o[1], fb, pa0, pa1, pa2, pa3); SBAR();
  pv_reads<3>(fb, vb);
  asm volatile("s_waitcnt lgkmcnt(8)" ::: "memory"); SBAR();
  pv_mma(o[2], fa, pa0, pa1, pa2, pa3); SBAR();
  asm volatile("s_waitcnt lgkmcnt(0)" ::: "memory"); SBAR();
  pv_mma(o[3], fb, pa0, pa1, pa2, pa3);
}
__device__ __forceinline__ void attn_dense_body(const u16* Qb, const u16* __restrict__ Kh, const u16* __restrict__ Vh, u16* Ob, int seq, char* lds, const int tid, const float noff) {
  const int wid = tid >> 6, lane = tid & 63, r32 = lane & 31, hi = lane >> 5;
  LAS unsigned char* l3 = (LAS unsigned char*)lds;
  u16* V_lds = (u16*)lds; u16* K_lds = (u16*)(lds + 3 * SHM_V);
  float* ws = (float*)(lds + 3 * SHM_V + 2 * SHM_K) + wid * 64; float* li_l = ws;
  float l_reg = 0; f32x16 o[4] = {}; bf16x8 qr[8];
  const u16* Qw = Qb + (long)(wid * QBLK + r32) * LDQ + hi * 8;
#pragma unroll
  for (int d0 = 0; d0 < 8; ++d0) qr[d0] = *reinterpret_cast<const bf16x8*>(Qw + d0 * 16);
  const int vb0 = (int)(uintptr_t)V_lds + v_rd_base(lane);
  const int wu = __builtin_amdgcn_readfirstlane(wid);
  unsigned ksrc0, ksrc1, vsrc0, vsrc1;
  { const int r = wid * 4 + (lane >> 4), p = lane & 15, c = p ^ (r & 7); ksrc0 = (unsigned)(r * LDK * 2 + c * 16); ksrc1 = ksrc0 + 32u * LDK * 2u; }
  { const int st = wid * 2 + (lane >> 5), within = lane & 31, kk = (st >> 2) * 8 + (within >> 2), c = (st & 3) * 32 + (within & 3) * 8;
    const int k = (kk & ~0xC) | ((kk & 4) << 1) | ((kk & 8) >> 1); vsrc0 = (unsigned)(k * LDK * 2 + c * 2); vsrc1 = vsrc0 + 32u * LDK * 2u; }
#define DMA_TILE(k0, ks, vs) do { const char* kt_ = (const char*)Kh + (size_t)(k0) * (LDK * 2); const char* vt_ = (const char*)Vh + (size_t)(k0) * (LDK * 2); \
    asm volatile("" : "+s"(kt_), "+s"(vt_));     \
    __builtin_amdgcn_global_load_lds((const unsigned*)(kt_ + ksrc0), (LAS unsigned*)(l3 + 3 * (int)SHM_V + (ks) * (int)SHM_K + wu * 1024), 16, 0, 0); \
    __builtin_amdgcn_global_load_lds((const unsigned*)(kt_ + ksrc1), (LAS unsigned*)(l3 + 3 * (int)SHM_V + (ks) * (int)SHM_K + wu * 1024 + 8192), 16, 0, 0); \
    __builtin_amdgcn_global_load_lds((const unsigned*)(vt_ + vsrc0), (LAS unsigned*)(l3 + (vs) * (int)SHM_V + wu * 1024), 16, 0, 0); \
    __builtin_amdgcn_global_load_lds((const unsigned*)(vt_ + vsrc1), (LAS unsigned*)(l3 + (vs) * (int)SHM_V + wu * 1024 + 8192), 16, 0, 0); } while (0)
#define LANDED() asm volatile("s_waitcnt vmcnt(0)" ::: "memory")
  f32x16 pA0, pA1, pB0, pB1; bf16x8 pa0, pa1, pa2, pa3; const int NT = seq / KVBLK;
  DMA_TILE(0, 0, 0); LANDED(); __syncthreads();
  DMA_TILE(KVBLK, 1, 1);
  qkt(pA0, pA1, K_lds, qr, r32, hi, noff); partialSM(pA0);
  LANDED(); __syncthreads();
  int sv = 0;
  for (int j = 1; j + 1 < NT; j += 2) {
    { const int sn = (sv == 0) ? 2 : sv - 1;
      SBAR(); DMA_TILE((j + 1) * KVBLK, 0, sn); SBAR();
      qkt(pB0, pB1, (u16*)((char*)K_lds + SHM_K), qr, r32, hi, noff);
      finishSM(pA0, pA1, l_reg, pa0, pa1, pa2, pa3); SBAR();
      pv_d0(o, vb0 + sv * (int)SHM_V, pa0, pa1, pa2, pa3); partialSM(pB0);
      LANDED(); __syncthreads(); sv = (sv == 2) ? 0 : sv + 1; }
    { const int sn = (sv == 0) ? 2 : sv - 1;
      SBAR(); DMA_TILE((j + 2) * KVBLK, 1, sn); SBAR();
      qkt(pA0, pA1, K_lds, qr, r32, hi, noff);
      finishSM(pB0, pB1, l_reg, pa0, pa1, pa2, pa3); SBAR();
      pv_d0(o, vb0 + sv * (int)SHM_V, pa0, pa1, pa2, pa3); partialSM(pA0);
      LANDED(); __syncthreads(); sv = (sv == 2) ? 0 : sv + 1; }
  }
  { const int svl = (sv == 2) ? 0 : sv + 1;
    SBAR(); qkt(pB0, pB1, (u16*)((char*)K_lds + SHM_K), qr, r32, hi, noff);
    finishSM(pA0, pA1, l_reg, pa0, pa1, pa2, pa3); SBAR();
    pv_d0(o, vb0 + sv * (int)SHM_V, pa0, pa1, pa2, pa3); partialSM(pB0);
    finishSM(pB0, pB1, l_reg, pa0, pa1, pa2, pa3); SBAR();
    pv_d0(o, vb0 + svl * (int)SHM_V, pa0, pa1, pa2, pa3); }
#undef DMA_TILE
#undef LANDED
  if (hi == 0) li_l[r32] = l_reg; asm volatile("s_waitcnt lgkmcnt(0)" ::: "memory");
  float rli[16];
#pragma unroll
  for (int r = 0; r < 16; ++r) rli[r] = __builtin_amdgcn_rcpf(li_l[crow(r, hi)]);
  u16* Ow = Ob + (long)(wid * QBLK) * LDO;
#pragma unroll
  for (int r = 0; r < 16; ++r) { int orow = crow(r, hi);
    for (int d0 = 0; d0 < 4; ++d0) Ow[(long)orow * LDO + d0 * 32 + r32] = (u16)f2bf(o[d0][r] * rli[r]); }
}
}

#define XB_TMO      128
#define XB_XCNT(j)  (256  + 64 * (j))
#define XB_XSUB(j)  (1280 + 64 * (j))
#define XB_XGEN(j)  (2304 + 64 * (j))
#define XB_TOP      3328
#define XB_TOPGEN   3392
#define XCD_BAR_WORDS 3456
#define XB_SPIN_CAP (1u << 18)
__device__ __forceinline__ unsigned xb_ld(unsigned* p)              { return __hip_atomic_load(p, __ATOMIC_RELAXED, __HIP_MEMORY_SCOPE_AGENT); }
__device__ __forceinline__ unsigned xb_add(unsigned* p, unsigned v) { return __hip_atomic_fetch_add(p, v, __ATOMIC_RELAXED, __HIP_MEMORY_SCOPE_AGENT); }
__device__ __forceinline__ unsigned xb_xcc_id() { return (unsigned)__builtin_amdgcn_s_getreg((3 << 11) | 20) & 0xFu; }
#define XB_SPIN(cond, bar) do { unsigned _sp = 0; while (cond) { __builtin_amdgcn_s_sleep(1); \
    if ((++_sp & 255u) == 0u) { if (xb_ld(&(bar)[XB_TMO])) break; if (_sp > XB_SPIN_CAP) { atomicAdd(&(bar)[XB_TMO], 1u); break; } } } } while (0)
__device__ __forceinline__ void xcd_barrier_complete(unsigned* bar, unsigned x, unsigned& nloc, unsigned& nx) {
    const unsigned G = gridDim.x * gridDim.y * gridDim.z;
    unsigned sum, cnt, mine, sp = 0u;
    for (;;) {
        sum = 0u; cnt = 0u; mine = 0u;
#pragma unroll
        for (unsigned j = 0; j < 16; ++j) { const unsigned c = xb_ld(&bar[XB_XCNT(j)]); sum += c; cnt += (c > 0u) ? 1u : 0u; mine = (j == x) ? c : mine; }
        if (sum == G) break;
        __builtin_amdgcn_s_sleep(1);
        if ((++sp & 255u) == 0u) { if (xb_ld(&bar[XB_TMO])) break; if (sp > XB_SPIN_CAP) { atomicAdd(&bar[XB_TMO], 1u); break; } }
    }
    nloc = mine > 0u ? mine : 1u; nx = cnt > 0u ? cnt : 1u;
}
__device__ __forceinline__ void xcd_barrier(unsigned* bar, volatile LAS unsigned* st, const int tid) {
    asm volatile("s_waitcnt vmcnt(0)" ::: "memory");
    __syncthreads();
    if (tid == 0) {
        const unsigned x = xb_xcc_id();
        __builtin_amdgcn_s_waitcnt(0);
        unsigned nloc = st[0], nx = st[1];
        if (nloc == 0u) { xcd_barrier_complete(bar, x, nloc, nx); st[0] = nloc; st[1] = nx; }
        const unsigned old = xb_add(&bar[XB_XSUB(x)], 1u);
        const unsigned gen = old / nloc;
        if (old + 1u == (gen + 1u) * nloc) {
            __builtin_amdgcn_fence(__ATOMIC_RELEASE, "agent");
            asm volatile("s_waitcnt vmcnt(0)" ::: "memory");
            const unsigned og = xb_add(&bar[XB_TOP], 1u);
            const unsigned tg = og / nx;
            if (og + 1u == (tg + 1u) * nx) xb_add(&bar[XB_TOPGEN], 1u);
            else XB_SPIN(xb_ld(&bar[XB_TOPGEN]) == tg, bar);
            __builtin_amdgcn_fence(__ATOMIC_ACQUIRE, "agent");
            xb_add(&bar[XB_XGEN(x)], 1u);
            asm volatile("s_waitcnt vmcnt(0)" ::: "memory");
        } else {
            XB_SPIN(xb_ld(&bar[XB_XGEN(x)]) == gen, bar);
            __builtin_amdgcn_fence(__ATOMIC_ACQUIRE, "agent");
            asm volatile("s_waitcnt vmcnt(0)" ::: "memory");
        }
    }
    __syncthreads();
}

struct Params { const float* in[23]; float* out; unsigned char* ws; int ph_lo, ph_hi; };
static_assert(sizeof(Params) == 23 * 8 + 8 + 8 + 8, "no padding in Params");

struct Ctx {
    int tid, lane, wid, G, gw, NGW;
    unsigned char* smem;
};

template <int MODE>
__device__ __forceinline__ void transpose_job(const Ctx& C, const float* W, int K, int N, u16* WT, int ldt) {
    float* scr = (float*)(C.smem + C.wid * 16384);
    const int nblk = N / 32, nitems = (K / 64) * nblk, lane = C.lane;
    for (int item = C.gw; item < nitems; item += C.NGW) {
        const int kb = item / nblk, nb = item % nblk, k0 = 64 * kb, n0 = 32 * nb;
        float tv[32];
#pragma unroll
        for (int i = 0; i < 32; ++i) tv[i] = __builtin_nontemporal_load(&W[(size_t)(k0 + 2 * i + (lane >> 5)) * N + n0 + (lane & 31)]);
#pragma unroll
        for (int i = 0; i < 32; ++i) scr[(2 * i + (lane >> 5)) * 33 + (lane & 31)] = tv[i];
        asm volatile("s_waitcnt lgkmcnt(0)" ::: "memory");
        const int c = lane & 7;
#pragma unroll
        for (int j = 0; j < 4; ++j) { const int n = (lane >> 3) + 8 * j; const float* s = scr + (8 * c) * 33 + n;
            u32x4 o; o.x = pk2(s[0 * 33], s[1 * 33]); o.y = pk2(s[2 * 33], s[3 * 33]); o.z = pk2(s[4 * 33], s[5 * 33]); o.w = pk2(s[6 * 33], s[7 * 33]);
            int row = n0 + n;
            if (MODE == 1) { const int b = row / FFH, jj = row % FFH; row = (jj / 128) * 256 + b * 128 + (jj % 128); }
            *(u32x4*)(WT + (size_t)row * ldt + k0 + 8 * c) = o; }
        asm volatile("s_waitcnt lgkmcnt(0)" ::: "memory");
    }
}
__device__ __forceinline__ void fold_fourier_job(const Ctx& C, const float* Wf, u16* Bt) {
    f32x2* tab = (f32x2*)(C.smem + 131072);
    __syncthreads();
    if (C.tid < 128) { float s, c; sincospif(2.0f * (float)C.tid / 128.0f, &s, &c); tab[C.tid] = (f32x2){c, s}; }
    __syncthreads();
    const int gt = blockIdx.x * 512 + C.tid, NT_ = C.G * 512;
    float* ct = (float*)(C.smem + C.wid * 4096);
    for (int id = gt; id < 131072; id += NT_) {
        const int n = id & 1023, combo = id >> 10, c8 = combo & 15, ro = (combo >> 4) & 1, g = combo >> 5;
        const float sc = 0.08838834764831845f;
#pragma unroll
        for (int i = 0; i < 16; ++i) { const int q = C.lane + 64 * i, k2 = q >> 3, e = q & 7; const f32x2 cs = tab[(k2 * (c8 * 8 + e)) & 127]; ct[q] = (ro ? cs.y : cs.x) * sc; }
        asm volatile("s_waitcnt lgkmcnt(0)" ::: "memory");
        float a[8] = {0.f, 0.f, 0.f, 0.f, 0.f, 0.f, 0.f, 0.f};
        const float* wp = Wf + (size_t)(g * 128) * 1024 + n;
        const f32x4* ct4 = (const f32x4*)ct;
#pragma unroll 16
        for (int k2 = 0; k2 < 128; ++k2) { const float w = __builtin_nontemporal_load(&wp[(size_t)k2 * 1024]); const f32x4 c0 = ct4[2 * k2], c1 = ct4[2 * k2 + 1];
            a[0] += c0[0] * w; a[1] += c0[1] * w; a[2] += c0[2] * w; a[3] += c0[3] * w; a[4] += c1[0] * w; a[5] += c1[1] * w; a[6] += c1[2] * w; a[7] += c1[3] * w; }
        u32x4 o; o.x = pk2(a[0], a[1]); o.y = pk2(a[2], a[3]); o.z = pk2(a[4], a[5]); o.w = pk2(a[6], a[7]);
        *(u32x4*)(Bt + (size_t)n * 2560 + ro * 512 + g * 128 + c8 * 8) = o;
        asm volatile("s_waitcnt lgkmcnt(0)" ::: "memory");
    }
}

__device__ __forceinline__ void ln_norm(f32x4 (&v)[4], float& mean_o, float& rstd_o) {
    float s = 0.f;
#pragma unroll
    for (int j = 0; j < 4; ++j) s += (v[j][0] + v[j][1]) + (v[j][2] + v[j][3]);
    const float mean = wave_sum(s) * (1.f / D); float s2 = 0.f;
#pragma unroll
    for (int j = 0; j < 4; ++j) { v[j] = v[j] - mean; s2 += (v[j][0] * v[j][0] + v[j][1] * v[j][1]) + (v[j][2] * v[j][2] + v[j][3] * v[j][3]); }
    const float rstd = 1.0f / sqrtf(wave_sum(s2) * (1.f / D) + LN_EPS);
#pragma unroll
    for (int j = 0; j < 4; ++j) v[j] = v[j] * rstd;
    mean_o = mean; rstd_o = rstd;
}
__device__ __forceinline__ void ln_rows(const Ctx& C, int nrows, const float* src, float* dst, const float* lg, const float* lb, bool do_h, const float* mod, int shift_off, int scale_off,
                                        u16* H, float* st, bool write_x, bool xmap) {
    f32x4 g4[4], b4[4], sh[4], sc[4];
#pragma unroll
    for (int j = 0; j < 4; ++j) { g4[j] = (f32x4){1.f, 1.f, 1.f, 1.f}; b4[j] = (f32x4){0.f, 0.f, 0.f, 0.f}; sh[j] = b4[j]; sc[j] = g4[j]; }
    if (lg) {
#pragma unroll
        for (int j = 0; j < 4; ++j) { g4[j] = *(const f32x4*)(lg + 4 * C.lane + 256 * j); b4[j] = *(const f32x4*)(lb + 4 * C.lane + 256 * j); } }
    if (do_h) {
#pragma unroll
        for (int j = 0; j < 4; ++j) { sh[j] = *(const f32x4*)(mod + shift_off + 4 * C.lane + 256 * j); sc[j] = *(const f32x4*)(mod + scale_off + 4 * C.lane + 256 * j) + 1.0f; } }
    const bool xm = xmap && C.G == 256 && nrows == T;
    const int mstep = xm ? 256 : C.NGW, mend = xm ? (int)(2048 * (blockIdx.x & 7)) + 2048 : nrows;
    int m = xm ? (int)(2048 * (blockIdx.x & 7) + (blockIdx.x >> 3) * 8) + C.wid : C.gw; f32x4 nv[4];
    if (m < mend) {
#pragma unroll
        for (int j = 0; j < 4; ++j) nv[j] = *(const f32x4*)(src + (size_t)m * D + 4 * C.lane + 256 * j); }
    for (; m < mend; m += mstep) {
        f32x4 v[4];
#pragma unroll
        for (int j = 0; j < 4; ++j) v[j] = nv[j];
        { const int mn = m + mstep;
          if (mn < mend) {
#pragma unroll
              for (int j = 0; j < 4; ++j) nv[j] = *(const f32x4*)(src + (size_t)mn * D + 4 * C.lane + 256 * j); } }
        float mu, rs;
        if (lg) {
            ln_norm(v, mu, rs);
            if (st && C.lane == 0) *(f32x2*)(st + 2 * (size_t)m) = (f32x2){mu, rs};
#pragma unroll
            for (int j = 0; j < 4; ++j) { v[j] = v[j] * g4[j] + b4[j]; if (write_x) *(f32x4*)(dst + (size_t)m * D + 4 * C.lane + 256 * j) = v[j]; }
        }
        if (do_h) {
            ln_norm(v, mu, rs);
            u32x2* hp = (u32x2*)(H + (size_t)m * D) + C.lane;
#pragma unroll
            for (int j = 0; j < 4; ++j) { const f32x4 h = v[j] * sc[j] + sh[j]; u32x2 w; w.x = pk2(h[0], h[1]); w.y = pk2(h[2], h[3]); hp[64 * j] = w; }
        }
    }
}
__device__ __forceinline__ void ln_pass(const Ctx& C, int nrows, const float* src_lat, const float* src_ctx, float* dst_lat, float* dst_ctx,
                                        const float* lg, const float* lb, bool do_h, const float* mod_lat, const float* mod_ctx, int shift_off, int scale_off, u16* H, float* st, bool write_x) {
    ln_rows(C, T, src_lat, dst_lat, lg, lb, do_h, mod_lat, shift_off, scale_off, H, st, write_x, true);
    if (nrows > T) ln_rows(C, nrows - T, src_ctx, dst_ctx, lg, lb, do_h, mod_ctx, shift_off, scale_off, H + (size_t)T * D, st ? st + 2 * (size_t)T : st, write_x, false);
}

template <int K>
__device__ __forceinline__ void load_B_transposed(const Ctx& C, const u16* B, size_t ldb) {
    constexpr int KP = K + 8;
    unsigned* sB32 = (unsigned*)C.smem;
#pragma unroll
    for (int ch = C.tid; ch < (K / 2) * 16; ch += 512) {
        const int n8 = ch & 15, kp = ch >> 4;
        const u32x4 r0 = __builtin_nontemporal_load((const u32x4*)(B + (size_t)(2 * kp) * ldb + n8 * 8)), r1 = __builtin_nontemporal_load((const u32x4*)(B + (size_t)(2 * kp + 1) * ldb + n8 * 8));
        const unsigned a[4] = {r0.x, r0.y, r0.z, r0.w}, b[4] = {r1.x, r1.y, r1.z, r1.w};
#pragma unroll
        for (int e = 0; e < 4; ++e) { const int n = n8 * 8 + 2 * e;
            sB32[(n * KP) / 2 + kp] = (a[e] & 0xffffu) | (b[e] << 16);
            sB32[((n + 1) * KP) / 2 + kp] = (a[e] >> 16) | (b[e] & 0xffff0000u); }
    }
}
template <int K>
__device__ __forceinline__ void mma_256x128(const Ctx& C, const u16* A_re, const u16* A_im, f32x16 (&acc_re)[2], f32x16 (&acc_im)[2]) {
    constexpr int KP = K + 8;
    const int l32 = C.lane & 31, hi = C.lane >> 5, mb = C.wid & 3, nh = C.wid >> 2;
    const u16* are = A_re + (size_t)(32 * mb + l32) * K + 8 * hi; const u16* aim = A_im + (size_t)(32 * mb + l32) * K + 8 * hi;
    const u16* sB = (const u16*)C.smem;
    const u16* b0p = sB + (64 * nh + l32) * KP + 8 * hi; const u16* b1p = b0p + 32 * KP;
    acc_re[0] = f32x16{}; acc_re[1] = f32x16{}; acc_im[0] = f32x16{}; acc_im[1] = f32x16{};
#pragma unroll 8
    for (int k0 = 0; k0 < K; k0 += 16) {
        const bf16x8 ar = *(const bf16x8*)(are + k0), ai = *(const bf16x8*)(aim + k0);
        const bf16x8 b0 = *(const bf16x8*)(b0p + k0), b1 = *(const bf16x8*)(b1p + k0);
        acc_re[0] = __builtin_amdgcn_mfma_f32_32x32x16_bf16(ar, b0, acc_re[0], 0, 0, 0);
        acc_re[1] = __builtin_amdgcn_mfma_f32_32x32x16_bf16(ar, b1, acc_re[1], 0, 0, 0);
        acc_im[0] = __builtin_amdgcn_mfma_f32_32x32x16_bf16(ai, b0, acc_im[0], 0, 0, 0);
        acc_im[1] = __builtin_amdgcn_mfma_f32_32x32x16_bf16(ai, b1, acc_im[1], 0, 0, 0);
    }
}

__device__ __forceinline__ void ctx_tile(const Ctx& C, const u16* A, int lda, const u16* Bt, int ldb, int K, float (&out)[2]) {
    const int l32 = C.lane & 31, hi = C.lane >> 5, ks = K >> 3;
    const u16* ap = A + (size_t)l32 * lda + C.wid * ks + 8 * hi; const u16* bp = Bt + (size_t)l32 * ldb + C.wid * ks + 8 * hi;
    f32x16 acc = f32x16{};
#pragma unroll 8
    for (int k0 = 0; k0 < ks; k0 += 16) acc = __builtin_amdgcn_mfma_f32_32x32x16_bf16(*(const bf16x8*)(ap + k0), *(const bf16x8*)(bp + k0), acc, 0, 0, 0);
    float* red = (float*)C.smem;
    __syncthreads();
#pragma unroll
    for (int r = 0; r < 16; ++r) red[(C.wid * 32 + crow(r, hi)) * 33 + l32] = acc[r];
    __syncthreads();
#pragma unroll
    for (int i = 0; i < 2; ++i) { const int e = C.tid + 512 * i, rr = e >> 5, cc = e & 31; float s = 0.f;
#pragma unroll
        for (int w = 0; w < 8; ++w) s += red[(w * 32 + rr) * 33 + cc];
        out[i] = s; }
}

__device__ __forceinline__ int lane_id_volatile() { int l; asm volatile("v_mbcnt_lo_u32_b32 %0, -1, 0\n\tv_mbcnt_hi_u32_b32 %0, -1, %0" : "=v"(l)); return l; }
typedef const Params __attribute__((address_space(4))) * KargP;
__global__ void __launch_bounds__(512, 2) fwd_megakernel(Params p_unused) {
    extern __shared__ __attribute__((aligned(16))) unsigned char smem[];
    cg::grid_group grid = cg::this_grid();
    int ph_lo, ph_hi;
    const int WID = __builtin_amdgcn_readfirstlane((int)(threadIdx.x >> 6));
#define MYTID() (WID * 64 + lane_id_volatile())
#define RETID() do { C.lane = lane_id_volatile(); C.tid = WID * 64 + C.lane; } while (0)
    { KargP kp0 = (KargP)__builtin_amdgcn_kernarg_segment_ptr(); ph_lo = kp0->ph_lo; ph_hi = kp0->ph_hi; }
#define p (*KARG)
#define x_in    (p.in[0])
#define c_in    (p.in[1])
#define ctx_in  (p.in[2])
#define cctx_in (p.in[3])
#define w_ada   (p.in[4])
#define b_ada   (p.in[5])
#define w_in    (p.in[6])
#define q_gain  (p.in[7])
#define k_gain  (p.in[8])
#define sgu_g   (p.in[9])
#define sgu_b   (p.in[10])
#define w_sp    (p.in[11])
#define b_sp    (p.in[12])
#define w_bra   (p.in[13])
#define w_brs   (p.in[14])
#define w_brf   (p.in[15])
#define w_out   (p.in[16])
#define ln1_g   (p.in[17])
#define ln1_b   (p.in[18])
#define w_up    (p.in[19])
#define w_down  (p.in[20])
#define ln2_g   (p.in[21])
#define ln2_b   (p.in[22])
#define Hb   ((u16*)(ws + OFF_H))
#define Qb   ((u16*)(ws + OFF_Q))
#define Fb   ((u16*)(ws + OFF_F))
#define Kb   ((u16*)(ws + OFF_K))
#define Vb   ((u16*)(ws + OFF_V))
#define YCb  ((u16*)(ws + OFF_YC))
#define Sb   ((u16*)(ws + OFF_S))
#define Gb   ((u16*)(ws + OFF_G))
#define ACTb ((u16*)(ws + OFF_G))
#define WINt ((u16*)(ws + OFF_W1))
#define WUPt ((u16*)(ws + OFF_WUP))
#define WDNt ((u16*)(ws + OFF_WDN))
#define WBAt ((u16*)(ws + OFF_WBA))
#define WBSt (WBAt + 1024)
#define WBFt (WBAt + 1536)
#define WOt  ((u16*)(ws + OFF_WO))
#define XCTX ((float*)(ws + OFF_XCTX))
#define MODP ((float*)(ws + OFF_MODP))
#define MOD  ((float*)(ws + OFF_MOD))
#define MA   ((u16*)(ws + OFF_MA))
#define MB   ((u16*)(ws + OFF_MB))
#define MC   ((u16*)(ws + OFF_MC))
#define TW   ((f32x2*)(ws + OFF_TW))
#define ROPE ((f32x2*)(ws + OFF_ROPE))
#define WSP  ((u16*)(ws + OFF_WSP))
#define FCb  ((u16*)(ws + OFF_FC))
#define ST1  ((float*)(ws + OFF_ST1))
#define ST2  ((float*)(ws + OFF_ST2))
#define XLAT (p.out)
#define lds3 ((PG8_LAS unsigned char*)smem)

    int ph = 0;
#ifdef PROBE_MASK
#define PROBE_LT ((volatile unsigned long long*)(smem + 131072 + 1536))
    if (MYTID() == 0) { PROBE_LT[0] = 0; PROBE_LT[1] = 0; }
#define PROBE_SEL(k) ((PROBE_MASK >> ((k) < 3 ? (k) : 3 + ((k) - 3) % 10)) & 1)
#define PROBE_T0 if (MYTID() == 0 && PROBE_SEL(ph)) PROBE_LT[1] = __builtin_amdgcn_s_memrealtime();
#define PROBE_T1 if (MYTID() == 0 && PROBE_SEL(ph)) PROBE_LT[0] += __builtin_amdgcn_s_memrealtime() - PROBE_LT[1];
#else
#define PROBE_T0
#define PROBE_T1
#endif
#define XB_ST ((volatile LAS unsigned*)(smem + 131072 + 1600))
#define XB_BAR ((unsigned*)((unsigned char*)((KargP)__builtin_amdgcn_kernarg_segment_ptr())->ws + OFF_BAR))
    if (MYTID() == 0) { XB_ST[0] = 0u; XB_ST[1] = 0u; (void)xb_add(&XB_BAR[XB_XCNT(xb_xcc_id())], 1u); }
    __syncthreads();
    if (ph_hi < ph_lo) grid.sync();
#ifdef PROBE_DUPSYNC
#define GSYNC() do { xcd_barrier(XB_BAR, XB_ST, MYTID()); xcd_barrier(XB_BAR, XB_ST, MYTID()); } while (0)
#else
#define GSYNC() xcd_barrier(XB_BAR, XB_ST, MYTID())
#endif
#define PH_BEGIN if (ph >= ph_lo && ph < ph_hi) { PROBE_T0 KargP KARG = (KargP)__builtin_amdgcn_kernarg_segment_ptr(); asm volatile("" : "+s"(KARG)); unsigned char* ws = KARG->ws; \
    Ctx C; C.wid = WID; RETID(); C.G = gridDim.x; C.gw = blockIdx.x * 8 + C.wid; C.NGW = C.G * 8; C.smem = smem;
#define PH_END } if (ph >= ph_lo && ph + 1 < ph_hi) GSYNC(); if (ph >= ph_lo && ph < ph_hi) { PROBE_T1 } ++ph;

    PH_BEGIN
    {
        float* sm = (float*)(smem + 131072);
        for (int it = blockIdx.x; it < 384; it += C.G) {
            const int l = it / 192, rem = it % 192, kp = rem / 12, nb = rem % 12;
            __syncthreads();
            if (C.tid < 128) { const int w = C.tid >> 6, kk = C.tid & 63; const float v = (w ? cctx_in : c_in)[kp * 64 + kk]; sm[C.tid] = v / (1.0f + expf(-v)); }
            __syncthreads();
            const int n = nb * 512 + C.tid; float a0 = 0.f, a1 = 0.f; const float* wp = w_ada + ((size_t)l * 1024 + kp * 64) * INW + n;
#pragma unroll 32
            for (int kk = 0; kk < 64; ++kk) { const float w = __builtin_nontemporal_load(&wp[(size_t)kk * INW]); a0 += sm[kk] * w; a1 += sm[64 + kk] * w; }
            MODP[(size_t)((l * 16 + kp) * 2 + 0) * INW + n] = a0; MODP[(size_t)((l * 16 + kp) * 2 + 1) * INW + n] = a1;
        }
        __syncthreads();
        const int gt = blockIdx.x * 512 + C.tid, NTH = C.G * 512;
        const float r128 = 0.08838834764831845f;
        for (int i = gt; i < 256 * 128; i += NTH) { const int m = i >> 7, t1 = i & 127, ka = m & 127, im = m >> 7; float s, c; sincospif(2.0f * (float)((ka * t1) & 127) / 128.0f, &s, &c); MA[i] = (u16)f2bf((im ? -s : c) * r128); }
        for (int i = gt; i < 256 * 256; i += NTH) { const int row = i >> 8, col = i & 255, ro = row >> 7, kb = row & 127, ri = col >> 7, t0 = col & 127; float s, c; sincospif(2.0f * (float)((kb * t0) & 127) / 128.0f, &s, &c);
            const float v = (ro == ri) ? c : (ro == 0 ? s : -s); MB[i] = (u16)f2bf(v * r128); }
        for (int i = gt; i < 512 * 256; i += NTH) { const int row = i >> 8, t = i & 255, ro = row >> 8, k1 = row & 255; float s, c; sincospif(2.0f * (float)((k1 * t) & 255) / 256.0f, &s, &c); MC[i] = (u16)f2bf((ro ? -s : c) * 0.0625f); }
        for (int i = gt; i < 128 * 128; i += NTH) { const int ka = i >> 7, t0 = i & 127; float s, c; sincospif(2.0f * (float)((ka * t0) & 16383) / 16384.0f, &s, &c); TW[i] = (f32x2){c, s}; }
        for (int i = gt; i < 256 * 32; i += NTH) { const int pos = i >> 5, j = i & 31; const float inv = exp2f(-(float)j * (13.287712379549449f / 32.0f)); const float ang = (float)pos * inv;
            const double rev = (double)ang * 0.15915494309189535; const double fr = rev - rint(rev); float s, c; sincospif((float)(2.0 * fr), &s, &c); ROPE[i] = (f32x2){c, s}; }
        for (int i = gt; i < NL * 8 * 128 * 128; i += NTH) WSP[i] = (u16)f2bf(__builtin_nontemporal_load(&w_sp[i]));
        transpose_job<0>(C, w_in, D, INW, WINt, D);
        transpose_job<0>(C, w_bra, D, D, WBAt, 2560);
        transpose_job<0>(C, w_brs, 512, D, WBSt, 2560);
        transpose_job<0>(C, w_out, D, D, WOt, D);
        fold_fourier_job(C, w_brf, WBFt);
    }
    PH_END
    PH_BEGIN
    {
        const int gt = blockIdx.x * 512 + C.tid, NTH = C.G * 512;
        for (int i = gt; i < NL * 2 * INW; i += NTH) { const int n = i % INW, lw = i / INW, l = lw >> 1, w = lw & 1; float a = b_ada[l * INW + n];
            for (int kp = 0; kp < 16; ++kp) a += MODP[(size_t)((l * 16 + kp) * 2 + w) * INW + n];
            MOD[i] = a; }
    }
    PH_END
    PH_BEGIN
    ln_pass(C, R, x_in, ctx_in, nullptr, nullptr, nullptr, nullptr, true, MOD, MOD + INW, 0, 1024, Hb, nullptr, false);
    PH_END

#pragma unroll 1
    for (int l = 0; l < NL; ++l) {
        const bool lastl = (l == NL - 1);
#define modl (MOD + (size_t)(l * 2 + 0) * INW)
#define modc (MOD + (size_t)(l * 2 + 1) * INW)
#define xin_lat ((l == 0) ? x_in : (const float*)XLAT)
#define xin_ctx ((l == 0) ? ctx_in : (const float*)XCTX)

        PH_BEGIN
        {
            pg8::Gemm g{Hb, WINt, D, D, D, nullptr, nullptr, 0, nullptr, nullptr, 0}; pg8::OrderX S; S.init(INW, C.G, (int)blockIdx.x, 0, 0);
            pg8::EpiIn E{Qb, Kb, Vb, Sb, Fb, FCb, Gb};
            pg8::gemm_phase<pg8::EpiIn, pg8::OrderX>(lds3, g, S, E, C.tid);
            const int ct0 = lastl ? 32 : 0, nct = lastl ? 16 : 192;
            for (int it = blockIdx.x; it < 8 * nct; it += C.G) {
                const int rt = it / nct, ctile = ct0 + it % nct, r0 = T + 32 * rt, c0 = 32 * ctile;
                float v[2]; ctx_tile(C, Hb + (size_t)r0 * D, D, WINt + (size_t)c0 * D, D, D, v);
#pragma unroll
                for (int i = 0; i < 2; ++i) { const int e = C.tid + 512 * i, row = r0 + (e >> 5), col = c0 + (e & 31); const float x = v[i];
                    if (col < 1024) Qb[(size_t)row * 1024 + col] = (u16)f2bf(x);
                    else if (col < 1280) Kb[(size_t)row * 256 + col - 1024] = (u16)f2bf(x);
                    else if (col < 1536) Vb[(size_t)row * 256 + col - 1280] = (u16)f2bf(x);
                    else if (col < 2560) Sb[(size_t)row * 1024 + col - 1536] = (u16)f2bf(fgelu_tanh(x));
                    else if (col < 3072) FCb[(size_t)(row - T) * 512 + col - 2560] = (u16)f2bf(x);
                    else Gb[(size_t)row * 3072 + col - 3072] = (u16)f2bf(fsigmoid(x)); }
            }
            __syncthreads();
        }
        PH_END
        PH_BEGIN
        {
            {
                const int sub = C.lane >> 4, l16 = C.lane & 15;
#pragma unroll 1
                for (int pass = 0; pass < 2; ++pass) {
                    u16* base = pass == 0 ? Qb : Kb; const int nseg = pass == 0 ? (lastl ? T : R) * 8 : R * 2; const int shift = pass == 0 ? 3 : 1;
                    const float* gain = (pass == 0 ? q_gain : k_gain) + l * 128 + l16 * 8;
                    const f32x4 g0 = *(const f32x4*)gain, g1 = *(const f32x4*)(gain + 4);
                    const int ngroups = nseg >> 2;
#pragma unroll 4
                    for (int grp = C.gw; grp < ngroups; grp += C.NGW) {
                        const int s = grp * 4 + sub, m = s >> shift;
                        u32x4* pp = (u32x4*)(base + (size_t)s * 128 + l16 * 8);
                        const u32x4 w = *pp;
                        float x0 = bflo(w.x), x1 = bfhi(w.x), x2 = bflo(w.y), x3 = bfhi(w.y), x4 = bflo(w.z), x5 = bfhi(w.z), x6 = bflo(w.w), x7 = bfhi(w.w);
                        float ss = (x0 * x0 + x1 * x1) + (x2 * x2 + x3 * x3) + (x4 * x4 + x5 * x5) + (x6 * x6 + x7 * x7);
                        ss += __shfl_xor(ss, 1); ss += __shfl_xor(ss, 2); ss += __shfl_xor(ss, 4); ss += __shfl_xor(ss, 8);
                        const float rs = (pass == 0 ? 0.12751743f   : 1.0f) / sqrtf(ss * (1.0f / 128.0f) + RMS_EPS);
                        x0 *= rs * g0[0]; x1 *= rs * g0[1]; x2 *= rs * g0[2]; x3 *= rs * g0[3]; x4 *= rs * g1[0]; x5 *= rs * g1[1]; x6 *= rs * g1[2]; x7 *= rs * g1[3];
                        if (m < T) { const int pos = l16 < 8 ? (m >> 6) : (m & 63); const f32x2* rp = ROPE + pos * 32 + (l16 & 7) * 4;
                            const f32x4 c01 = *(const f32x4*)rp, c23 = *(const f32x4*)(rp + 2);
                            float t;
                            t = x0 * c01[0] - x1 * c01[1]; x1 = x0 * c01[1] + x1 * c01[0]; x0 = t;
                            t = x2 * c01[2] - x3 * c01[3]; x3 = x2 * c01[3] + x3 * c01[2]; x2 = t;
                            t = x4 * c23[0] - x5 * c23[1]; x5 = x4 * c23[1] + x5 * c23[0]; x4 = t;
                            t = x6 * c23[2] - x7 * c23[3]; x7 = x6 * c23[3] + x7 * c23[2]; x6 = t; }
                        u32x4 o; o.x = pk2(x0, x1); o.y = pk2(x2, x3); o.z = pk2(x4, x5); o.w = pk2(x6, x7);
                        *pp = o;
                    }
                }
            }
            RETID();
            {
                const int nchunks = lastl ? 128 : 130;
                float* smean = (float*)(smem + 65536); float* srstd = smean + 128;
                unsigned* sB32 = (unsigned*)smem; constexpr int KP = 136;
                const int l32 = C.lane & 31, hi = C.lane >> 5, mb = C.wid & 3, nb = C.wid >> 2;
                for (int it = blockIdx.x; it < nchunks * 2; it += C.G) {
                    const int ch = it >> 1, gh = it & 1, R0 = ch * 128;
                    __syncthreads();
                    { const int q = C.tid >> 2, part = C.tid & 3; const u16* vr = Sb + (size_t)(R0 + q) * 1024 + 512 + part * 128; float s = 0.f, s2 = 0.f;
                      u32x4 w[16];
#pragma unroll
                      for (int j = 0; j < 16; ++j) w[j] = *(const u32x4*)(vr + j * 8);
#pragma unroll
                      for (int j = 0; j < 16; ++j) { const unsigned ww[4] = {w[j].x, w[j].y, w[j].z, w[j].w};
#pragma unroll
                          for (int e = 0; e < 4; ++e) { const float a = bflo(ww[e]), b = bfhi(ww[e]); s += a + b; s2 += a * a + b * b; } }
                      s += __shfl_xor(s, 1); s += __shfl_xor(s, 2); s2 += __shfl_xor(s2, 1); s2 += __shfl_xor(s2, 2);
                      const float mean = s * (1.0f / 512.0f); const float var = fmaxf(s2 * (1.0f / 512.0f) - mean * mean, 0.f);
                      if (part == 0) { smean[q] = mean; srstd[q] = 1.0f / sqrtf(var + LN_EPS); } }
                    __syncthreads();
                    const int qp = C.tid >> 3, c8 = C.tid & 7;
                    const float m0 = smean[2 * qp], s0 = srstd[2 * qp], m1 = smean[2 * qp + 1], s1 = srstd[2 * qp + 1];
#pragma unroll 1
                    for (int gi = 0; gi < 4; ++gi) {
                        const int g = gh * 4 + gi, cb = g * 64 + c8 * 8, cc = g * 64 + 32 * nb + l32;
                        const u32x4 r0 = *(const u32x4*)(Sb + (size_t)(R0 + 2 * qp) * 1024 + 512 + cb), r1 = *(const u32x4*)(Sb + (size_t)(R0 + 2 * qp + 1) * 1024 + 512 + cb);
                        const f32x4 ga = *(const f32x4*)(sgu_g + l * 512 + cb), gb = *(const f32x4*)(sgu_g + l * 512 + cb + 4), ba = *(const f32x4*)(sgu_b + l * 512 + cb), bb = *(const f32x4*)(sgu_b + l * 512 + cb + 4);
                        const u16* arow = WSP + ((size_t)(l * 8 + g) * 128 + 32 * mb + l32) * 128 + 8 * hi;
                        bf16x8 af[8];
#pragma unroll
                        for (int k = 0; k < 8; ++k) af[k] = *(const bf16x8*)(arow + 16 * k);
                        u16 uv[16]; float bsp[16];
#pragma unroll
                        for (int r = 0; r < 16; ++r) { const int pr = 32 * mb + crow(r, hi); uv[r] = Sb[(size_t)(R0 + pr) * 1024 + cc]; bsp[r] = b_sp[(l * 8 + g) * 128 + pr]; }
                        const float gg[8] = {ga[0], ga[1], ga[2], ga[3], gb[0], gb[1], gb[2], gb[3]}, bbv[8] = {ba[0], ba[1], ba[2], ba[3], bb[0], bb[1], bb[2], bb[3]};
                        const unsigned a[4] = {r0.x, r0.y, r0.z, r0.w}, b[4] = {r1.x, r1.y, r1.z, r1.w};
#pragma unroll
                        for (int e = 0; e < 4; ++e) { const int c = c8 * 8 + 2 * e;
                            const float v00 = (bflo(a[e]) - m0) * s0 * gg[2 * e] + bbv[2 * e], v01 = (bfhi(a[e]) - m0) * s0 * gg[2 * e + 1] + bbv[2 * e + 1];
                            const float v10 = (bflo(b[e]) - m1) * s1 * gg[2 * e] + bbv[2 * e], v11 = (bfhi(b[e]) - m1) * s1 * gg[2 * e + 1] + bbv[2 * e + 1];
                            sB32[(c * KP) / 2 + qp] = pk2(v00, v10); sB32[((c + 1) * KP) / 2 + qp] = pk2(v01, v11); }
                        __syncthreads();
                        { const u16* bp = (const u16*)smem + (32 * nb + l32) * KP + 8 * hi;
                          f32x16 acc = f32x16{};
#pragma unroll
                          for (int k = 0; k < 8; ++k) acc = __builtin_amdgcn_mfma_f32_32x32x16_bf16(af[k], *(const bf16x8*)(bp + 16 * k), acc, 0, 0, 0);
#pragma unroll
                          for (int r = 0; r < 16; ++r) { const int pr = 32 * mb + crow(r, hi); Sb[(size_t)(R0 + pr) * 1024 + cc] = (u16)f2bf(bf2f(uv[r]) * (acc[r] + bsp[r])); } }
                        __syncthreads();
                    }
                }
                __syncthreads();
            }
            RETID();
            for (int it = blockIdx.x; it < 512; it += C.G) {
                const int n0 = it * 128, t0 = it >> 2;
                __syncthreads();
                load_B_transposed<128>(C, Fb + n0, 65536);
                __syncthreads();
                f32x16 are[2], aim[2];
                mma_256x128<128>(C, MA, MA + 128 * 128, are, aim);
                const int l32 = C.lane & 31, hi = C.lane >> 5, mb = C.wid & 3, nh = C.wid >> 2;
#pragma unroll
                for (int s = 0; s < 2; ++s)
#pragma unroll
                    for (int r = 0; r < 16; ++r) { const int ka = 32 * mb + crow(r, hi); const f32x2 tw = TW[ka * 128 + t0];
                        const float hr = are[s][r], hm = aim[s][r]; const float orr = hr * tw.x + hm * tw.y, oi = hm * tw.x - hr * tw.y;
                        const size_t o = (size_t)ka * 131072 + n0 + 64 * nh + 32 * s + l32;
                        Hb[o] = (u16)f2bf(orr); Hb[o + 65536] = (u16)f2bf(oi); }
            }
            __syncthreads();
            RETID();
            transpose_job<1>(C, w_up + (size_t)l * D * 2 * FFH, D, 2 * FFH, WUPt, D);
            transpose_job<0>(C, w_down + (size_t)l * FFH * D, FFH, D, WDNt, FFH);
        }
        PH_END
        PH_BEGIN
        {
            const int nunits = lastl ? 512 : 520;
            float noff;
            { float gq = fmaxf(fabsf(q_gain[l * 128 + C.lane]), fabsf(q_gain[l * 128 + 64 + C.lane])), gk = fmaxf(fabsf(k_gain[l * 128 + C.lane]), fabsf(k_gain[l * 128 + 64 + C.lane]));
#pragma unroll
              for (int o = 1; o < 64; o <<= 1) { gq = fmaxf(gq, __shfl_xor(gq, o)); gk = fmaxf(gk, __shfl_xor(gk, o)); }
              const float bound = gq * gk * 11.3137085f * 1.44269504f;
              noff = -fmaxf(0.f, bound - 60.f); }
            for (int L = blockIdx.x; L < nunits; L += C.G) {
                __syncthreads();
                const u16 *qp, *kp, *vp; int seq;
                if (L < 512) { const int h = L >> 6, qb = L & 63, kvh = h >> 2; qp = Qb + (size_t)(qb * 256) * 1024 + h * 128; kp = Kb + kvh * 128; vp = Vb + kvh * 128; seq = R; }
                else { const int h = L - 512, kvh = h >> 2; qp = Qb + (size_t)T * 1024 + h * 128; kp = Kb + (size_t)T * 256 + kvh * 128; vp = Vb + (size_t)T * 256 + kvh * 128; seq = CTX; }
                att::attn_dense_body(qp, kp, vp, (u16*)qp, seq, (char*)smem, C.tid, noff);
            }
            __syncthreads();
        }
        PH_END
        PH_BEGIN
        {
            const int nitems = lastl ? 512 : 520;
            for (int it = blockIdx.x; it < nitems; it += C.G) {
                const u16 *Are, *Aim, *Bp; int rowbase, rowstride, nt;
                if (it < 512) { const int ka = it >> 2; nt = it & 3; Are = MB; Aim = MB + 128 * 256; Bp = Hb + (size_t)ka * 131072 + nt * 128; rowbase = ka; rowstride = 128; }
                else { const int hs = (it - 512) >> 2; nt = it & 3; Are = MC + (size_t)(128 * hs) * 256; Aim = MC + (size_t)(256 + 128 * hs) * 256; Bp = FCb + nt * 128; rowbase = T + 128 * hs; rowstride = 1; }
                __syncthreads();
                load_B_transposed<256>(C, Bp, 512);
                __syncthreads();
                f32x16 are[2], aim[2];
                mma_256x128<256>(C, Are, Aim, are, aim);
                const int l32 = C.lane & 31, hi = C.lane >> 5, mb = C.wid & 3, nh = C.wid >> 2;
#pragma unroll
                for (int s = 0; s < 2; ++s)
#pragma unroll
                    for (int r = 0; r < 16; ++r) { const int kb = 32 * mb + crow(r, hi); const size_t o = (size_t)(rowbase + rowstride * kb) * 1024 + nt * 128 + 64 * nh + 32 * s + l32;
                        YCb[o] = (u16)f2bf(are[s][r]); YCb[o + 512] = (u16)f2bf(aim[s][r]); }
            }
            __syncthreads();
        }
        PH_END
        PH_BEGIN
        {
            {
                pg8::Gemm g{Qb, WBAt, 1024, 1024, 2560, Sb, WBSt, 512, YCb, WBFt, 1024};
                pg8::OrderBr S; S.init(D, C.G, (int)blockIdx.x);
                pg8::EpiBr E{Gb, Hb};
                pg8::gemm_phase<pg8::EpiBr, pg8::OrderBr>(lds3, g, S, E, C.tid);
            }
            if (!lastl) {
                for (int it = blockIdx.x; it < 8 * 32; it += C.G) {
                    const int r0 = T + 32 * (it >> 5), c0 = 32 * (it & 31);
                    float m[2] = {0.f, 0.f};
#pragma unroll 1
                    for (int b = 0; b < 3; ++b) { float v[2];
                        ctx_tile(C, (b == 0 ? Qb : (b == 1 ? Sb : YCb)) + (size_t)r0 * 1024, 1024, (b == 0 ? WBAt : (b == 1 ? WBSt : WBFt)) + (size_t)c0 * 2560, 2560, b == 1 ? 512 : 1024, v);
#pragma unroll
                        for (int i = 0; i < 2; ++i) { const int e = C.tid + 512 * i, row = r0 + (e >> 5), col = c0 + (e & 31); m[i] += v[i] * bf2f(Gb[(size_t)row * 3072 + b * 1024 + col]); } }
#pragma unroll
                    for (int i = 0; i < 2; ++i) { const int e = C.tid + 512 * i, row = r0 + (e >> 5), col = c0 + (e & 31); Hb[(size_t)row * 1024 + col] = (u16)f2bf(m[i]); }
                }
                __syncthreads();
            }
        }
        PH_END
        PH_BEGIN
        {
            pg8::Gemm g{Hb, WOt, D, D, D, nullptr, nullptr, 0, nullptr, nullptr, 0}; pg8::OrderX S; S.init(D, C.G, (int)blockIdx.x, 0, 0);
            pg8::EpiRes E{xin_lat, XLAT, modl + 2 * 1024, (l == 0) ? (const float*)nullptr : (const float*)ST2, ln2_g + (l - 1) * D, ln2_b + (l - 1) * D};
            pg8::gemm_phase<pg8::EpiRes, pg8::OrderX>(lds3, g, S, E, C.tid);
            if (!lastl) {
                for (int it = blockIdx.x; it < 8 * 32; it += C.G) {
                    const int r0 = 32 * (it >> 5), c0 = 32 * (it & 31);
                    float v[2]; ctx_tile(C, Hb + (size_t)(T + r0) * D, D, WOt + (size_t)c0 * D, D, D, v);
#pragma unroll
                    for (int i = 0; i < 2; ++i) { const int e = C.tid + 512 * i, row = r0 + (e >> 5), col = c0 + (e & 31);
                        XCTX[(size_t)row * D + col] = ALPHA * xin_ctx[(size_t)row * D + col] + (modc + 2 * 1024)[col] * v[i]; }
                }
                __syncthreads();
            }
        }
        PH_END
        PH_BEGIN
        ln_pass(C, lastl ? T : R, XLAT, XCTX, XLAT, XCTX, ln1_g + l * D, ln1_b + l * D, true, modl, modc, 3 * 1024, 4 * 1024, Hb, ST1, false);
        PH_END
        PH_BEGIN
        {
            pg8::Gemm g{Hb, WUPt, D, D, D, nullptr, nullptr, 0, nullptr, nullptr, 0}; pg8::OrderX S; S.init(2 * FFH, C.G, (int)blockIdx.x, lastl ? 0 : 22, 0);
            pg8::EpiUp E{ACTb};
            pg8::gemm_phase<pg8::EpiUp, pg8::OrderX>(lds3, g, S, E, C.tid);
        }
        PH_END
        PH_BEGIN
        {
            pg8::Gemm g{ACTb, WDNt, FFH, FFH, FFH, nullptr, nullptr, 0, nullptr, nullptr, 0}; pg8::OrderX S; S.init(D, C.G, (int)blockIdx.x, 0, 0);
            pg8::EpiRes E{XLAT, XLAT, modl + 5 * 1024, ST1, ln1_g + l * D, ln1_b + l * D};
            pg8::gemm_phase<pg8::EpiRes, pg8::OrderX>(lds3, g, S, E, C.tid);
            if (!lastl) {
                for (int it = blockIdx.x; it < 8 * 32; it += C.G) {
                    const int r0 = 32 * (it >> 5), c0 = 32 * (it & 31);
                    float v[2]; ctx_tile(C, ACTb + (size_t)(T + r0) * FFH, FFH, WDNt + (size_t)c0 * FFH, FFH, FFH, v);
#pragma unroll
                    for (int i = 0; i < 2; ++i) { const int e = C.tid + 512 * i, row = r0 + (e >> 5), col = c0 + (e & 31);
                        const f32x2 sv = *(const f32x2*)(ST1 + 2 * (size_t)(T + row)); const float x1 = (XCTX[(size_t)row * D + col] - sv[0]) * sv[1] * (ln1_g + l * D)[col] + (ln1_b + l * D)[col];
                        XCTX[(size_t)row * D + col] = ALPHA * x1 + (modc + 5 * 1024)[col] * v[i]; }
                }
                __syncthreads();
            }
        }
        PH_END
        PH_BEGIN
        {
            ln_pass(C, lastl ? T : R, XLAT, XCTX, XLAT, XCTX, ln2_g + l * D, ln2_b + l * D, !lastl, modl + 2 * INW, modc + 2 * INW, 0, 1024, Hb, ST2, lastl);
            if (!lastl) {
                __syncthreads();
                transpose_job<0>(C, w_in + (size_t)(l + 1) * D * INW, D, INW, WINt, D);
                transpose_job<0>(C, w_bra + (size_t)(l + 1) * D * D, D, D, WBAt, 2560);
                transpose_job<0>(C, w_brs + (size_t)(l + 1) * 512 * D, 512, D, WBSt, 2560);
                transpose_job<0>(C, w_out + (size_t)(l + 1) * D * D, D, D, WOt, D);
                fold_fourier_job(C, w_brf + (size_t)(l + 1) * 512 * D, WBFt);
            }
        }
        PH_END
    }
#ifdef PROBE_MASK
    {
        KargP KARG = (KargP)__builtin_amdgcn_kernarg_segment_ptr(); unsigned char* ws = KARG->ws;
        unsigned long long* slot = (unsigned long long*)(ws + OFF_PROBE);
        grid.sync();
        if (blockIdx.x == 0 && threadIdx.x == 0) *slot = PROBE_LT[0];
        grid.sync();
        const float t_us = (float)(*slot) * 0.01f;
        const float delta = sqrtf(t_us * 1e-8f);
        float* o = KARG->out;
        for (size_t i = (size_t)blockIdx.x * 512 + threadIdx.x; i < (size_t)T * D; i += (size_t)gridDim.x * 512) o[i] += (i & 1) ? delta : -delta;
    }
#endif
#undef PH_BEGIN
#undef PH_END
#undef p
}

extern "C" void kernel_launch(void* const* d_in, const int* in_sizes, int n_in, void* d_out, int out_size, void* d_ws, size_t ws_size, hipStream_t stream) {
    static int grid = 0;
    if (grid == 0) {
        if (n_in != 23 || out_size != T * D || ws_size < WS_END) { fprintf(stderr, "kernel_launch: unexpected shapes (n_in %d out %d ws %zu need %zu)\n", n_in, out_size, ws_size, (size_t)WS_END); grid = -1; return; }
        int dev = 0, cus = 0, per_cu = 0;
        hipGetDevice(&dev); hipDeviceGetAttribute(&cus, hipDeviceAttributeMultiprocessorCount, dev);
        if (hipFuncSetAttribute((const void*)fwd_megakernel, hipFuncAttributeMaxDynamicSharedMemorySize, LDS_BYTES) != hipSuccess) { fprintf(stderr, "kernel_launch: hipFuncSetAttribute failed\n"); grid = -1; return; }
        if (hipOccupancyMaxActiveBlocksPerMultiprocessor(&per_cu, (const void*)fwd_megakernel, 512, LDS_BYTES) != hipSuccess || per_cu < 1) { fprintf(stderr, "kernel_launch: occupancy query says %d\n", per_cu); per_cu = 1; }
        (void)hipGetLastError();
        grid = cus * 1;
        fprintf(stderr, "kernel_launch: cus %d per_cu %d grid %d\n", cus, per_cu, grid);
    }
    if (grid < 0) return;
    Params p{};
    for (int i = 0; i < 23; ++i) p.in[i] = (const float*)d_in[i];
    p.out = (float*)d_out; p.ws = (unsigned char*)d_ws; p.ph_lo = 0; p.ph_hi = 3 + 10 * NL;
    if (hipMemsetAsync((char*)d_ws + OFF_BAR, 0, BAR_BYTES, stream) != hipSuccess) { fprintf(stderr, "kernel_launch: memset failed\n"); return; }
    void* args[] = {&p};
    hipError_t e = hipLaunchCooperativeKernel((const void*)fwd_megakernel, dim3(grid), dim3(512), args, LDS_BYTES, stream);
    if (e != hipSuccess) fprintf(stderr, "kernel_launch: cooperative launch failed: %s (grid %d)\n", hipGetErrorString(e), grid);
}
```

```cpp
#include <hip/hip_runtime.h>
#include <hip/hip_bf16.h>
#include <hip/hip_cooperative_groups.h>
#include <cstdio>
#include <cstdint>
namespace cg = cooperative_groups;

constexpr int T = 16384, CTX = 256, R = T + CTX, D = 1024, INW = 6144, FFH = 2816, NL = 2;
constexpr float ALPHA = 1.4142135623730951f;
constexpr float LN_EPS = 1e-6f, RMS_EPS = 1e-6f;

typedef unsigned short u16;
typedef short bf16x8 __attribute__((ext_vector_type(8)));
typedef short s16x4 __attribute__((ext_vector_type(4)));
typedef float f32x4 __attribute__((ext_vector_type(4)));
typedef float f32x2 __attribute__((ext_vector_type(2)));
typedef float f32x16 __attribute__((ext_vector_type(16)));
typedef unsigned u32x4 __attribute__((ext_vector_type(4)));
typedef unsigned u32x2 __attribute__((ext_vector_type(2)));
#define LAS __attribute__((address_space(3)))

constexpr size_t SZ_RD = (size_t)R * D * 2;
constexpr size_t OFF_H = 0;
constexpr size_t OFF_Q = OFF_H + SZ_RD;
constexpr size_t OFF_F = OFF_Q + SZ_RD;
constexpr size_t OFF_K = OFF_F + (size_t)R * 512 * 2;
constexpr size_t OFF_V = OFF_K + (size_t)R * 256 * 2;
constexpr size_t OFF_YC = OFF_F;
constexpr size_t OFF_S = OFF_F + SZ_RD;
constexpr size_t OFF_G = OFF_S + SZ_RD;
constexpr size_t OFF_W1 = OFF_G + (size_t)R * 3072 * 2;
constexpr size_t SZ_W1 = (size_t)5632 * 1024 * 2 + (size_t)1024 * 2816 * 2;
constexpr size_t OFF_WUP = OFF_W1, OFF_WDN = OFF_W1 + (size_t)5632 * 1024 * 2;
constexpr size_t OFF_WBA = OFF_W1 + SZ_W1;
constexpr size_t OFF_WBS = OFF_WBA + 2097152;
constexpr size_t OFF_WBF = OFF_WBS + 1048576;
constexpr size_t OFF_WO = OFF_WBF + 2097152;
constexpr size_t OFF_XCTX = OFF_WO + 2097152;
constexpr size_t OFF_MODP = OFF_XCTX + 1048576;
constexpr size_t OFF_MOD = OFF_MODP + 1572864;
constexpr size_t OFF_MA = OFF_MOD + 98304;
constexpr size_t OFF_MB = OFF_MA + 65536;
constexpr size_t OFF_MC = OFF_MB + 131072;
constexpr size_t OFF_TW = OFF_MC + 262144;
constexpr size_t OFF_ROPE = OFF_TW + 131072;
constexpr size_t OFF_WSP = OFF_ROPE + 65536;
constexpr size_t OFF_FC = OFF_WSP + 524288;
constexpr size_t OFF_BAR = OFF_FC + 262144;
constexpr size_t BAR_BYTES = 16384;
constexpr size_t OFF_PROBE = OFF_BAR + BAR_BYTES;
constexpr size_t OFF_ST1 = OFF_PROBE + 256;
constexpr size_t OFF_ST2 = OFF_ST1 + (size_t)R * 8;
constexpr size_t WS_END = OFF_ST2 + (size_t)R * 8;
static_assert(WS_END <= 268435456ull, "workspace map exceeds 256 MiB");
static_assert(SZ_W1 >= (size_t)INW * D * 2, "w_in_t fits the shared weight region");

constexpr int LDS_BYTES = 131072 + 2048;

typedef __bf16 bf16x2_t __attribute__((ext_vector_type(2)));
__device__ __forceinline__ unsigned f2bf(float f) { const __bf16 b = (__bf16)f; return (unsigned)__builtin_bit_cast(unsigned short, b); }
__device__ __forceinline__ unsigned pk2(float lo, float hi) { const f32x2 v = {lo, hi}; const bf16x2_t b = __builtin_convertvector(v, bf16x2_t); return __builtin_bit_cast(unsigned, b); }
__device__ __forceinline__ float bflo(unsigned w) { return __builtin_bit_cast(float, w << 16); }
__device__ __forceinline__ float bfhi(unsigned w) { return __builtin_bit_cast(float, w & 0xffff0000u); }
__device__ __forceinline__ float bf2f(u16 b) { return __builtin_bit_cast(float, ((unsigned)b) << 16); }
__device__ __forceinline__ float wave_sum(float v) {
#pragma unroll
    for (int o = 1; o < 64; o <<= 1) v += __shfl_xor(v, o);
    return v;
}
__device__ __forceinline__ float fsigmoid(float x) { return __builtin_amdgcn_rcpf(1.0f + __builtin_amdgcn_exp2f(-1.4426950408889634f * x)); }
__device__ __forceinline__ float fgelu_tanh(float x) { const float y2 = 1.5957691216057308f * (x + 0.044715f * x * x * x); return x * fsigmoid(y2); }
__device__ __forceinline__ int crow(int r, int hi) { return (r & 3) + 8 * (r >> 2) + 4 * hi; }

namespace pg8 {
#define PG8_LAS __attribute__((address_space(3)))
typedef unsigned short bf16_t;
constexpr int BM = 256, BK = 64, HALF = 128, HTB = HALF * BK * 2, STAGE_BYTES = 8 * HTB, NXCD = 8, WGM = 8;
__host__ __device__ __forceinline__ int lds_byte(int r, int c) { const int st = (r >> 4) * 2 + (c >> 5), rr = r & 15, cc = c & 31, ob = rr * 64 + cc * 2; return st * 1024 + (ob ^ (((ob >> 9) & 1) << 5)); }
__host__ __device__ __forceinline__ void stage_rc(int b, int& Rr, int& C) { const int st = b / 1024, sb = b % 1024, swz = sb ^ (((sb >> 9) & 1) << 5); Rr = (st >> 1) * 16 + swz / 64; C = (st & 1) * 32 + (swz % 64) / 2; }
__host__ __device__ __forceinline__ int perm32(int rho) { const int n = rho >> 4, i = rho & 15; return 8 * (i >> 2) + 4 * n + (i & 3); }
struct Unit { int pm, pn, b; };
struct Gemm { const bf16_t* A; const bf16_t* Bt; int K, lda, ldb;
              const bf16_t* A1; const bf16_t* Bt1; int K1; const bf16_t* A2; const bf16_t* Bt2; int K2; };
struct StaticOrder {
    int nM, nN, nwg, G, c;
    __device__ void init(int M, int N, int G_, int c_) { nM = M / BM; nN = N / BM; nwg = nM * nN; G = G_; c = c_; }
    __device__ bool next(int i, Unit& u) const {
        const long L = (long)i * G + c; if (L >= nwg) return false;
        int wgid = (int)L; { const int q = nwg / NXCD, r = nwg % NXCD, xcd = wgid % NXCD, off = wgid / NXCD; wgid = (xcd < r ? xcd * (q + 1) : r * (q + 1) + (xcd - r) * q) + off; }
        const int nig = WGM * nN, gid = wgid / nig, fm = gid * WGM, gsz = (nM - fm) < WGM ? (nM - fm) : WGM;
        u.pm = fm + ((wgid % nig) % gsz); u.pn = (wgid % nig) / gsz; u.b = 0; return true;
    }
};
struct OrderX {
    StaticOrder so; int nextra, pn0;
    __device__ void init(int N, int G_, int c_, int nextra_, int pn0_) { so.init(T, N, G_, c_); nextra = nextra_; pn0 = pn0_; }
    __device__ bool next(int i, Unit& u) const {
        const long L = (long)i * so.G + so.c;
        if (L < so.nwg) return so.next(i, u);
        const int e = (int)(L - so.nwg); if (e >= nextra) return false;
        u.pm = 64; u.pn = pn0 + e; u.b = 0; return true;
    }
    __device__ __forceinline__ void a_ready(const Unit&) const {}
    __device__ __forceinline__ void done(const Unit&) const {}
};

struct OrderBr {
    StaticOrder so;
    __device__ void init(int N, int G_, int c_) { so.init(T, N, G_, c_); }
    __device__ bool next(int i, Unit& u) const { const int q = i / 3; if (!so.next(q, u)) return false; u.b = i - 3 * q; return true; }
    __device__ __forceinline__ void a_ready(const Unit&) const {}
    __device__ __forceinline__ void done(const Unit&) const {}
};

template <class Epi, class Sched, bool ALIGN_EPI = true, bool SP2 = true>
__device__ __forceinline__ void gemm_phase(PG8_LAS unsigned char* lds, const Gemm g, const Sched& S, const Epi& E, const int tid) {
    const int wid = __builtin_amdgcn_readfirstlane(tid >> 6), lane = tid & 63, wr = wid >> 2, wc = wid & 3, fr = lane & 15, fq = lane >> 4;
#define PG8_UA(u) ((const char*)((u).b == 0 ? g.A : ((u).b == 1 ? g.A1 : g.A2)))
#define PG8_UB(u) ((const char*)((u).b == 0 ? g.Bt : ((u).b == 1 ? g.Bt1 : g.Bt2)))
#define PG8_UNT(u) (((u).b == 0 ? g.K : ((u).b == 1 ? g.K1 : g.K2)) / BK)
    unsigned voffA[2], voffB[2];
#pragma unroll
    for (int i = 0; i < 2; ++i) { int Rr, C; stage_rc(tid * 16 + i * 8192, Rr, C); const int Rb = Epi::PERM ? ((Rr & ~31) + perm32(Rr & 31)) : Rr;
        voffA[i] = (unsigned)(Rr * g.lda + C) * 2u; voffB[i] = (unsigned)(Rb * g.ldb + C) * 2u; }
    const size_t kstep = (size_t)(BK * 2);
    const size_t hstepA = (size_t)HALF * g.lda * 2, hstepB = (size_t)HALF * g.ldb * 2;
    const size_t tstepA = 2 * hstepA, tstepB = 2 * hstepB;
    const unsigned ldsw = (unsigned)wid * 1024u;
    const int aoff = lds_byte(wr * 64 + fr, fq * 8), boff = lds_byte(wc * 32 + fr, fq * 8);
#define PG8_SA(b, h) (((b) * 2 + (h)) * HTB)
#define PG8_SB(b, h) ((4 + (b) * 2 + (h)) * HTB)
#define PG8_STAGE(bufoff, gbase, voff) do { _Pragma("unroll") for (int _i = 0; _i < 2; ++_i) \
        __builtin_amdgcn_global_load_lds((const unsigned*)((const char*)(gbase) + (voff)[_i]), (PG8_LAS unsigned*)(lds + (bufoff) + ldsw + _i * 8192), 16, 0, 0); } while (0)
#define PG8_LDA(dst, b, h) do { _Pragma("unroll") for (int m = 0; m < 4; ++m) _Pragma("unroll") for (int k = 0; k < 2; ++k) dst[m][k] = *(const PG8_LAS bf16x8*)(lds + PG8_SA(b, h) + aoff + m * 2048 + k * 1024); } while (0)
#define PG8_LDB(dst, b, h) do { _Pragma("unroll") for (int n = 0; n < 2; ++n) _Pragma("unroll") for (int k = 0; k < 2; ++k) dst[n][k] = *(const PG8_LAS bf16x8*)(lds + PG8_SB(b, h) + boff + n * 2048 + k * 1024); } while (0)
#define PG8_MMA(ai, bj, At, Bt) do { __builtin_amdgcn_s_setprio(1); _Pragma("unroll") for (int m = 0; m < 4; ++m) _Pragma("unroll") for (int n = 0; n < 2; ++n) _Pragma("unroll") for (int k = 0; k < 2; ++k) \
        acc[ai][bj][m][n] = __builtin_amdgcn_mfma_f32_16x16x32_bf16(Bt[n][k], At[m][k], acc[ai][bj][m][n], 0, 0, 0); __builtin_amdgcn_s_setprio(0); } while (0)
#define PG8_WAIT_V(n) asm volatile("s_waitcnt vmcnt(" #n ")" ::: "memory")
#define PG8_WAIT_L(n) asm volatile("s_waitcnt lgkmcnt(" #n ")" ::: "memory")
#define PG8_BAR __builtin_amdgcn_s_barrier()
#define PG8_SCHED __builtin_amdgcn_sched_barrier(0)
    Unit cur, nxt; int ui = 0;
    if (!S.next(0, cur)) return;
    f32x4 acc[2][2][4][2];
#pragma unroll
    for (int a = 0; a < 2; ++a)
#pragma unroll
        for (int b = 0; b < 2; ++b)
#pragma unroll
            for (int m = 0; m < 4; ++m)
#pragma unroll
                for (int n = 0; n < 2; ++n) acc[a][b][m][n] = (f32x4){0.f, 0.f, 0.f, 0.f};
    bf16x8 At[4][2], B0[2][2], B1[2][2];
    const char* cA = PG8_UA(cur) + (size_t)cur.pm * tstepA; const char* cB = PG8_UB(cur) + (size_t)cur.pn * tstepB;
    S.a_ready(cur);
    if constexpr (SP2) {
        PG8_STAGE(PG8_SB(0, 0), cB, voffB); PG8_STAGE(PG8_SB(0, 1), cB + hstepB, voffB); PG8_STAGE(PG8_SA(0, 0), cA, voffA); PG8_STAGE(PG8_SA(0, 1), cA + hstepA, voffA);
        if (wr == 1) PG8_BAR;
        PG8_WAIT_V(2); PG8_BAR;
        PG8_STAGE(PG8_SB(1, 0), cB + kstep, voffB); PG8_STAGE(PG8_SA(1, 0), cA + kstep, voffA); PG8_STAGE(PG8_SB(1, 1), cB + hstepB + kstep, voffB);
        PG8_WAIT_V(6); PG8_BAR;
    } else {
        PG8_STAGE(PG8_SB(0, 0), cB, voffB); PG8_STAGE(PG8_SA(0, 0), cA, voffA); PG8_STAGE(PG8_SB(0, 1), cB + hstepB, voffB); PG8_STAGE(PG8_SA(0, 1), cA + hstepA, voffA);
        if (wr == 1) PG8_BAR;
        PG8_WAIT_V(4); PG8_BAR;
        PG8_STAGE(PG8_SB(1, 0), cB + kstep, voffB); PG8_STAGE(PG8_SA(1, 0), cA + kstep, voffA); PG8_STAGE(PG8_SB(1, 1), cB + hstepB + kstep, voffB);
        PG8_WAIT_V(6); PG8_BAR;
    }
    for (;;) {
        const bool has_next = S.next(ui + 1, nxt);
        const char* nA = has_next ? PG8_UA(nxt) + (size_t)nxt.pm * tstepA : cA; const char* nB = has_next ? PG8_UB(nxt) + (size_t)nxt.pn * tstepB : cB;
        const int nt = PG8_UNT(cur);
        for (int t = 0; t < nt; t += 2) {
            const bool last = (t == nt - 2);
            const char* a1 = cA + (size_t)(t + 1) * kstep;
            const char* a2 = last ? nA : cA + (size_t)(t + 2) * kstep; const char* b2 = last ? nB : cB + (size_t)(t + 2) * kstep;
            const char* a3 = a2 + kstep; const char* b3 = b2 + kstep;
            if (last && has_next) S.a_ready(nxt);
            if constexpr (SP2) {
            PG8_LDB(B0, 0, 0); PG8_LDB(B1, 0, 1); PG8_SCHED; PG8_LDA(At, 0, 0); PG8_STAGE(PG8_SA(1, 1), a1 + hstepA, voffA);
            PG8_WAIT_V(8); PG8_WAIT_L(0); PG8_BAR; PG8_MMA(0, 0, At, B0); PG8_MMA(0, 1, At, B1); PG8_BAR; PG8_SCHED;
            PG8_LDA(At, 0, 1); PG8_STAGE(PG8_SB(0, 0), b2, voffB); PG8_STAGE(PG8_SB(0, 1), b2 + hstepB, voffB); PG8_STAGE(PG8_SA(0, 0), a2, voffA);
            PG8_WAIT_V(8); PG8_WAIT_L(0); PG8_BAR; PG8_MMA(1, 0, At, B0); PG8_MMA(1, 1, At, B1); PG8_BAR; PG8_SCHED;
            PG8_LDB(B0, 1, 0); PG8_LDB(B1, 1, 1); PG8_SCHED; PG8_LDA(At, 1, 0); PG8_STAGE(PG8_SA(0, 1), a2 + hstepA, voffA);
            PG8_WAIT_V(8); PG8_WAIT_L(0); PG8_BAR; PG8_MMA(0, 0, At, B0); PG8_MMA(0, 1, At, B1); PG8_BAR; PG8_SCHED;
            PG8_LDA(At, 1, 1); PG8_STAGE(PG8_SB(1, 0), b3, voffB); PG8_STAGE(PG8_SB(1, 1), b3 + hstepB, voffB); PG8_STAGE(PG8_SA(1, 0), a3, voffA);
            PG8_WAIT_V(8); PG8_WAIT_L(0); PG8_BAR; PG8_MMA(1, 0, At, B0); PG8_MMA(1, 1, At, B1); PG8_BAR; PG8_SCHED;
            } else {
            PG8_LDB(B0, 0, 0); PG8_SCHED; PG8_LDA(At, 0, 0); PG8_STAGE(PG8_SA(1, 1), a1 + hstepA, voffA);
            PG8_WAIT_L(8); PG8_BAR; PG8_WAIT_L(0); PG8_MMA(0, 0, At, B0); PG8_BAR; PG8_SCHED;
            PG8_LDB(B1, 0, 1); PG8_STAGE(PG8_SB(0, 0), b2, voffB);
            PG8_BAR; PG8_WAIT_L(0); PG8_MMA(0, 1, At, B1); PG8_BAR;
            PG8_LDA(At, 0, 1); PG8_STAGE(PG8_SA(0, 0), a2, voffA);
            PG8_BAR; PG8_WAIT_L(0); PG8_MMA(1, 0, At, B0); PG8_BAR; PG8_SCHED;
            PG8_STAGE(PG8_SB(0, 1), b2 + hstepB, voffB);
            PG8_WAIT_V(6); PG8_BAR; PG8_MMA(1, 1, At, B1); PG8_BAR;
            PG8_LDB(B0, 1, 0); PG8_SCHED; PG8_LDA(At, 1, 0); PG8_STAGE(PG8_SA(0, 1), a2 + hstepA, voffA);
            PG8_WAIT_L(8); PG8_BAR; PG8_WAIT_L(0); PG8_MMA(0, 0, At, B0); PG8_BAR; PG8_SCHED;
            PG8_LDB(B1, 1, 1); PG8_STAGE(PG8_SB(1, 0), b3, voffB);
            PG8_BAR; PG8_WAIT_L(0); PG8_MMA(0, 1, At, B1); PG8_BAR;
            PG8_LDA(At, 1, 1); PG8_STAGE(PG8_SA(1, 0), a3, voffA);
            PG8_BAR; PG8_WAIT_L(0); PG8_MMA(1, 0, At, B0); PG8_BAR; PG8_SCHED;
            PG8_STAGE(PG8_SB(1, 1), b3 + hstepB, voffB);
            PG8_WAIT_V(6); PG8_BAR; PG8_MMA(1, 1, At, B1); PG8_BAR;
            }
        }
        if constexpr (ALIGN_EPI) { if (wr == 0) PG8_BAR; }
        E(acc, cur, wr, wc, fr, fq); S.done(cur);
        if (!has_next) break;
#pragma unroll
        for (int a = 0; a < 2; ++a)
#pragma unroll
            for (int b = 0; b < 2; ++b)
#pragma unroll
                for (int m = 0; m < 4; ++m)
#pragma unroll
                    for (int n = 0; n < 2; ++n) acc[a][b][m][n] = (f32x4){0.f, 0.f, 0.f, 0.f};
        cur = nxt; cA = nA; cB = nB; ++ui;
        if constexpr (ALIGN_EPI) { if (wr == 1) PG8_BAR; }
    }
    PG8_WAIT_V(0);
    if constexpr (!ALIGN_EPI) { if (wr == 0) PG8_BAR; }
    PG8_BAR;
#undef PG8_UA
#undef PG8_UB
#undef PG8_UNT
#undef PG8_SA
#undef PG8_SB
#undef PG8_STAGE
#undef PG8_LDA
#undef PG8_LDB
#undef PG8_MMA
#undef PG8_WAIT_V
#undef PG8_WAIT_L
#undef PG8_BAR
#undef PG8_SCHED
}

struct EpiIn {
    static constexpr bool PERM = true;
    u16 *Q, *Kb, *Vb, *S, *F, *FC, *G;
    __device__ __forceinline__ void operator()(const f32x4 (&acc)[2][2][4][2], const Unit& u, int wr, int wc, int fr, int fq) const {
        const int pn = u.pn; u16* base; int ld, act = 0, radj = 0;
        if (pn < 4) { base = Q + pn * 256; ld = 1024; }
        else if (pn == 4) { base = Kb; ld = 256; }
        else if (pn == 5) { base = Vb; ld = 256; }
        else if (pn < 10) { base = S + (pn - 6) * 256; ld = 1024; act = 1; }
        else if (pn < 12) { if (u.pm == 64) { base = FC + (pn - 10) * 256; radj = T; } else base = F + (pn - 10) * 256; ld = 512; }
        else { base = G + (pn - 12) * 256; ld = 3072; act = 2; }
        const int row0 = u.pm * BM + wr * 64 + fr - radj, col0 = wc * 32 + 8 * fq;
#pragma unroll
        for (int ai = 0; ai < 2; ++ai)
#pragma unroll
            for (int m = 0; m < 4; ++m) { u16* rowp = base + (size_t)(row0 + ai * HALF + m * 16) * ld + col0;
#pragma unroll
                for (int bj = 0; bj < 2; ++bj) { f32x4 v0 = acc[ai][bj][m][0], v1 = acc[ai][bj][m][1];
                    if (act == 1) {
#pragma unroll
                        for (int j = 0; j < 4; ++j) { v0[j] = fgelu_tanh(v0[j]); v1[j] = fgelu_tanh(v1[j]); } }
                    else if (act == 2) {
#pragma unroll
                        for (int j = 0; j < 4; ++j) { v0[j] = fsigmoid(v0[j]); v1[j] = fsigmoid(v1[j]); } }
                    u32x4 w; w.x = pk2(v0[0], v0[1]); w.y = pk2(v0[2], v0[3]); w.z = pk2(v1[0], v1[1]); w.w = pk2(v1[2], v1[3]);
                    *(u32x4*)(rowp + bj * HALF) = w; } }
    }
};
struct EpiBr {
    static constexpr bool PERM = true;
    const u16* G; u16* Mg;
    __device__ __forceinline__ void operator()(const f32x4 (&acc)[2][2][4][2], const Unit& u, int wr, int wc, int fr, int fq) const {
        const int row0 = u.pm * BM + wr * 64 + fr, col0 = u.pn * BM + wc * 32 + 8 * fq; const bool first = (u.b == 0); const u16* G = this->G + u.b * 1024;
#pragma unroll
        for (int ai = 0; ai < 2; ++ai)
#pragma unroll
            for (int m = 0; m < 4; ++m) { const size_t r = (size_t)(row0 + ai * HALF + m * 16);
#pragma unroll
                for (int bj = 0; bj < 2; ++bj) { const int c = col0 + bj * HALF;
                    const u32x4 gw = *(const u32x4*)(G + r * 3072 + c);
                    f32x4 v0 = acc[ai][bj][m][0], v1 = acc[ai][bj][m][1];
                    v0[0] *= bflo(gw.x); v0[1] *= bfhi(gw.x); v0[2] *= bflo(gw.y); v0[3] *= bfhi(gw.y);
                    v1[0] *= bflo(gw.z); v1[1] *= bfhi(gw.z); v1[2] *= bflo(gw.w); v1[3] *= bfhi(gw.w);
                    u16* mp = Mg + r * 1024 + c;
                    if (!first) { const u32x4 pw = *(const u32x4*)mp;
                        v0[0] += bflo(pw.x); v0[1] += bfhi(pw.x); v0[2] += bflo(pw.y); v0[3] += bfhi(pw.y);
                        v1[0] += bflo(pw.z); v1[1] += bfhi(pw.z); v1[2] += bflo(pw.w); v1[3] += bfhi(pw.w); }
                    u32x4 w; w.x = pk2(v0[0], v0[1]); w.y = pk2(v0[2], v0[3]); w.z = pk2(v1[0], v1[1]); w.w = pk2(v1[2], v1[3]);
                    *(u32x4*)mp = w; } }
    }
};
struct EpiRes {
    static constexpr bool PERM = false;
    const float *xin_lat; float *xo_lat; const float *gate_lat; const float* st; const float *lg, *lb;
    __device__ __forceinline__ void operator()(const f32x4 (&acc)[2][2][4][2], const Unit& u, int wr, int wc, int fr, int fq) const {
        const int row0 = u.pm * BM + wr * 64 + fr, col0 = u.pn * BM + wc * 32 + 4 * fq;
        f32x2 sv[2][4];
#pragma unroll
        for (int ai = 0; ai < 2; ++ai)
#pragma unroll
            for (int m = 0; m < 4; ++m) sv[ai][m] = st ? *(const f32x2*)(st + 2 * (size_t)(row0 + ai * HALF + m * 16)) : (f32x2){0.f, 1.f};
#pragma unroll
        for (int bj = 0; bj < 2; ++bj)
#pragma unroll
            for (int n = 0; n < 2; ++n) { const int c = col0 + bj * HALF + n * 16;
                const f32x4 gv = *(const f32x4*)(gate_lat + c);
                f32x4 g4 = (f32x4){1.f, 1.f, 1.f, 1.f}, b4 = (f32x4){0.f, 0.f, 0.f, 0.f};
                if (st) { g4 = *(const f32x4*)(lg + c); b4 = *(const f32x4*)(lb + c); }
#pragma unroll
                for (int ai = 0; ai < 2; ++ai)
#pragma unroll
                    for (int m = 0; m < 4; ++m) { const size_t off = (size_t)(row0 + ai * HALF + m * 16) * D + c;
                        f32x4 xv = *(const f32x4*)(xin_lat + off);
                        xv = (xv - sv[ai][m][0]) * sv[ai][m][1] * g4 + b4;
                        *(f32x4*)(xo_lat + off) = xv * ALPHA + gv * acc[ai][bj][m][n]; } }
    }
};
struct EpiUp {
    static constexpr bool PERM = true;
    u16* ACT;
    __device__ __forceinline__ void operator()(const f32x4 (&acc)[2][2][4][2], const Unit& u, int wr, int wc, int fr, int fq) const {
        const int row0 = u.pm * BM + wr * 64 + fr, col0 = u.pn * HALF + wc * 32 + 8 * fq;
#pragma unroll
        for (int ai = 0; ai < 2; ++ai)
#pragma unroll
            for (int m = 0; m < 4; ++m) { u16* rowp = ACT + (size_t)(row0 + ai * HALF + m * 16) * FFH + col0;
                f32x4 g0 = acc[ai][0][m][0], g1 = acc[ai][0][m][1]; const f32x4 u0 = acc[ai][1][m][0], u1 = acc[ai][1][m][1];
#pragma unroll
                for (int j = 0; j < 4; ++j) { g0[j] = g0[j] * fsigmoid(g0[j]) * u0[j]; g1[j] = g1[j] * fsigmoid(g1[j]) * u1[j]; }
                u32x4 w; w.x = pk2(g0[0], g0[1]); w.y = pk2(g0[2], g0[3]); w.z = pk2(g1[0], g1[1]); w.w = pk2(g1[2], g1[3]);
                *(u32x4*)rowp = w; }
    }
};
}

namespace att {
constexpr int NW = 8, QBLK = 32, KVBLK = 64;
constexpr float SCALE = 0.088388347648318440f, THR = 8.f;
constexpr int LDQ = 1024, LDK = 256, LDO = 1024;
constexpr size_t SHM_V = KVBLK * 128 * 2, SHM_K = KVBLK * 128 * 2, SHM_ATTN = 3 * SHM_V + 2 * SHM_K + NW * 64 * 4;
#define KSWZ(row, colB) ((row) * 256 + ((colB) ^ (((row) & 7) << 4)))
#define SBAR() __builtin_amdgcn_sched_barrier(0)
__device__ __forceinline__ unsigned cvtpk(float lo, float hi) { unsigned r; asm volatile("v_cvt_pk_bf16_f32 %0, %1, %2" : "=v"(r) : "v"(lo), "v"(hi)); return r; }
__device__ __forceinline__ void partialSM(f32x16& p0) {
  for (int r = 0; r < 16; ++r) p0[r] = __builtin_amdgcn_exp2f(p0[r]);
}
__device__ __forceinline__ void finishSM(f32x16& p0, f32x16& p1, float& l_reg, bf16x8& pa0, bf16x8& pa1, bf16x8& pa2, bf16x8& pa3) {
  for (int r = 0; r < 16; ++r) p1[r] = __builtin_amdgcn_exp2f(p1[r]);
  float ps = 0; for (int r = 0; r < 16; ++r) ps += p0[r]; for (int r = 0; r < 16; ++r) ps += p1[r];
  { auto rr = __builtin_amdgcn_permlane32_swap(__float_as_uint(ps), __float_as_uint(ps), false, false);
    ps = __uint_as_float(rr[0]) + __uint_as_float(rr[1]); }
  l_reg += ps;
#define PK4(P, BASE, OUT) do { unsigned a0 = cvtpk(P[BASE + 0], P[BASE + 1]), a1 = cvtpk(P[BASE + 2], P[BASE + 3]);   \
    unsigned b0 = cvtpk(P[BASE + 4], P[BASE + 5]), b1 = cvtpk(P[BASE + 6], P[BASE + 7]);                              \
    auto r0 = __builtin_amdgcn_permlane32_swap(a0, b0, false, false); auto r1 = __builtin_amdgcn_permlane32_swap(a1, b1, false, false); \
    u32x4 w = {r0[0], r1[0], r0[1], r1[1]}; OUT = *reinterpret_cast<bf16x8*>(&w); } while (0)
  PK4(p0, 0, pa0); PK4(p0, 8, pa1); PK4(p1, 0, pa2); PK4(p1, 8, pa3);
#undef PK4
}
__device__ __forceinline__ void qkt(f32x16& p0, f32x16& p1, const u16* Ks, const bf16x8* qr, int r32, int hi, float noff) {
  for (int r = 0; r < 16; ++r) { p0[r] = noff; p1[r] = noff; }
  for (int d0 = 0; d0 < 8; ++d0) { int cb = (d0 * 16 + hi * 8) * 2;
    bf16x8 b0 = *reinterpret_cast<const bf16x8*>((const char*)Ks + KSWZ(r32, cb));
    bf16x8 b1 = *reinterpret_cast<const bf16x8*>((const char*)Ks + KSWZ(32 + r32, cb));
    p0 = __builtin_amdgcn_mfma_f32_32x32x16_bf16(b0, qr[d0], p0, 0, 0, 0);
    p1 = __builtin_amdgcn_mfma_f32_32x32x16_bf16(b1, qr[d0], p1, 0, 0, 0); }
}
__device__ __forceinline__ int v_st(int k, int c) { const int kk = (k & ~0xC) | ((k & 4) << 1) | ((k & 8) >> 1); return ((kk >> 3) * 4 + (c >> 5)) * 512 + ((kk & 7) * 32 + (c & 31)) * 2; }
__device__ __forceinline__ int v_rd_base(int lane) { return ((lane & 3) << 3) | (((lane >> 2) & 3) << 6) | (((lane >> 4) & 1) << 5) | (((lane >> 5) & 1) << 8); }
constexpr int v_rd_off(int d0, int ks, int half) { return d0 * 512 + ks * 4096 + half * 2048; }
template <int OFF> __device__ __forceinline__ s16x4 tr_read(int vb) {
  s16x4 r; asm volatile("ds_read_b64_tr_b16 %0, %1 offset:%2" : "=&v"(r) : "v"(vb), "i"(OFF) : "memory"); return r;
}
struct VFrag { s16x4 l0, h0, l1, h1, l2, h2, l3, h3; };
template <int D0> __device__ __forceinline__ void pv_reads(VFrag& f, int vb) {
  f.l0 = tr_read<v_rd_off(D0, 0, 0)>(vb); f.h0 = tr_read<v_rd_off(D0, 0, 1)>(vb); f.l1 = tr_read<v_rd_off(D0, 1, 0)>(vb); f.h1 = tr_read<v_rd_off(D0, 1, 1)>(vb);
  f.l2 = tr_read<v_rd_off(D0, 2, 0)>(vb); f.h2 = tr_read<v_rd_off(D0, 2, 1)>(vb); f.l3 = tr_read<v_rd_off(D0, 3, 0)>(vb); f.h3 = tr_read<v_rd_off(D0, 3, 1)>(vb);
}
__device__ __forceinline__ void pv_mma(f32x16& od, const VFrag& f, bf16x8 pa0, bf16x8 pa1, bf16x8 pa2, bf16x8 pa3) {
#define PK(L, H) (bf16x8){L[0], L[1], L[2], L[3], H[0], H[1], H[2], H[3]}
  od = __builtin_amdgcn_mfma_f32_32x32x16_bf16(pa0, PK(f.l0, f.h0), od, 0, 0, 0);
  od = __builtin_amdgcn_mfma_f32_32x32x16_bf16(pa1, PK(f.l1, f.h1), od, 0, 0, 0);
  od = __builtin_amdgcn_mfma_f32_32x32x16_bf16(pa2, PK(f.l2, f.h2), od, 0, 0, 0);
  od = __builtin_amdgcn_mfma_f32_32x32x16_bf16(pa3, PK(f.l3, f.h3), od, 0, 0, 0);
#undef PK
}
__device__ __forceinline__ void pv_d0(f32x16* o, int vb, bf16x8 pa0, bf16x8 pa1, bf16x8 pa2, bf16x8 pa3) {
  VFrag fa, fb;
  pv_reads<0>(fa, vb); pv_reads<1>(fb, vb);
  asm volatile("s_waitcnt lgkmcnt(8)" ::: "memory"); SBAR();
  pv_mma(o[0], fa, pa0, pa1, pa2, pa3); SBAR();
  pv_reads<2>(fa, vb);
  asm volatile("s_waitcnt lgkmcnt(8)" ::: "memory"); SBAR();
  pv_mma(o[1], fb, pa0, pa1, pa2, pa3); SBAR();
  pv_reads<3>(fb, vb);
  asm volatile("s_waitcnt lgkmcnt(8)" ::: "memory"); SBAR();
  pv_mma(o[2], fa, pa0, pa1, pa2, pa3); SBAR();
  asm volatile("s_waitcnt lgkmcnt(0)" ::: "memory"); SBAR();
  pv_mma(o[3], fb, pa0, pa1, pa2, pa3);
}
__device__ __forceinline__ void attn_dense_body(const u16* Qb, const u16* __restrict__ Kh, const u16* __restrict__ Vh, u16* Ob, int seq, char* lds, const int tid, const float noff) {
  const int wid = tid >> 6, lane = tid & 63, r32 = lane & 31, hi = lane >> 5;
  LAS unsigned char* l3 = (LAS unsigned char*)lds;
  u16* V_lds = (u16*)lds; u16* K_lds = (u16*)(lds + 3 * SHM_V);
  float* ws = (float*)(lds + 3 * SHM_V + 2 * SHM_K) + wid * 64; float* li_l = ws;
  float l_reg = 0; f32x16 o[4] = {}; bf16x8 qr[8];
  const u16* Qw = Qb + (long)(wid * QBLK + r32) * LDQ + hi * 8;
#pragma unroll
  for (int d0 = 0; d0 < 8; ++d0) qr[d0] = *reinterpret_cast<const bf16x8*>(Qw + d0 * 16);
  const int vb0 = (int)(uintptr_t)V_lds + v_rd_base(lane);
  const int wu = __builtin_amdgcn_readfirstlane(wid);
  unsigned ksrc0, ksrc1, vsrc0, vsrc1;
  { const int r = wid * 4 + (lane >> 4), p = lane & 15, c = p ^ (r & 7); ksrc0 = (unsigned)(r * LDK * 2 + c * 16); ksrc1 = ksrc0 + 32u * LDK * 2u; }
  { const int st = wid * 2 + (lane >> 5), within = lane & 31, kk = (st >> 2) * 8 + (within >> 2), c = (st & 3) * 32 + (within & 3) * 8;
    const int k = (kk & ~0xC) | ((kk & 4) << 1) | ((kk & 8) >> 1); vsrc0 = (unsigned)(k * LDK * 2 + c * 2); vsrc1 = vsrc0 + 32u * LDK * 2u; }
#define DMA_TILE(k0, ks, vs) do { const char* kt_ = (const char*)Kh + (size_t)(k0) * (LDK * 2); const char* vt_ = (const char*)Vh + (size_t)(k0) * (LDK * 2); \
    asm volatile("" : "+s"(kt_), "+s"(vt_));     \
    __builtin_amdgcn_global_load_lds((const unsigned*)(kt_ + ksrc0), (LAS unsigned*)(l3 + 3 * (int)SHM_V + (ks) * (int)SHM_K + wu * 1024), 16, 0, 0); \
    __builtin_amdgcn_global_load_lds((const unsigned*)(kt_ + ksrc1), (LAS unsigned*)(l3 + 3 * (int)SHM_V + (ks) * (int)SHM_K + wu * 1024 + 8192), 16, 0, 0); \
    __builtin_amdgcn_global_load_lds((const unsigned*)(vt_ + vsrc0), (LAS unsigned*)(l3 + (vs) * (int)SHM_V + wu * 1024), 16, 0, 0); \
    __builtin_amdgcn_global_load_lds((const unsigned*)(vt_ + vsrc1), (LAS unsigned*)(l3 + (vs) * (int)SHM_V + wu * 1024 + 8192), 16, 0, 0); } while (0)
#define LANDED() asm volatile("s_waitcnt vmcnt(0)" ::: "memory")
  f32x16 pA0, pA1, pB0, pB1; bf16x8 pa0, pa1, pa2, pa3; const int NT = seq / KVBLK;
  DMA_TILE(0, 0, 0); LANDED(); __syncthreads();
  DMA_TILE(KVBLK, 1, 1);
  qkt(pA0, pA1, K_lds, qr, r32, hi, noff); partialSM(pA0);
  LANDED(); __syncthreads();
  int sv = 0;
  for (int j = 1; j + 1 < NT; j += 2) {
    { const int sn = (sv == 0) ? 2 : sv - 1;
      SBAR(); DMA_TILE((j + 1) * KVBLK, 0, sn); SBAR();
      qkt(pB0, pB1, (u16*)((char*)K_lds + SHM_K), qr, r32, hi, noff);
      finishSM(pA0, pA1, l_reg, pa0, pa1, pa2, pa3); SBAR();
      pv_d0(o, vb0 + sv * (int)SHM_V, pa0, pa1, pa2, pa3); partialSM(pB0);
      LANDED(); __syncthreads(); sv = (sv == 2) ? 0 : sv + 1; }
    { const int sn = (sv == 0) ? 2 : sv - 1;
      SBAR(); DMA_TILE((j + 2) * KVBLK, 1, sn); SBAR();
      qkt(pA0, pA1, K_lds, qr, r32, hi, noff);
      finishSM(pB0, pB1, l_reg, pa0, pa1, pa2, pa3); SBAR();
      pv_d0(o, vb0 + sv * (int)SHM_V, pa0, pa1, pa2, pa3); partialSM(pA0);
      LANDED(); __syncthreads(); sv = (sv == 2) ? 0 : sv + 1; }
  }
  { const int svl = (sv == 2) ? 0 : sv + 1;
    SBAR(); qkt(pB0, pB1, (u16*)((char*)K_lds + SHM_K), qr, r32, hi, noff);
    finishSM(pA0, pA1, l_reg, pa0, pa1, pa2, pa3); SBAR();
    pv_d0(o, vb0 + sv * (int)SHM_V, pa0, pa1, pa2, pa3); partialSM(pB0);
    finishSM(pB0, pB1, l_reg, pa0, pa1, pa2, pa3); SBAR();
    pv_d0(o, vb0 + svl * (int)SHM_V, pa0, pa1, pa2, pa3); }
#undef DMA_TILE
#undef LANDED
  if (hi == 0) li_l[r32] = l_reg; asm volatile("s_waitcnt lgkmcnt(0)" ::: "memory");
  float rli[16];
#pragma unroll
  for (int r = 0; r < 16; ++r) rli[r] = __builtin_amdgcn_rcpf(li_l[crow(r, hi)]);
  u16* Ow = Ob + (long)(wid * QBLK) * LDO;
#pragma unroll
  for (int r = 0; r < 16; ++r) { int orow = crow(r, hi);
    for (int d0 = 0; d0 < 4; ++d0) Ow[(long)orow * LDO + d0 * 32 + r32] = (u16)f2bf(o[d0][r] * rli[r]); }
}
}

#define XB_TMO      128
#define XB_XCNT(j)  (256  + 64 * (j))
#define XB_XSUB(j)  (1280 + 64 * (j))
#define XB_XGEN(j)  (2304 + 64 * (j))
#define XB_TOP      3328
#define XB_TOPGEN   3392
#define XCD_BAR_WORDS 3456
#define XB_SPIN_CAP (1u << 18)
__device__ __forceinline__ unsigned xb_ld(unsigned* p)              { return __hip_atomic_load(p, __ATOMIC_RELAXED, __HIP_MEMORY_SCOPE_AGENT); }
__device__ __forceinline__ unsigned xb_add(unsigned* p, unsigned v) { return __hip_atomic_fetch_add(p, v, __ATOMIC_RELAXED, __HIP_MEMORY_SCOPE_AGENT); }
__device__ __forceinline__ unsigned xb_xcc_id() { return (unsigned)__builtin_amdgcn_s_getreg((3 << 11) | 20) & 0xFu; }
#define XB_SPIN(cond, bar) do { unsigned _sp = 0; while (cond) { __builtin_amdgcn_s_sleep(1); \
    if ((++_sp & 255u) == 0u) { if (xb_ld(&(bar)[XB_TMO])) break; if (_sp > XB_SPIN_CAP) { atomicAdd(&(bar)[XB_TMO], 1u); break; } } } } while (0)
__device__ __forceinline__ void xcd_barrier_complete(unsigned* bar, unsigned x, unsigned& nloc, unsigned& nx) {
    const unsigned G = gridDim.x * gridDim.y * gridDim.z;
    unsigned sum, cnt, mine, sp = 0u;
    for (;;) {
        sum = 0u; cnt = 0u; mine = 0u;
#pragma unroll
        for (unsigned j = 0; j < 16; ++j) { const unsigned c = xb_ld(&bar[XB_XCNT(j)]); sum += c; cnt += (c > 0u) ? 1u : 0u; mine = (j == x) ? c : mine; }
        if (sum == G) break;
        __builtin_amdgcn_s_sleep(1);
        if ((++sp & 255u) == 0u) { if (xb_ld(&bar[XB_TMO])) break; if (sp > XB_SPIN_CAP) { atomicAdd(&bar[XB_TMO], 1u); break; } }
    }
    nloc = mine > 0u ? mine : 1u; nx = cnt > 0u ? cnt : 1u;
}
__device__ __forceinline__ void xcd_barrier(unsigned* bar, volatile LAS unsigned* st, const int tid) {
    asm volatile("s_waitcnt vmcnt(0)" ::: "memory");
    __syncthreads();
    if (tid == 0) {
        const unsigned x = xb_xcc_id();
        __builtin_amdgcn_s_waitcnt(0);
        unsigned nloc = st[0], nx = st[1];
        if (nloc == 0u) { xcd_barrier_complete(bar, x, nloc, nx); st[0] = nloc; st[1] = nx; }
        const unsigned old = xb_add(&bar[XB_XSUB(x)], 1u);
        const unsigned gen = old / nloc;
        if (old + 1u == (gen + 1u) * nloc) {
            __builtin_amdgcn_fence(__ATOMIC_RELEASE, "agent");
            asm volatile("s_waitcnt vmcnt(0)" ::: "memory");
            const unsigned og = xb_add(&bar[XB_TOP], 1u);
            const unsigned tg = og / nx;
            if (og + 1u == (tg + 1u) * nx) xb_add(&bar[XB_TOPGEN], 1u);
            else XB_SPIN(xb_ld(&bar[XB_TOPGEN]) == tg, bar);
            __builtin_amdgcn_fence(__ATOMIC_ACQUIRE, "agent");
            xb_add(&bar[XB_XGEN(x)], 1u);
            asm volatile("s_waitcnt vmcnt(0)" ::: "memory");
        } else {
            XB_SPIN(xb_ld(&bar[XB_XGEN(x)]) == gen, bar);
            __builtin_amdgcn_fence(__ATOMIC_ACQUIRE, "agent");
            asm volatile("s_waitcnt vmcnt(0)" ::: "memory");
        }
    }
    __syncthreads();
}

struct Params { const float* in[23]; float* out; unsigned char* ws; int ph_lo, ph_hi; };
static_assert(sizeof(Params) == 23 * 8 + 8 + 8 + 8, "no padding in Params");

struct Ctx {
    int tid, lane, wid, G, gw, NGW;
    unsigned char* smem;
};

template <int MODE>
__device__ __forceinline__ void transpose_job(const Ctx& C, const float* W, int K, int N, u16* WT, int ldt) {
    float* scr = (float*)(C.smem + C.wid * 16384);
    const int nblk = N / 32, nitems = (K / 64) * nblk, lane = C.lane;
    for (int item = C.gw; item < nitems; item += C.NGW) {
        const int kb = item / nblk, nb = item % nblk, k0 = 64 * kb, n0 = 32 * nb;
        float tv[32];
#pragma unroll
        for (int i = 0; i < 32; ++i) tv[i] = __builtin_nontemporal_load(&W[(size_t)(k0 + 2 * i + (lane >> 5)) * N + n0 + (lane & 31)]);
#pragma unroll
        for (int i = 0; i < 32; ++i) scr[(2 * i + (lane >> 5)) * 33 + (lane & 31)] = tv[i];
        asm volatile("s_waitcnt lgkmcnt(0)" ::: "memory");
        const int c = lane & 7;
#pragma unroll
        for (int j = 0; j < 4; ++j) { const int n = (lane >> 3) + 8 * j; const float* s = scr + (8 * c) * 33 + n;
            u32x4 o; o.x = pk2(s[0 * 33], s[1 * 33]); o.y = pk2(s[2 * 33], s[3 * 33]); o.z = pk2(s[4 * 33], s[5 * 33]); o.w = pk2(s[6 * 33], s[7 * 33]);
            int row = n0 + n;
            if (MODE == 1) { const int b = row / FFH, jj = row % FFH; row = (jj / 128) * 256 + b * 128 + (jj % 128); }
            *(u32x4*)(WT + (size_t)row * ldt + k0 + 8 * c) = o; }
        asm volatile("s_waitcnt lgkmcnt(0)" ::: "memory");
    }
}
__device__ __forceinline__ void fold_fourier_job(const Ctx& C, const float* Wf, u16* Bt) {
    f32x2* tab = (f32x2*)(C.smem + 131072);
    __syncthreads();
    if (C.tid < 128) { float s, c; sincospif(2.0f * (float)C.tid / 128.0f, &s, &c); tab[C.tid] = (f32x2){c, s}; }
    __syncthreads();
    const int gt = blockIdx.x * 512 + C.tid, NT_ = C.G * 512;
    float* ct = (float*)(C.smem + C.wid * 4096);
    for (int id = gt; id < 131072; id += NT_) {
        const int n = id & 1023, combo = id >> 10, c8 = combo & 15, ro = (combo >> 4) & 1, g = combo >> 5;
        const float sc = 0.08838834764831845f;
#pragma unroll
        for (int i = 0; i < 16; ++i) { const int q = C.lane + 64 * i, k2 = q >> 3, e = q & 7; const f32x2 cs = tab[(k2 * (c8 * 8 + e)) & 127]; ct[q] = (ro ? cs.y : cs.x) * sc; }
        asm volatile("s_waitcnt lgkmcnt(0)" ::: "memory");
        float a[8] = {0.f, 0.f, 0.f, 0.f, 0.f, 0.f, 0.f, 0.f};
        const float* wp = Wf + (size_t)(g * 128) * 1024 + n;
        const f32x4* ct4 = (const f32x4*)ct;
#pragma unroll 16
        for (int k2 = 0; k2 < 128; ++k2) { const float w = __builtin_nontemporal_load(&wp[(size_t)k2 * 1024]); const f32x4 c0 = ct4[2 * k2], c1 = ct4[2 * k2 + 1];
            a[0] += c0[0] * w; a[1] += c0[1] * w; a[2] += c0[2] * w; a[3] += c0[3] * w; a[4] += c1[0] * w; a[5] += c1[1] * w; a[6] += c1[2] * w; a[7] += c1[3] * w; }
        u32x4 o; o.x = pk2(a[0], a[1]); o.y = pk2(a[2], a[3]); o.z = pk2(a[4], a[5]); o.w = pk2(a[6], a[7]);
        *(u32x4*)(Bt + (size_t)n * 2560 + ro * 512 + g * 128 + c8 * 8) = o;
        asm volatile("s_waitcnt lgkmcnt(0)" ::: "memory");
    }
}

__device__ __forceinline__ void ln_norm(f32x4 (&v)[4], float& mean_o, float& rstd_o) {
    float s = 0.f;
#pragma unroll
    for (int j = 0; j < 4; ++j) s += (v[j][0] + v[j][1]) + (v[j][2] + v[j][3]);
    const float mean = wave_sum(s) * (1.f / D); float s2 = 0.f;
#pragma unroll
    for (int j = 0; j < 4; ++j) { v[j] = v[j] - mean; s2 += (v[j][0] * v[j][0] + v[j][1] * v[j][1]) + (v[j][2] * v[j][2] + v[j][3] * v[j][3]); }
    const float rstd = 1.0f / sqrtf(wave_sum(s2) * (1.f / D) + LN_EPS);
#pragma unroll
    for (int j = 0; j < 4; ++j) v[j] = v[j] * rstd;
    mean_o = mean; rstd_o = rstd;
}
__device__ __forceinline__ void ln_rows(const Ctx& C, int nrows, const float* src, float* dst, const float* lg, const float* lb, bool do_h, const float* mod, int shift_off, int scale_off,
                                        u16* H, float* st, bool write_x, bool xmap) {
    f32x4 g4[4], b4[4], sh[4], sc[4];
#pragma unroll
    for (int j = 0; j < 4; ++j) { g4[j] = (f32x4){1.f, 1.f, 1.f, 1.f}; b4[j] = (f32x4){0.f, 0.f, 0.f, 0.f}; sh[j] = b4[j]; sc[j] = g4[j]; }
    if (lg) {
#pragma unroll
        for (int j = 0; j < 4; ++j) { g4[j] = *(const f32x4*)(lg + 4 * C.lane + 256 * j); b4[j] = *(const f32x4*)(lb + 4 * C.lane + 256 * j); } }
    if (do_h) {
#pragma unroll
        for (int j = 0; j < 4; ++j) { sh[j] = *(const f32x4*)(mod + shift_off + 4 * C.lane + 256 * j); sc[j] = *(const f32x4*)(mod + scale_off + 4 * C.lane + 256 * j) + 1.0f; } }
    const bool xm = xmap && C.G == 256 && nrows == T;
    const int mstep = xm ? 256 : C.NGW, mend = xm ? (int)(2048 * (blockIdx.x & 7)) + 2048 : nrows;
    int m = xm ? (int)(2048 * (blockIdx.x & 7) + (blockIdx.x >> 3) * 8) + C.wid : C.gw; f32x4 nv[4];
    if (m < mend) {
#pragma unroll
        for (int j = 0; j < 4; ++j) nv[j] = *(const f32x4*)(src + (size_t)m * D + 4 * C.lane + 256 * j); }
    for (; m < mend; m += mstep) {
        f32x4 v[4];
#pragma unroll
        for (int j = 0; j < 4; ++j) v[j] = nv[j];
        { const int mn = m + mstep;
          if (mn < mend) {
#pragma unroll
              for (int j = 0; j < 4; ++j) nv[j] = *(const f32x4*)(src + (size_t)mn * D + 4 * C.lane + 256 * j); } }
        float mu, rs;
        if (lg) {
            ln_norm(v, mu, rs);
            if (st && C.lane == 0) *(f32x2*)(st + 2 * (size_t)m) = (f32x2){mu, rs};
#pragma unroll
            for (int j = 0; j < 4; ++j) { v[j] = v[j] * g4[j] + b4[j]; if (write_x) *(f32x4*)(dst + (size_t)m * D + 4 * C.lane + 256 * j) = v[j]; }
        }
        if (do_h) {
            ln_norm(v, mu, rs);
            u32x2* hp = (u32x2*)(H + (size_t)m * D) + C.lane;
#pragma unroll
            for (int j = 0; j < 4; ++j) { const f32x4 h = v[j] * sc[j] + sh[j]; u32x2 w; w.x = pk2(h[0], h[1]); w.y = pk2(h[2], h[3]); hp[64 * j] = w; }
        }
    }
}
__device__ __forceinline__ void ln_pass(const Ctx& C, int nrows, const float* src_lat, const float* src_ctx, float* dst_lat, float* dst_ctx,
                                        const float* lg, const float* lb, bool do_h, const float* mod_lat, const float* mod_ctx, int shift_off, int scale_off, u16* H, float* st, bool write_x) {
    ln_rows(C, T, src_lat, dst_lat, lg, lb, do_h, mod_lat, shift_off, scale_off, H, st, write_x, true);
    if (nrows > T) ln_rows(C, nrows - T, src_ctx, dst_ctx, lg, lb, do_h, mod_ctx, shift_off, scale_off, H + (size_t)T * D, st ? st + 2 * (size_t)T : st, write_x, false);
}

template <int K>
__device__ __forceinline__ void load_B_transposed(const Ctx& C, const u16* B, size_t ldb) {
    constexpr int KP = K + 8;
    unsigned* sB32 = (unsigned*)C.smem;
#pragma unroll
    for (int ch = C.tid; ch < (K / 2) * 16; ch += 512) {
        const int n8 = ch & 15, kp = ch >> 4;
        const u32x4 r0 = __builtin_nontemporal_load((const u32x4*)(B + (size_t)(2 * kp) * ldb + n8 * 8)), r1 = __builtin_nontemporal_load((const u32x4*)(B + (size_t)(2 * kp + 1) * ldb + n8 * 8));
        const unsigned a[4] = {r0.x, r0.y, r0.z, r0.w}, b[4] = {r1.x, r1.y, r1.z, r1.w};
#pragma unroll
        for (int e = 0; e < 4; ++e) { const int n = n8 * 8 + 2 * e;
            sB32[(n * KP) / 2 + kp] = (a[e] & 0xffffu) | (b[e] << 16);
            sB32[((n + 1) * KP) / 2 + kp] = (a[e] >> 16) | (b[e] & 0xffff0000u); }
    }
}
template <int K>
__device__ __forceinline__ void mma_256x128(const Ctx& C, const u16* A_re, const u16* A_im, f32x16 (&acc_re)[2], f32x16 (&acc_im)[2]) {
    constexpr int KP = K + 8;
    const int l32 = C.lane & 31, hi = C.lane >> 5, mb = C.wid & 3, nh = C.wid >> 2;
    const u16* are = A_re + (size_t)(32 * mb + l32) * K + 8 * hi; const u16* aim = A_im + (size_t)(32 * mb + l32) * K + 8 * hi;
    const u16* sB = (const u16*)C.smem;
    const u16* b0p = sB + (64 * nh + l32) * KP + 8 * hi; const u16* b1p = b0p + 32 * KP;
    acc_re[0] = f32x16{}; acc_re[1] = f32x16{}; acc_im[0] = f32x16{}; acc_im[1] = f32x16{};
#pragma unroll 8
    for (int k0 = 0; k0 < K; k0 += 16) {
        const bf16x8 ar = *(const bf16x8*)(are + k0), ai = *(const bf16x8*)(aim + k0);
        const bf16x8 b0 = *(const bf16x8*)(b0p + k0), b1 = *(const bf16x8*)(b1p + k0);
        acc_re[0] = __builtin_amdgcn_mfma_f32_32x32x16_bf16(ar, b0, acc_re[0], 0, 0, 0);
        acc_re[1] = __builtin_amdgcn_mfma_f32_32x32x16_bf16(ar, b1, acc_re[1], 0, 0, 0);
        acc_im[0] = __builtin_amdgcn_mfma_f32_32x32x16_bf16(ai, b0, acc_im[0], 0, 0, 0);
        acc_im[1] = __builtin_amdgcn_mfma_f32_32x32x16_bf16(ai, b1, acc_im[1], 0, 0, 0);
    }
}

__device__ __forceinline__ void ctx_tile(const Ctx& C, const u16* A, int lda, const u16* Bt, int ldb, int K, float (&out)[2]) {
    const int l32 = C.lane & 31, hi = C.lane >> 5, ks = K >> 3;
    const u16* ap = A + (size_t)l32 * lda + C.wid * ks + 8 * hi; const u16* bp = Bt + (size_t)l32 * ldb + C.wid * ks + 8 * hi;
    f32x16 acc = f32x16{};
#pragma unroll 8
    for (int k0 = 0; k0 < ks; k0 += 16) acc = __builtin_amdgcn_mfma_f32_32x32x16_bf16(*(const bf16x8*)(ap + k0), *(const bf16x8*)(bp + k0), acc, 0, 0, 0);
    float* red = (float*)C.smem;
    __syncthreads();
#pragma unroll
    for (int r = 0; r < 16; ++r) red[(C.wid * 32 + crow(r, hi)) * 33 + l32] = acc[r];
    __syncthreads();
#pragma unroll
    for (int i = 0; i < 2; ++i) { const int e = C.tid + 512 * i, rr = e >> 5, cc = e & 31; float s = 0.f;
#pragma unroll
        for (int w = 0; w < 8; ++w) s += red[(w * 32 + rr) * 33 + cc];
        out[i] = s; }
}

__device__ __forceinline__ int lane_id_volatile() { int l; asm volatile("v_mbcnt_lo_u32_b32 %0, -1, 0\n\tv_mbcnt_hi_u32_b32 %0, -1, %0" : "=v"(l)); return l; }
typedef const Params __attribute__((address_space(4))) * KargP;
__global__ void __launch_bounds__(512, 2) fwd_megakernel(Params p_unused) {
    extern __shared__ __attribute__((aligned(16))) unsigned char smem[];
    cg::grid_group grid = cg::this_grid();
    int ph_lo, ph_hi;
    const int WID = __builtin_amdgcn_readfirstlane((int)(threadIdx.x >> 6));
#define MYTID() (WID * 64 + lane_id_volatile())
#define RETID() do { C.lane = lane_id_volatile(); C.tid = WID * 64 + C.lane; } while (0)
    { KargP kp0 = (KargP)__builtin_amdgcn_kernarg_segment_ptr(); ph_lo = kp0->ph_lo; ph_hi = kp0->ph_hi; }
#define p (*KARG)
#define x_in    (p.in[0])
#define c_in    (p.in[1])
#define ctx_in  (p.in[2])
#define cctx_in (p.in[3])
#define w_ada   (p.in[4])
#define b_ada   (p.in[5])
#define w_in    (p.in[6])
#define q_gain  (p.in[7])
#define k_gain  (p.in[8])
#define sgu_g   (p.in[9])
#define sgu_b   (p.in[10])
#define w_sp    (p.in[11])
#define b_sp    (p.in[12])
#define w_bra   (p.in[13])
#define w_brs   (p.in[14])
#define w_brf   (p.in[15])
#define w_out   (p.in[16])
#define ln1_g   (p.in[17])
#define ln1_b   (p.in[18])
#define w_up    (p.in[19])
#define w_down  (p.in[20])
#define ln2_g   (p.in[21])
#define ln2_b   (p.in[22])
#define Hb   ((u16*)(ws + OFF_H))
#define Qb   ((u16*)(ws + OFF_Q))
#define Fb   ((u16*)(ws + OFF_F))
#define Kb   ((u16*)(ws + OFF_K))
#define Vb   ((u16*)(ws + OFF_V))
#define YCb  ((u16*)(ws + OFF_YC))
#define Sb   ((u16*)(ws + OFF_S))
#define Gb   ((u16*)(ws + OFF_G))
#define ACTb ((u16*)(ws + OFF_G))
#define WINt ((u16*)(ws + OFF_W1))
#define WUPt ((u16*)(ws + OFF_WUP))
#define WDNt ((u16*)(ws + OFF_WDN))
#define WBAt ((u16*)(ws + OFF_WBA))
#define WBSt (WBAt + 1024)
#define WBFt (WBAt + 1536)
#define WOt  ((u16*)(ws + OFF_WO))
#define XCTX ((float*)(ws + OFF_XCTX))
#define MODP ((float*)(ws + OFF_MODP))
#define MOD  ((float*)(ws + OFF_MOD))
#define MA   ((u16*)(ws + OFF_MA))
#define MB   ((u16*)(ws + OFF_MB))
#define MC   ((u16*)(ws + OFF_MC))
#define TW   ((f32x2*)(ws + OFF_TW))
#define ROPE ((f32x2*)(ws + OFF_ROPE))
#define WSP  ((u16*)(ws + OFF_WSP))
#define FCb  ((u16*)(ws + OFF_FC))
#define ST1  ((float*)(ws + OFF_ST1))
#define ST2  ((float*)(ws + OFF_ST2))
#define XLAT (p.out)
#define lds3 ((PG8_LAS unsigned char*)smem)

    int ph = 0;
#ifdef PROBE_MASK
#define PROBE_LT ((volatile unsigned long long*)(smem + 131072 + 1536))
    if (MYTID() == 0) { PROBE_LT[0] = 0; PROBE_LT[1] = 0; }
#define PROBE_SEL(k) ((PROBE_MASK >> ((k) < 3 ? (k) : 3 + ((k) - 3) % 10)) & 1)
#define PROBE_T0 if (MYTID() == 0 && PROBE_SEL(ph)) PROBE_LT[1] = __builtin_amdgcn_s_memrealtime();
#define PROBE_T1 if (MYTID() == 0 && PROBE_SEL(ph)) PROBE_LT[0] += __builtin_amdgcn_s_memrealtime() - PROBE_LT[1];
#else
#define PROBE_T0
#define PROBE_T1
#endif
#define XB_ST ((volatile LAS unsigned*)(smem + 131072 + 1600))
#define XB_BAR ((unsigned*)((unsigned char*)((KargP)__builtin_amdgcn_kernarg_segment_ptr())->ws + OFF_BAR))
    if (MYTID() == 0) { XB_ST[0] = 0u; XB_ST[1] = 0u; (void)xb_add(&XB_BAR[XB_XCNT(xb_xcc_id())], 1u); }
    __syncthreads();
    if (ph_hi < ph_lo) grid.sync();
#ifdef PROBE_DUPSYNC
#define GSYNC() do { xcd_barrier(XB_BAR, XB_ST, MYTID()); xcd_barrier(XB_BAR, XB_ST, MYTID()); } while (0)
#else
#define GSYNC() xcd_barrier(XB_BAR, XB_ST, MYTID())
#endif
#define PH_BEGIN if (ph >= ph_lo && ph < ph_hi) { PROBE_T0 KargP KARG = (KargP)__builtin_amdgcn_kernarg_segment_ptr(); asm volatile("" : "+s"(KARG)); unsigned char* ws = KARG->ws; \
    Ctx C; C.wid = WID; RETID(); C.G = gridDim.x; C.gw = blockIdx.x * 8 + C.wid; C.NGW = C.G * 8; C.smem = smem;
#define PH_END } if (ph >= ph_lo && ph + 1 < ph_hi) GSYNC(); if (ph >= ph_lo && ph < ph_hi) { PROBE_T1 } ++ph;

    PH_BEGIN
    {
        float* sm = (float*)(smem + 131072);
        for (int it = blockIdx.x; it < 384; it += C.G) {
            const int l = it / 192, rem = it % 192, kp = rem / 12, nb = rem % 12;
            __syncthreads();
            if (C.tid < 128) { const int w = C.tid >> 6, kk = C.tid & 63; const float v = (w ? cctx_in : c_in)[kp * 64 + kk]; sm[C.tid] = v / (1.0f + expf(-v)); }
            __syncthreads();
            const int n = nb * 512 + C.tid; float a0 = 0.f, a1 = 0.f; const float* wp = w_ada + ((size_t)l * 1024 + kp * 64) * INW + n;
#pragma unroll 32
            for (int kk = 0; kk < 64; ++kk) { const float w = __builtin_nontemporal_load(&wp[(size_t)kk * INW]); a0 += sm[kk] * w; a1 += sm[64 + kk] * w; }
            MODP[(size_t)((l * 16 + kp) * 2 + 0) * INW + n] = a0; MODP[(size_t)((l * 16 + kp) * 2 + 1) * INW + n] = a1;
        }
        __syncthreads();
        const int gt = blockIdx.x * 512 + C.tid, NTH = C.G * 512;
        const float r128 = 0.08838834764831845f;
        for (int i = gt; i < 256 * 128; i += NTH) { const int m = i >> 7, t1 = i & 127, ka = m & 127, im = m >> 7; float s, c; sincospif(2.0f * (float)((ka * t1) & 127) / 128.0f, &s, &c); MA[i] = (u16)f2bf((im ? -s : c) * r128); }
        for (int i = gt; i < 256 * 256; i += NTH) { const int row = i >> 8, col = i & 255, ro = row >> 7, kb = row & 127, ri = col >> 7, t0 = col & 127; float s, c; sincospif(2.0f * (float)((kb * t0) & 127) / 128.0f, &s, &c);
            const float v = (ro == ri) ? c : (ro == 0 ? s : -s); MB[i] = (u16)f2bf(v * r128); }
        for (int i = gt; i < 512 * 256; i += NTH) { const int row = i >> 8, t = i & 255, ro = row >> 8, k1 = row & 255; float s, c; sincospif(2.0f * (float)((k1 * t) & 255) / 256.0f, &s, &c); MC[i] = (u16)f2bf((ro ? -s : c) * 0.0625f); }
        for (int i = gt; i < 128 * 128; i += NTH) { const int ka = i >> 7, t0 = i & 127; float s, c; sincospif(2.0f * (float)((ka * t0) & 16383) / 16384.0f, &s, &c); TW[i] = (f32x2){c, s}; }
        for (int i = gt; i < 256 * 32; i += NTH) { const int pos = i >> 5, j = i & 31; const float inv = exp2f(-(float)j * (13.287712379549449f / 32.0f)); const float ang = (float)pos * inv;
            const double rev = (double)ang * 0.15915494309189535; const double fr = rev - rint(rev); float s, c; sincospif((float)(2.0 * fr), &s, &c); ROPE[i] = (f32x2){c, s}; }
        for (int i = gt; i < NL * 8 * 128 * 128; i += NTH) WSP[i] = (u16)f2bf(__builtin_nontemporal_load(&w_sp[i]));
        transpose_job<0>(C, w_in, D, INW, WINt, D);
        transpose_job<0>(C, w_bra, D, D, WBAt, 2560);
        transpose_job<0>(C, w_brs, 512, D, WBSt, 2560);
        transpose_job<0>(C, w_out, D, D, WOt, D);
        fold_fourier_job(C, w_brf, WBFt);
    }
    PH_END
    PH_BEGIN
    {
        const int gt = blockIdx.x * 512 + C.tid, NTH = C.G * 512;
        for (int i = gt; i < NL * 2 * INW; i += NTH) { const int n = i % INW, lw = i / INW, l = lw >> 1, w = lw & 1; float a = b_ada[l * INW + n];
            for (int kp = 0; kp < 16; ++kp) a += MODP[(size_t)((l * 16 + kp) * 2 + w) * INW + n];
            MOD[i] = a; }
    }
    PH_END
    PH_BEGIN
    ln_pass(C, R, x_in, ctx_in, nullptr, nullptr, nullptr, nullptr, true, MOD, MOD + INW, 0, 1024, Hb, nullptr, false);
    PH_END

#pragma unroll 1
    for (int l = 0; l < NL; ++l) {
        const bool lastl = (l == NL - 1);
#define modl (MOD + (size_t)(l * 2 + 0) * INW)
#define modc (MOD + (size_t)(l * 2 + 1) * INW)
#define xin_lat ((l == 0) ? x_in : (const float*)XLAT)
#define xin_ctx ((l == 0) ? ctx_in : (const float*)XCTX)

        PH_BEGIN
        {
            pg8::Gemm g{Hb, WINt, D, D, D, nullptr, nullptr, 0, nullptr, nullptr, 0}; pg8::OrderX S; S.init(INW, C.G, (int)blockIdx.x, 0, 0);
            pg8::EpiIn E{Qb, Kb, Vb, Sb, Fb, FCb, Gb};
            pg8::gemm_phase<pg8::EpiIn, pg8::OrderX>(lds3, g, S, E, C.tid);
            const int ct0 = lastl ? 32 : 0, nct = lastl ? 16 : 192;
            for (int it = blockIdx.x; it < 8 * nct; it += C.G) {
                const int rt = it / nct, ctile = ct0 + it % nct, r0 = T + 32 * rt, c0 = 32 * ctile;
                float v[2]; ctx_tile(C, Hb + (size_t)r0 * D, D, WINt + (size_t)c0 * D, D, D, v);
#pragma unroll
                for (int i = 0; i < 2; ++i) { const int e = C.tid + 512 * i, row = r0 + (e >> 5), col = c0 + (e & 31); const float x = v[i];
                    if (col < 1024) Qb[(size_t)row * 1024 + col] = (u16)f2bf(x);
                    else if (col < 1280) Kb[(size_t)row * 256 + col - 1024] = (u16)f2bf(x);
                    else if (col < 1536) Vb[(size_t)row * 256 + col - 1280] = (u16)f2bf(x);
                    else if (col < 2560) Sb[(size_t)row * 1024 + col - 1536] = (u16)f2bf(fgelu_tanh(x));
                    else if (col < 3072) FCb[(size_t)(row - T) * 512 + col - 2560] = (u16)f2bf(x);
                    else Gb[(size_t)row * 3072 + col - 3072] = (u16)f2bf(fsigmoid(x)); }
            }
            __syncthreads();
        }
        PH_END
        PH_BEGIN
        {
            {
                const int sub = C.lane >> 4, l16 = C.lane & 15;
#pragma unroll 1
                for (int pass = 0; pass < 2; ++pass) {
                    u16* base = pass == 0 ? Qb : Kb; const int nseg = pass == 0 ? (lastl ? T : R) * 8 : R * 2; const int shift = pass == 0 ? 3 : 1;
                    const float* gain = (pass == 0 ? q_gain : k_gain) + l * 128 + l16 * 8;
                    const f32x4 g0 = *(const f32x4*)gain, g1 = *(const f32x4*)(gain + 4);
                    const int ngroups = nseg >> 2;
#pragma unroll 4
                    for (int grp = C.gw; grp < ngroups; grp += C.NGW) {
                        const int s = grp * 4 + sub, m = s >> shift;
                        u32x4* pp = (u32x4*)(base + (size_t)s * 128 + l16 * 8);
                        const u32x4 w = *pp;
                        float x0 = bflo(w.x), x1 = bfhi(w.x), x2 = bflo(w.y), x3 = bfhi(w.y), x4 = bflo(w.z), x5 = bfhi(w.z), x6 = bflo(w.w), x7 = bfhi(w.w);
                        float ss = (x0 * x0 + x1 * x1) + (x2 * x2 + x3 * x3) + (x4 * x4 + x5 * x5) + (x6 * x6 + x7 * x7);
                        ss += __shfl_xor(ss, 1); ss += __shfl_xor(ss, 2); ss += __shfl_xor(ss, 4); ss += __shfl_xor(ss, 8);
                        const float rs = (pass == 0 ? 0.12751743f   : 1.0f) / sqrtf(ss * (1.0f / 128.0f) + RMS_EPS);
                        x0 *= rs * g0[0]; x1 *= rs * g0[1]; x2 *= rs * g0[2]; x3 *= rs * g0[3]; x4 *= rs * g1[0]; x5 *= rs * g1[1]; x6 *= rs * g1[2]; x7 *= rs * g1[3];
                        if (m < T) { const int pos = l16 < 8 ? (m >> 6) : (m & 63); const f32x2* rp = ROPE + pos * 32 + (l16 & 7) * 4;
                            const f32x4 c01 = *(const f32x4*)rp, c23 = *(const f32x4*)(rp + 2);
                            float t;
                            t = x0 * c01[0] - x1 * c01[1]; x1 = x0 * c01[1] + x1 * c01[0]; x0 = t;
                            t = x2 * c01[2] - x3 * c01[3]; x3 = x2 * c01[3] + x3 * c01[2]; x2 = t;
                            t = x4 * c23[0] - x5 * c23[1]; x5 = x4 * c23[1] + x5 * c23[0]; x4 = t;
                            t = x6 * c23[2] - x7 * c23[3]; x7 = x6 * c23[3] + x7 * c23[2]; x6 = t; }
                        u32x4 o; o.x = pk2(x0, x1); o.y = pk2(x2, x3); o.z = pk2(x4, x5); o.w = pk2(x6, x7);
                        *pp = o;
                    }
                }
            }
            RETID();
            {
                const int nchunks = lastl ? 128 : 130;
                float* smean = (float*)(smem + 65536); float* srstd = smean + 128;
                unsigned* sB32 = (unsigned*)smem; constexpr int KP = 136;
                const int l32 = C.lane & 31, hi = C.lane >> 5, mb = C.wid & 3, nb = C.wid >> 2;
                const int nitems = 256 + (lastl ? 0 : 16);
                for (int it = blockIdx.x; it < nitems; it += C.G) {
                    const int ch = it < 256 ? (it >> 1) : 128 + ((it - 256) >> 3), g0 = it < 256 ? (it & 1) * 4 : ((it - 256) & 7), ngr = it < 256 ? 4 : 1, R0 = ch * 128;
                    __syncthreads();
                    { const int q = C.tid >> 2, part = C.tid & 3; const u16* vr = Sb + (size_t)(R0 + q) * 1024 + 512 + part * 128; float s = 0.f, s2 = 0.f;
                      u32x4 w[16];
#pragma unroll
                      for (int j = 0; j < 16; ++j) w[j] = *(const u32x4*)(vr + j * 8);
#pragma unroll
                      for (int j = 0; j < 16; ++j) { const unsigned ww[4] = {w[j].x, w[j].y, w[j].z, w[j].w};
#pragma unroll
                          for (int e = 0; e < 4; ++e) { const float a = bflo(ww[e]), b = bfhi(ww[e]); s += a + b; s2 += a * a + b * b; } }
                      s += __shfl_xor(s, 1); s += __shfl_xor(s, 2); s2 += __shfl_xor(s2, 1); s2 += __shfl_xor(s2, 2);
                      const float mean = s * (1.0f / 512.0f); const float var = fmaxf(s2 * (1.0f / 512.0f) - mean * mean, 0.f);
                      if (part == 0) { smean[q] = mean; srstd[q] = 1.0f / sqrtf(var + LN_EPS); } }
                    __syncthreads();
                    const int qp = C.tid >> 3, c8 = C.tid & 7;
                    const float m0 = smean[2 * qp], s0 = srstd[2 * qp], m1 = smean[2 * qp + 1], s1 = srstd[2 * qp + 1];
#pragma unroll 1
                    for (int gi = 0; gi < ngr; ++gi) {
                        const int g = g0 + gi, cb = g * 64 + c8 * 8, cc = g * 64 + 32 * nb + l32;
                        const u32x4 r0 = *(const u32x4*)(Sb + (size_t)(R0 + 2 * qp) * 1024 + 512 + cb), r1 = *(const u32x4*)(Sb + (size_t)(R0 + 2 * qp + 1) * 1024 + 512 + cb);
                        const f32x4 ga = *(const f32x4*)(sgu_g + l * 512 + cb), gb = *(const f32x4*)(sgu_g + l * 512 + cb + 4), ba = *(const f32x4*)(sgu_b + l * 512 + cb), bb = *(const f32x4*)(sgu_b + l * 512 + cb + 4);
                        const u16* arow = WSP + ((size_t)(l * 8 + g) * 128 + 32 * mb + l32) * 128 + 8 * hi;
                        bf16x8 af[8];
#pragma unroll
                        for (int k = 0; k < 8; ++k) af[k] = *(const bf16x8*)(arow + 16 * k);
                        u16 uv[16]; float bsp[16];
#pragma unroll
                        for (int r = 0; r < 16; ++r) { const int pr = 32 * mb + crow(r, hi); uv[r] = Sb[(size_t)(R0 + pr) * 1024 + cc]; bsp[r] = b_sp[(l * 8 + g) * 128 + pr]; }
                        const float gg[8] = {ga[0], ga[1], ga[2], ga[3], gb[0], gb[1], gb[2], gb[3]}, bbv[8] = {ba[0], ba[1], ba[2], ba[3], bb[0], bb[1], bb[2], bb[3]};
                        const unsigned a[4] = {r0.x, r0.y, r0.z, r0.w}, b[4] = {r1.x, r1.y, r1.z, r1.w};
#pragma unroll
                        for (int e = 0; e < 4; ++e) { const int c = c8 * 8 + 2 * e;
                            const float v00 = (bflo(a[e]) - m0) * s0 * gg[2 * e] + bbv[2 * e], v01 = (bfhi(a[e]) - m0) * s0 * gg[2 * e + 1] + bbv[2 * e + 1];
                            const float v10 = (bflo(b[e]) - m1) * s1 * gg[2 * e] + bbv[2 * e], v11 = (bfhi(b[e]) - m1) * s1 * gg[2 * e + 1] + bbv[2 * e + 1];
                            sB32[(c * KP) / 2 + qp] = pk2(v00, v10); sB32[((c + 1) * KP) / 2 + qp] = pk2(v01, v11); }
                        __syncthreads();
                        { const u16* bp = (const u16*)smem + (32 * nb + l32) * KP + 8 * hi;
                          f32x16 acc = f32x16{};
#pragma unroll
                          for (int k = 0; k < 8; ++k) acc = __builtin_amdgcn_mfma_f32_32x32x16_bf16(af[k], *(const bf16x8*)(bp + 16 * k), acc, 0, 0, 0);
#pragma unroll
                          for (int r = 0; r < 16; ++r) { const int pr = 32 * mb + crow(r, hi); Sb[(size_t)(R0 + pr) * 1024 + cc] = (u16)f2bf(bf2f(uv[r]) * (acc[r] + bsp[r])); } }
                        __syncthreads();
                    }
                }
                __syncthreads();
            }
            RETID();
            for (int it = blockIdx.x; it < 512; it += C.G) {
                const int n0 = it * 128, t0 = it >> 2;
                __syncthreads();
                load_B_transposed<128>(C, Fb + n0, 65536);
                __syncthreads();
                f32x16 are[2], aim[2];
                mma_256x128<128>(C, MA, MA + 128 * 128, are, aim);
                const int l32 = C.lane & 31, hi = C.lane >> 5, mb = C.wid & 3, nh = C.wid >> 2;
#pragma unroll
                for (int s = 0; s < 2; ++s)
#pragma unroll
                    for (int r = 0; r < 16; ++r) { const int ka = 32 * mb + crow(r, hi); const f32x2 tw = TW[ka * 128 + t0];
                        const float hr = are[s][r], hm = aim[s][r]; const float orr = hr * tw.x + hm * tw.y, oi = hm * tw.x - hr * tw.y;
                        const size_t o = (size_t)ka * 131072 + n0 + 64 * nh + 32 * s + l32;
                        Hb[o] = (u16)f2bf(orr); Hb[o + 65536] = (u16)f2bf(oi); }
            }
            __syncthreads();
            RETID();
            transpose_job<1>(C, w_up + (size_t)l * D * 2 * FFH, D, 2 * FFH, WUPt, D);
            transpose_job<0>(C, w_down + (size_t)l * FFH * D, FFH, D, WDNt, FFH);
        }
        PH_END
        PH_BEGIN
        {
            const int nunits = lastl ? 512 : 520;
            float noff;
            { float gq = fmaxf(fabsf(q_gain[l * 128 + C.lane]), fabsf(q_gain[l * 128 + 64 + C.lane])), gk = fmaxf(fabsf(k_gain[l * 128 + C.lane]), fabsf(k_gain[l * 128 + 64 + C.lane]));
#pragma unroll
              for (int o = 1; o < 64; o <<= 1) { gq = fmaxf(gq, __shfl_xor(gq, o)); gk = fmaxf(gk, __shfl_xor(gk, o)); }
              const float bound = gq * gk * 11.3137085f * 1.44269504f;
              noff = -fmaxf(0.f, bound - 60.f); }
            for (int L = blockIdx.x; L < nunits; L += C.G) {
                __syncthreads();
                const u16 *qp, *kp, *vp; int seq;
                if (L < 512) { const int h = L >> 6, qb = L & 63, kvh = h >> 2; qp = Qb + (size_t)(qb * 256) * 1024 + h * 128; kp = Kb + kvh * 128; vp = Vb + kvh * 128; seq = R; }
                else { const int h = L - 512, kvh = h >> 2; qp = Qb + (size_t)T * 1024 + h * 128; kp = Kb + (size_t)T * 256 + kvh * 128; vp = Vb + (size_t)T * 256 + kvh * 128; seq = CTX; }
                att::attn_dense_body(qp, kp, vp, (u16*)qp, seq, (char*)smem, C.tid, noff);
            }
            __syncthreads();
        }
        PH_END
        PH_BEGIN
        {
            const int nitems = lastl ? 512 : 520;
            for (int it = blockIdx.x; it < nitems; it += C.G) {
                const u16 *Are, *Aim, *Bp; int rowbase, rowstride, nt;
                if (it < 512) { const int ka = it >> 2; nt = it & 3; Are = MB; Aim = MB + 128 * 256; Bp = Hb + (size_t)ka * 131072 + nt * 128; rowbase = ka; rowstride = 128; }
                else { const int hs = (it - 512) >> 2; nt = it & 3; Are = MC + (size_t)(128 * hs) * 256; Aim = MC + (size_t)(256 + 128 * hs) * 256; Bp = FCb + nt * 128; rowbase = T + 128 * hs; rowstride = 1; }
                __syncthreads();
                load_B_transposed<256>(C, Bp, 512);
                __syncthreads();
                f32x16 are[2], aim[2];
                mma_256x128<256>(C, Are, Aim, are, aim);
                const int l32 = C.lane & 31, hi = C.lane >> 5, mb = C.wid & 3, nh = C.wid >> 2;
#pragma unroll
                for (int s = 0; s < 2; ++s)
#pragma unroll
                    for (int r = 0; r < 16; ++r) { const int kb = 32 * mb + crow(r, hi); const size_t o = (size_t)(rowbase + rowstride * kb) * 1024 + nt * 128 + 64 * nh + 32 * s + l32;
                        YCb[o] = (u16)f2bf(are[s][r]); YCb[o + 512] = (u16)f2bf(aim[s][r]); }
            }
            __syncthreads();
        }
        PH_END
        PH_BEGIN
        {
            {
                pg8::Gemm g{Qb, WBAt, 1024, 1024, 2560, Sb, WBSt, 512, YCb, WBFt, 1024};
                pg8::OrderBr S; S.init(D, C.G, (int)blockIdx.x);
                pg8::EpiBr E{Gb, Hb};
                pg8::gemm_phase<pg8::EpiBr, pg8::OrderBr>(lds3, g, S, E, C.tid);
            }
            if (!lastl) {
                for (int it = blockIdx.x; it < 8 * 32; it += C.G) {
                    const int r0 = T + 32 * (it >> 5), c0 = 32 * (it & 31);
                    float m[2] = {0.f, 0.f};
#pragma unroll 1
                    for (int b = 0; b < 3; ++b) { float v[2];
                        ctx_tile(C, (b == 0 ? Qb : (b == 1 ? Sb : YCb)) + (size_t)r0 * 1024, 1024, (b == 0 ? WBAt : (b == 1 ? WBSt : WBFt)) + (size_t)c0 * 2560, 2560, b == 1 ? 512 : 1024, v);
#pragma unroll
                        for (int i = 0; i < 2; ++i) { const int e = C.tid + 512 * i, row = r0 + (e >> 5), col = c0 + (e & 31); m[i] += v[i] * bf2f(Gb[(size_t)row * 3072 + b * 1024 + col]); } }
#pragma unroll
                    for (int i = 0; i < 2; ++i) { const int e = C.tid + 512 * i, row = r0 + (e >> 5), col = c0 + (e & 31); Hb[(size_t)row * 1024 + col] = (u16)f2bf(m[i]); }
                }
                __syncthreads();
            }
        }
        PH_END
        PH_BEGIN
        {
            pg8::Gemm g{Hb, WOt, D, D, D, nullptr, nullptr, 0, nullptr, nullptr, 0}; pg8::OrderX S; S.init(D, C.G, (int)blockIdx.x, 0, 0);
            pg8::EpiRes E{xin_lat, XLAT, modl + 2 * 1024, (l == 0) ? (const float*)nullptr : (const float*)ST2, ln2_g + (l - 1) * D, ln2_b + (l - 1) * D};
            pg8::gemm_phase<pg8::EpiRes, pg8::OrderX>(lds3, g, S, E, C.tid);
            if (!lastl) {
                for (int it = blockIdx.x; it < 8 * 32; it += C.G) {
                    const int r0 = 32 * (it >> 5), c0 = 32 * (it & 31);
                    float v[2]; ctx_tile(C, Hb + (size_t)(T + r0) * D, D, WOt + (size_t)c0 * D, D, D, v);
#pragma unroll
                    for (int i = 0; i < 2; ++i) { const int e = C.tid + 512 * i, row = r0 + (e >> 5), col = c0 + (e & 31);
                        XCTX[(size_t)row * D + col] = ALPHA * xin_ctx[(size_t)row * D + col] + (modc + 2 * 1024)[col] * v[i]; }
                }
                __syncthreads();
            }
        }
        PH_END
        PH_BEGIN
        ln_pass(C, lastl ? T : R, XLAT, XCTX, XLAT, XCTX, ln1_g + l * D, ln1_b + l * D, true, modl, modc, 3 * 1024, 4 * 1024, Hb, ST1, false);
        PH_END
        PH_BEGIN
        {
            pg8::Gemm g{Hb, WUPt, D, D, D, nullptr, nullptr, 0, nullptr, nullptr, 0}; pg8::OrderX S; S.init(2 * FFH, C.G, (int)blockIdx.x, lastl ? 0 : 22, 0);
            pg8::EpiUp E{ACTb};
            pg8::gemm_phase<pg8::EpiUp, pg8::OrderX>(lds3, g, S, E, C.tid);
        }
        PH_END
        PH_BEGIN
        {
            pg8::Gemm g{ACTb, WDNt, FFH, FFH, FFH, nullptr, nullptr, 0, nullptr, nullptr, 0}; pg8::OrderX S; S.init(D, C.G, (int)blockIdx.x, 0, 0);
            pg8::EpiRes E{XLAT, XLAT, modl + 5 * 1024, ST1, ln1_g + l * D, ln1_b + l * D};
            pg8::gemm_phase<pg8::EpiRes, pg8::OrderX>(lds3, g, S, E, C.tid);
            if (!lastl) {
                for (int it = blockIdx.x; it < 8 * 32; it += C.G) {
                    const int r0 = 32 * (it >> 5), c0 = 32 * (it & 31);
                    float v[2]; ctx_tile(C, ACTb + (size_t)(T + r0) * FFH, FFH, WDNt + (size_t)c0 * FFH, FFH, FFH, v);
#pragma unroll
                    for (int i = 0; i < 2; ++i) { const int e = C.tid + 512 * i, row = r0 + (e >> 5), col = c0 + (e & 31);
                        const f32x2 sv = *(const f32x2*)(ST1 + 2 * (size_t)(T + row)); const float x1 = (XCTX[(size_t)row * D + col] - sv[0]) * sv[1] * (ln1_g + l * D)[col] + (ln1_b + l * D)[col];
                        XCTX[(size_t)row * D + col] = ALPHA * x1 + (modc + 5 * 1024)[col] * v[i]; }
                }
                __syncthreads();
            }
        }
        PH_END
        PH_BEGIN
        {
            ln_pass(C, lastl ? T : R, XLAT, XCTX, XLAT, XCTX, ln2_g + l * D, ln2_b + l * D, !lastl, modl + 2 * INW, modc + 2 * INW, 0, 1024, Hb, ST2, lastl);
            if (!lastl) {
                __syncthreads();
                transpose_job<0>(C, w_in + (size_t)(l + 1) * D * INW, D, INW, WINt, D);
                transpose_job<0>(C, w_bra + (size_t)(l + 1) * D * D, D, D, WBAt, 2560);
                transpose_job<0>(C, w_brs + (size_t)(l + 1) * 512 * D, 512, D, WBSt, 2560);
                transpose_job<0>(C, w_out + (size_t)(l + 1) * D * D, D, D, WOt, D);
                fold_fourier_job(C, w_brf + (size_t)(l + 1) * 512 * D, WBFt);
            }
        }
        PH_END
    }
#ifdef PROBE_MASK
    {
        KargP KARG = (KargP)__builtin_amdgcn_kernarg_segment_ptr(); unsigned char* ws = KARG->ws;
        unsigned long long* slot = (unsigned long long*)(ws + OFF_PROBE);
        grid.sync();
        if (blockIdx.x == 0 && threadIdx.x == 0) *slot = PROBE_LT[0];
        grid.sync();
        const float t_us = (float)(*slot) * 0.01f;
        const float delta = sqrtf(t_us * 1e-8f);
        float* o = KARG->out;
        for (size_t i = (size_t)blockIdx.x * 512 + threadIdx.x; i < (size_t)T * D; i += (size_t)gridDim.x * 512) o[i] += (i & 1) ? delta : -delta;
    }
#endif
#undef PH_BEGIN
#undef PH_END
#undef p
}

extern "C" void kernel_launch(void* const* d_in, const int* in_sizes, int n_in, void* d_out, int out_size, void* d_ws, size_t ws_size, hipStream_t stream) {
    static int grid = 0;
    if (grid == 0) {
        if (n_in != 23 || out_size != T * D || ws_size < WS_END) { fprintf(stderr, "kernel_launch: unexpected shapes (n_in %d out %d ws %zu need %zu)\n", n_in, out_size, ws_size, (size_t)WS_END); grid = -1; return; }
        int dev = 0, cus = 0, per_cu = 0;
        hipGetDevice(&dev); hipDeviceGetAttribute(&cus, hipDeviceAttributeMultiprocessorCount, dev);
        if (hipFuncSetAttribute((const void*)fwd_megakernel, hipFuncAttributeMaxDynamicSharedMemorySize, LDS_BYTES) != hipSuccess) { fprintf(stderr, "kernel_launch: hipFuncSetAttribute failed\n"); grid = -1; return; }
        if (hipOccupancyMaxActiveBlocksPerMultiprocessor(&per_cu, (const void*)fwd_megakernel, 512, LDS_BYTES) != hipSuccess || per_cu < 1) { fprintf(stderr, "kernel_launch: occupancy query says %d\n", per_cu); per_cu = 1; }
        (void)hipGetLastError();
        grid = cus * 1;
        fprintf(stderr, "kernel_launch: cus %d per_cu %d grid %d\n", cus, per_cu, grid);
    }
    if (grid < 0) return;
    Params p{};
    for (int i = 0; i < 23; ++i) p.in[i] = (const float*)d_in[i];
    p.out = (float*)d_out; p.ws = (unsigned char*)d_ws; p.ph_lo = 0; p.ph_hi = 3 + 10 * NL;
    if (hipMemsetAsync((char*)d_ws + OFF_BAR, 0, BAR_BYTES, stream) != hipSuccess) { fprintf(stderr, "kernel_launch: memset failed\n"); return; }
    void* args[] = {&p};
    hipError_t e = hipLaunchCooperativeKernel((const void*)fwd_megakernel, dim3(grid), dim3(512), args, LDS_BYTES, stream);
    if (e != hipSuccess) fprintf(stderr, "kernel_launch: cooperative launch failed: %s (grid %d)\n", hipGetErrorString(e), grid);
}
```
